# Optimizing an MI355X kernel written in HIP

```python
import math
import jax, jax.numpy as jnp
from jax import lax
import numpy as np


D_MODEL = 2048
BATCH = 2
SEQ = 8192
DEPTH = 4

D_MIX = D_MODEL
S5_WIDTH = D_MIX // 4
S5_GROUP = 16
S5_GROUPS = S5_WIDTH // S5_GROUP
S5_STATE = 64
S5_DT_MIN = 1e-3
S5_DT_MAX = 1e-1
S5_EIG_CLIP = -1e-4
GDN_HEAD_DIM = 128
GDN_WIDTH = D_MIX // 2
GDN_HEADS = GDN_WIDTH // GDN_HEAD_DIM
GDN_CHUNK = 64
LRU_WIDTH = D_MIX - S5_WIDTH - GDN_WIDTH
LRU_BLOCKS = 8
LRU_BLOCK = LRU_WIDTH // LRU_BLOCKS
LRU_C = 8.0
CONV_WIDTH = 4
D_FF = ((8 * D_MODEL // 3 + 255) // 256) * 256
IN_SPLITS = (S5_WIDTH, 3 * GDN_WIDTH, GDN_WIDTH, GDN_HEADS, GDN_HEADS, LRU_WIDTH, LRU_WIDTH)
D_IN_PROJ = sum(IN_SPLITS)
LN_EPS = 1e-5
RMS_EPS = 1e-6
DEEPNORM_ALPHA = (2.0 * DEPTH) ** 0.25
DEEPNORM_BETA = (8.0 * DEPTH) ** -0.25
MACARON_WEIGHT = 0.5

kernel_name = 'hybrid_s5_gdn_rglru_macaron_deepnorm'


def layer_norm(x, g, b):
    xf = x.astype(jnp.float32)
    mu = jnp.mean(xf, axis=-1, keepdims=True)
    xc = xf - mu
    var = jnp.mean(xc * xc, axis=-1, keepdims=True)
    return (xc * lax.rsqrt(var + LN_EPS) * g + b).astype(x.dtype)


def swiglu(x, w_gate, w_up, w_down):
    return (jax.nn.silu(x @ w_gate) * (x @ w_up)) @ w_down


def causal_depthwise_conv(x, w):
    k_width, seq = w.shape[0], x.shape[1]
    xp = jnp.pad(x, ((0, 0), (k_width - 1, 0), (0, 0)))
    y = xp[:, 0:seq] * w[0]
    for k in range(1, k_width):
        y = y + xp[:, k:k + seq] * w[k]
    return y


def linear_recurrence_combine(left, right):
    a_l, b_l = left
    a_r, b_r = right
    return a_l * a_r, a_r * b_l + b_r


def s5_mixer(u, lam_re, lam_im, b_re, b_im, c_re, c_im, d, log_step, w_glu, b_glu):
    bsz, seq, _ = u.shape
    uf = u.astype(jnp.float32).reshape(bsz, seq, S5_GROUPS, S5_GROUP)
    lam = lax.complex(jnp.minimum(lam_re.astype(jnp.float32), S5_EIG_CLIP), lam_im.astype(jnp.float32))
    dt = jnp.exp(log_step.astype(jnp.float32))[:, None]
    lam_bar = jnp.exp(lam * dt)
    b_mat = lax.complex(b_re.astype(jnp.float32), b_im.astype(jnp.float32))
    b_bar = ((lam_bar - 1.0) / lam)[..., None] * b_mat
    bu = jnp.einsum('blgp,gnp->blgn', uf.astype(jnp.complex64), b_bar)
    a = jnp.broadcast_to(lam_bar, bu.shape)
    _, h = lax.associative_scan(linear_recurrence_combine, (a, bu), axis=1)
    c_mat = lax.complex(c_re.astype(jnp.float32), c_im.astype(jnp.float32))
    y = jnp.einsum('blgn,gpn->blgp', h, c_mat).real + d.astype(jnp.float32).reshape(S5_GROUPS, S5_GROUP) * uf
    y = jax.nn.gelu(y.reshape(bsz, seq, S5_WIDTH))
    return y * jax.nn.sigmoid(y @ w_glu + b_glu)


def l2_normalize(x):
    return x * lax.rsqrt(jnp.sum(x * x, axis=-1, keepdims=True) + RMS_EPS)


def chunk_gated_delta_rule(q, k, v, g, beta):
    bsz, seq, heads, dk = q.shape
    dv = v.shape[-1]
    n_chunks = seq // GDN_CHUNK

    def to_chunks(t):
        return t.reshape(bsz, n_chunks, GDN_CHUNK, heads, -1).transpose(1, 0, 3, 2, 4)

    q, k, v = to_chunks(q), to_chunks(k), to_chunks(v)
    beta_c = beta.reshape(bsz, n_chunks, GDN_CHUNK, heads).transpose(1, 0, 3, 2)
    gc = jnp.cumsum(g.reshape(bsz, n_chunks, GDN_CHUNK, heads).transpose(1, 0, 3, 2), axis=-1)
    causal = jnp.tril(jnp.ones((GDN_CHUNK, GDN_CHUNK), dtype=bool))
    strict = jnp.tril(jnp.ones((GDN_CHUNK, GDN_CHUNK), dtype=bool), -1)
    decay = jnp.exp(jnp.where(causal, gc[..., :, None] - gc[..., None, :], -jnp.inf))
    k_beta = k * beta_c[..., None]
    v_beta = v * beta_c[..., None]
    m = jnp.where(strict, jnp.einsum('nbhid,nbhjd->nbhij', k_beta, k) * decay, 0.0)
    t_mat = jnp.eye(GDN_CHUNK, dtype=jnp.float32) + m
    rhs = jnp.concatenate([v_beta, k_beta * jnp.exp(gc)[..., None]], axis=-1)
    sol = lax.linalg.triangular_solve(t_mat, rhs, left_side=True, lower=True, unit_diagonal=True)
    u_val, w_val = sol[..., :dv], sol[..., dv:]
    qk = jnp.where(causal, jnp.einsum('nbhid,nbhjd->nbhij', q, k) * decay, 0.0)
    q_dec = q * jnp.exp(gc)[..., None]
    k_dec = k * jnp.exp(gc[..., -1:] - gc)[..., None]
    g_last = jnp.exp(gc[..., -1])

    def step(state, xs):
        u_i, w_i, qd_i, qk_i, kd_i, gl_i = xs
        v_new = u_i - jnp.einsum('bhck,bhkv->bhcv', w_i, state)
        o_i = jnp.einsum('bhck,bhkv->bhcv', qd_i, state) + jnp.einsum('bhij,bhjv->bhiv', qk_i, v_new)
        state = state * gl_i[..., None, None] + jnp.einsum('bhck,bhcv->bhkv', kd_i, v_new)
        return state, o_i

    state0 = jnp.zeros((bsz, heads, dk, dv), jnp.float32)
    _, o = lax.scan(step, state0, (u_val, w_val, q_dec, qk, k_dec, g_last))
    return o.transpose(1, 0, 3, 2, 4).reshape(bsz, seq, heads, dv)


def gdn_mixer(qkv, z, a_logit, b_logit, conv_w, a_log, dt_bias, norm_g):
    bsz, seq, _ = qkv.shape
    qkv = jax.nn.silu(causal_depthwise_conv(qkv, conv_w)).astype(jnp.float32)
    q, k, v = jnp.split(qkv, 3, axis=-1)
    heads_shape = (bsz, seq, GDN_HEADS, GDN_HEAD_DIM)
    q = l2_normalize(q.reshape(heads_shape)) * (GDN_HEAD_DIM ** -0.5)
    k = l2_normalize(k.reshape(heads_shape))
    v = v.reshape(heads_shape)
    beta = jax.nn.sigmoid(b_logit.astype(jnp.float32))
    g = -jnp.exp(a_log.astype(jnp.float32)) * jax.nn.softplus(a_logit.astype(jnp.float32) + dt_bias)
    o = chunk_gated_delta_rule(q, k, v, g, beta)
    o = o * lax.rsqrt(jnp.mean(o * o, axis=-1, keepdims=True) + RMS_EPS) * norm_g
    o = o * jax.nn.silu(z.astype(jnp.float32).reshape(heads_shape))
    return o.reshape(bsz, seq, GDN_WIDTH)


def rglru_mixer(xb, gate, conv_w, conv_b, w_a, b_a, w_x, b_x, lam):
    bsz, seq, _ = xb.shape
    xc = (causal_depthwise_conv(xb, conv_w) + conv_b).astype(jnp.float32)
    xh = xc.reshape(bsz, seq, LRU_BLOCKS, LRU_BLOCK)
    r = jax.nn.sigmoid(jnp.einsum('blhi,hij->blhj', xh, w_a).reshape(bsz, seq, LRU_WIDTH) + b_a)
    i = jax.nn.sigmoid(jnp.einsum('blhi,hij->blhj', xh, w_x).reshape(bsz, seq, LRU_WIDTH) + b_x)
    log_a = -LRU_C * r * jax.nn.softplus(-lam.astype(jnp.float32))
    a = jnp.exp(log_a)
    bt = jnp.sqrt(-jnp.expm1(2.0 * log_a)) * (i * xc)
    _, h = lax.associative_scan(linear_recurrence_combine, (a, bt), axis=1)
    return h * jax.nn.gelu(gate.astype(jnp.float32))


def setup_inputs(seed: int = 0) -> dict:
    key = jax.random.key(seed)
    keys = jax.random.split(key, 64)
    counter = [0]

    def nk():
        counter[0] += 1
        return keys[counter[0]]

    def normal(shape, scale):
        return jax.random.normal(nk(), shape, jnp.float32) * scale

    def uniform(shape, lo, hi):
        return jax.random.uniform(nk(), shape, jnp.float32, lo, hi)

    L = DEPTH
    inp = {}
    inp['x'] = normal((BATCH, SEQ, D_MODEL), 1.0)
    inp['ffn1_w_gate'] = normal((L, D_MODEL, D_FF), D_MODEL ** -0.5)
    inp['ffn1_w_up'] = normal((L, D_MODEL, D_FF), D_MODEL ** -0.5)
    inp['ffn1_w_down'] = normal((L, D_FF, D_MODEL), DEEPNORM_BETA * D_FF ** -0.5)
    inp['ln1_g'] = 1.0 + normal((L, D_MODEL), 0.02)
    inp['ln1_b'] = normal((L, D_MODEL), 0.02)
    inp['w_in'] = normal((L, D_MODEL, D_IN_PROJ), D_MODEL ** -0.5)
    n_idx = jnp.arange(S5_STATE, dtype=jnp.float32)
    inp['s5_lambda_re'] = -0.5 + normal((L, S5_GROUPS, S5_STATE), 0.01)
    inp['s5_lambda_im'] = math.pi * n_idx + normal((L, S5_GROUPS, S5_STATE), 0.01)
    inp['s5_b_re'] = normal((L, S5_GROUPS, S5_STATE, S5_GROUP), (2.0 * S5_GROUP) ** -0.5)
    inp['s5_b_im'] = normal((L, S5_GROUPS, S5_STATE, S5_GROUP), (2.0 * S5_GROUP) ** -0.5)
    inp['s5_c_re'] = normal((L, S5_GROUPS, S5_GROUP, S5_STATE), S5_STATE ** -0.5)
    inp['s5_c_im'] = normal((L, S5_GROUPS, S5_GROUP, S5_STATE), S5_STATE ** -0.5)
    inp['s5_d'] = normal((L, S5_WIDTH), 1.0)
    inp['s5_log_step'] = uniform((L, S5_GROUPS), math.log(S5_DT_MIN), math.log(S5_DT_MAX))
    inp['s5_w_glu'] = normal((L, S5_WIDTH, S5_WIDTH), S5_WIDTH ** -0.5)
    inp['s5_b_glu'] = normal((L, S5_WIDTH), 0.02)
    inp['gdn_conv_w'] = normal((L, CONV_WIDTH, 3 * GDN_WIDTH), CONV_WIDTH ** -0.5)
    inp['gdn_a_log'] = jnp.log(uniform((L, GDN_HEADS), 1.0, 16.0))
    dt = jnp.exp(uniform((L, GDN_HEADS), math.log(1e-3), math.log(1e-1)))
    inp['gdn_dt_bias'] = dt + jnp.log(-jnp.expm1(-dt))
    inp['gdn_norm_g'] = 1.0 + normal((L, GDN_HEAD_DIM), 0.02)
    inp['lru_conv_w'] = normal((L, CONV_WIDTH, LRU_WIDTH), CONV_WIDTH ** -0.5)
    inp['lru_conv_b'] = normal((L, LRU_WIDTH), 0.02)
    inp['lru_w_a'] = normal((L, LRU_BLOCKS, LRU_BLOCK, LRU_BLOCK), LRU_BLOCK ** -0.5)
    inp['lru_b_a'] = normal((L, LRU_WIDTH), 0.02)
    inp['lru_w_x'] = normal((L, LRU_BLOCKS, LRU_BLOCK, LRU_BLOCK), LRU_BLOCK ** -0.5)
    inp['lru_b_x'] = normal((L, LRU_WIDTH), 0.02)
    a0 = uniform((L, LRU_WIDTH), 0.9, 0.999) ** (1.0 / LRU_C)
    inp['lru_lambda'] = jnp.log(a0) - jnp.log1p(-a0)
    inp['w_out'] = normal((L, D_MIX, D_MODEL), DEEPNORM_BETA * D_MIX ** -0.5)
    inp['ln2_g'] = 1.0 + normal((L, D_MODEL), 0.02)
    inp['ln2_b'] = normal((L, D_MODEL), 0.02)
    inp['ffn2_w_gate'] = normal((L, D_MODEL, D_FF), D_MODEL ** -0.5)
    inp['ffn2_w_up'] = normal((L, D_MODEL, D_FF), D_MODEL ** -0.5)
    inp['ffn2_w_down'] = normal((L, D_FF, D_MODEL), DEEPNORM_BETA * D_FF ** -0.5)
    inp['ln3_g'] = 1.0 + normal((L, D_MODEL), 0.02)
    inp['ln3_b'] = normal((L, D_MODEL), 0.02)
    return inp


def reference(x, ffn1_w_gate, ffn1_w_up, ffn1_w_down, ln1_g, ln1_b, w_in,
              s5_lambda_re, s5_lambda_im, s5_b_re, s5_b_im, s5_c_re, s5_c_im, s5_d, s5_log_step,
              s5_w_glu, s5_b_glu, gdn_conv_w, gdn_a_log, gdn_dt_bias, gdn_norm_g,
              lru_conv_w, lru_conv_b, lru_w_a, lru_b_a, lru_w_x, lru_b_x, lru_lambda,
              w_out, ln2_g, ln2_b, ffn2_w_gate, ffn2_w_up, ffn2_w_down, ln3_g, ln3_b):
    split_points = []
    acc = 0
    for size in IN_SPLITS[:-1]:
        acc += size
        split_points.append(acc)
    for l in range(DEPTH):
        x = layer_norm(DEEPNORM_ALPHA * x + MACARON_WEIGHT * swiglu(x, ffn1_w_gate[l], ffn1_w_up[l], ffn1_w_down[l]),
                       ln1_g[l], ln1_b[l])
        proj = x @ w_in[l]
        s5_u, gdn_qkv, gdn_z, gdn_a, gdn_b, lru_x, lru_gate = jnp.split(proj, split_points, axis=-1)
        y_s5 = s5_mixer(s5_u, s5_lambda_re[l], s5_lambda_im[l], s5_b_re[l], s5_b_im[l], s5_c_re[l], s5_c_im[l],
                        s5_d[l], s5_log_step[l], s5_w_glu[l], s5_b_glu[l])
        y_gdn = gdn_mixer(gdn_qkv, gdn_z, gdn_a, gdn_b, gdn_conv_w[l], gdn_a_log[l], gdn_dt_bias[l], gdn_norm_g[l])
        y_lru = rglru_mixer(lru_x, lru_gate, lru_conv_w[l], lru_conv_b[l], lru_w_a[l], lru_b_a[l],
                            lru_w_x[l], lru_b_x[l], lru_lambda[l])
        mixed = jnp.concatenate([y_s5, y_gdn, y_lru], axis=-1) @ w_out[l]
        x = layer_norm(DEEPNORM_ALPHA * x + mixed.astype(x.dtype), ln2_g[l], ln2_b[l])
        x = layer_norm(DEEPNORM_ALPHA * x + MACARON_WEIGHT * swiglu(x, ffn2_w_gate[l], ffn2_w_up[l], ffn2_w_down[l]),
                       ln3_g[l], ln3_b[l])
    return x
```

```cpp
#include <hip/hip_runtime.h>
#include <cstdio>
#include <cstdint>

#define LAS __attribute__((address_space(3)))
#define GAS __attribute__((address_space(1)))
typedef unsigned short bf16_t;
typedef short bf16x8 __attribute__((ext_vector_type(8)));
typedef float f32x4 __attribute__((ext_vector_type(4)));
typedef float f32x2 __attribute__((ext_vector_type(2)));
typedef unsigned u32x4 __attribute__((ext_vector_type(4)));
typedef unsigned u32x2 __attribute__((ext_vector_type(2)));

constexpr int D_MODEL = 2048, BATCH = 2, SEQ = 8192, DEPTH = 4, M_TOK = BATCH * SEQ;
constexpr int D_FF = 5632, S5_W = 512, S5_G = 32, S5_P = 16, S5_N = 64;
constexpr int GDN_W = 1024, GDN_H = 8, GDN_D = 128, CH = 64, NCH = SEQ / CH  , NCHT = BATCH * NCH  ;
constexpr int LRU_W = 512;
constexpr int D_IN = 5648;
constexpr int N_IN_PAD = 5888;
constexpr float LN_EPS = 1e-5f, RMS_EPS = 1e-6f;
constexpr float DN_ALPHA = 1.6817928305074290f;

__device__ __forceinline__ unsigned cvt_pk_bf16(float lo, float hi) { unsigned r; asm volatile("v_cvt_pk_bf16_f32 %0, %1, %2" : "=v"(r) : "v"(lo), "v"(hi)); return r; }
__device__ __forceinline__ unsigned f2bf(float f) { unsigned u = __builtin_bit_cast(unsigned, f); return (u + 0x7fffu + ((u >> 16) & 1u)) >> 16; }
__device__ __forceinline__ float bf2f(unsigned h) { return __builtin_bit_cast(float, h << 16); }
__device__ __forceinline__ float bflo(unsigned w) { return __builtin_bit_cast(float, w << 16); }
__device__ __forceinline__ float bfhi(unsigned w) { return __builtin_bit_cast(float, w & 0xffff0000u); }
__device__ __forceinline__ float rcpf_(float x) { return __builtin_amdgcn_rcpf(x); }
__device__ __forceinline__ float rsqf_(float x) { return __builtin_amdgcn_rsqf(x); }
__device__ __forceinline__ float sqrtf_(float x) { return __builtin_amdgcn_sqrtf(x); }
__device__ __forceinline__ float sigmoidf_(float x) { return rcpf_(1.0f + __expf(-x)); }
__device__ __forceinline__ float siluf_(float x) { return x * rcpf_(1.0f + __expf(-x)); }
__device__ __forceinline__ float gelu_tanh(float x) { const float u = 0.7978845608028654f * (x + 0.044715f * x * x * x); return x * rcpf_(1.0f + __expf(-2.0f * u)); }
__device__ __forceinline__ float log1p_small(float e) { return e < 0.01f ? e * (1.0f - e * (0.5f - e * (1.0f / 3.0f))) : __logf(1.0f + e); }
__device__ __forceinline__ float softplusf_(float x) { return fmaxf(x, 0.f) + log1p_small(__expf(-fabsf(x))); }
__device__ __forceinline__ float expm1_neg(float z) {
    return fabsf(z) < 0.1f ? z * (1.0f + z * (0.5f + z * ((1.0f / 6.0f) + z * ((1.0f / 24.0f) + z * (1.0f / 120.0f))))) : __expf(z) - 1.0f; }
__device__ __forceinline__ float wave_sum(float v) {
#pragma unroll
    for (int o = 1; o < 64; o <<= 1) v += __shfl_xor(v, o);
    return v;
}

namespace pg8 {
constexpr int BM = 256, BK = 64, HALF = 128, HTB = HALF * BK * 2, STAGE_BYTES = 8 * HTB, NXCD = 8, WGM = 8;
__host__ __device__ __forceinline__ int lds_byte(int r, int c) { const int st = (r >> 4) * 2 + (c >> 5), rr = r & 15, cc = c & 31, ob = rr * 64 + cc * 2; return st * 1024 + (ob ^ (((ob >> 9) & 1) << 5)); }
__host__ __device__ __forceinline__ void stage_rc(int b, int& R, int& C) { const int st = b / 1024, sb = b % 1024, swz = sb ^ (((sb >> 9) & 1) << 5); R = (st >> 1) * 16 + swz / 64; C = (st & 1) * 32 + (swz % 64) / 2; }
__host__ __device__ __forceinline__ int perm32(int rho) { const int n = rho >> 4, i = rho & 15; return 8 * (i >> 2) + 4 * n + (i & 3); }

struct Unit { int pm, pn; };

struct GeoStd {
    const char* A; const char* B; int lda, ldb, K;
    __device__ __forceinline__ int nt() const { return K / BK; }
    __device__ __forceinline__ int a_voff(int R, int C) const { return (R * lda + C) * 2; }
    __device__ __forceinline__ int b_voff(int R, int C) const { return (R * ldb + C) * 2; }
    __device__ __forceinline__ long a_hstep() const { return (long)HALF * lda * 2; }
    __device__ __forceinline__ long b_hstep() const { return (long)HALF * ldb * 2; }
    __device__ __forceinline__ const char* a_base(const Unit& u) const { return A + (size_t)u.pm * BM * lda * 2; }
    __device__ __forceinline__ const char* b_base(const Unit& u) const { return B + (size_t)u.pn * BM * ldb * 2; }
};

struct StaticOrder {
    int nM, nN, nwg, G, c;
    __device__ void init(int M, int N, int G_, int c_) { nM = M / BM; nN = N / BM; nwg = nM * nN; G = G_; c = c_; }
    __device__ bool next(int i, Unit& u) const {
        if (c < 0) return false;
        const long L = (long)i * G + c; if (L >= nwg) return false;
        int wgid = (int)L; { const int q = nwg / NXCD, r = nwg % NXCD, xcd = wgid % NXCD, off = wgid / NXCD; wgid = (xcd < r ? xcd * (q + 1) : r * (q + 1) + (xcd - r) * q) + off; }
        const int nig = WGM * nN, gid = wgid / nig, fm = gid * WGM, gsz = (nM - fm) < WGM ? (nM - fm) : WGM;
        u.pm = fm + ((wgid % nig) % gsz); u.pn = (wgid % nig) / gsz; return true;
    }
};
struct GroupOrder {
    int nunits, per, G, c;
    __device__ bool next(int i, Unit& u) const { if (c < 0) return false; const long L = (long)i * G + c; if (L >= nunits) return false; u.pm = (int)L / per; u.pn = (int)L % per; return true; }
};

template <class Geo, class Epi, class Sched, bool ALIGN_EPI>
__device__ __forceinline__ void gemm_phase(LAS unsigned char* lds, int wave_id, const Geo& g, const Sched& S, const Epi& E) {
    int tid = threadIdx.x; asm volatile("" : "+v"(tid));
    const int wid = __builtin_amdgcn_readfirstlane(tid >> 6), lane = tid & 63, wr = wid >> 2, wc = wid & 3, fr = lane & 15, fq = lane >> 4;
    const int nt = g.nt();
    int voffA[2], voffB[2];
#pragma unroll
    for (int i = 0; i < 2; ++i) { int R, C; stage_rc(tid * 16 + i * 8192, R, C); const int Rb = Epi::PERM ? ((R & ~31) + perm32(R & 31)) : R;
        voffA[i] = g.a_voff(R, C); voffB[i] = g.b_voff(Rb, C); }
    const long kstep = (long)(BK * 2);
    const long hstepA = g.a_hstep(), hstepB = g.b_hstep();
    const unsigned ldsw = (unsigned)wid * 1024u;
    const int aoff = lds_byte(wr * 64 + fr, fq * 8), boff = lds_byte(wc * 32 + fr, fq * 8);
#define PG8_SA(b, h) (((b) * 2 + (h)) * HTB)
#define PG8_SB(b, h) ((4 + (b) * 2 + (h)) * HTB)
#define PG8_STAGE(bufoff, gbase, voff) do { _Pragma("unroll") for (int _i = 0; _i < 2; ++_i) \
        __builtin_amdgcn_global_load_lds((const unsigned*)((const char*)(gbase) + (voff)[_i]), (LAS unsigned*)(lds + (bufoff) + ldsw + _i * 8192), 16, 0, 0); } while (0)
#define PG8_LDA(dst, b, h) do { _Pragma("unroll") for (int m = 0; m < 4; ++m) _Pragma("unroll") for (int k = 0; k < 2; ++k) dst[m][k] = *(const LAS bf16x8*)(lds + PG8_SA(b, h) + aoff + m * 2048 + k * 1024); } while (0)
#define PG8_LDB(dst, b, h) do { _Pragma("unroll") for (int n = 0; n < 2; ++n) _Pragma("unroll") for (int k = 0; k < 2; ++k) dst[n][k] = *(const LAS bf16x8*)(lds + PG8_SB(b, h) + boff + n * 2048 + k * 1024); } while (0)
#define PG8_MMA(ai, bj, At, Bt) do { __builtin_amdgcn_s_setprio(1); _Pragma("unroll") for (int m = 0; m < 4; ++m) _Pragma("unroll") for (int n = 0; n < 2; ++n) _Pragma("unroll") for (int k = 0; k < 2; ++k) \
        acc[ai][bj][m][n] = __builtin_amdgcn_mfma_f32_16x16x32_bf16(Bt[n][k], At[m][k], acc[ai][bj][m][n], 0, 0, 0); __builtin_amdgcn_s_setprio(0); } while (0)
#define PG8_WAIT_V(n) asm volatile("s_waitcnt vmcnt(" #n ")" ::: "memory")
#define PG8_WAIT_L(n) asm volatile("s_waitcnt lgkmcnt(" #n ")" ::: "memory")
#define PG8_BAR __builtin_amdgcn_s_barrier()
#define PG8_SCHED __builtin_amdgcn_sched_barrier(0)
    Unit cur, nxt; int ui = 0;
    if (!S.next(0, cur)) return;
    f32x4 acc[2][2][4][2];
#pragma unroll
    for (int a = 0; a < 2; ++a)
#pragma unroll
        for (int b = 0; b < 2; ++b)
#pragma unroll
            for (int m = 0; m < 4; ++m)
#pragma unroll
                for (int n = 0; n < 2; ++n) acc[a][b][m][n] = (f32x4){0.f, 0.f, 0.f, 0.f};
    bf16x8 At[4][2], B0[2][2], B1[2][2];
    const char* cA = g.a_base(cur); const char* cB = g.b_base(cur);
    PG8_STAGE(PG8_SB(0, 0), cB, voffB); PG8_STAGE(PG8_SB(0, 1), cB + hstepB, voffB); PG8_STAGE(PG8_SA(0, 0), cA, voffA); PG8_STAGE(PG8_SA(0, 1), cA + hstepA, voffA);
    if (wr == 1) PG8_BAR;
    PG8_WAIT_V(2); PG8_BAR;
    PG8_STAGE(PG8_SB(1, 0), cB + kstep, voffB); PG8_STAGE(PG8_SA(1, 0), cA + kstep, voffA); PG8_STAGE(PG8_SB(1, 1), cB + hstepB + kstep, voffB);
    PG8_WAIT_V(6); PG8_BAR;
    for (;;) {
        const bool has_next = S.next(ui + 1, nxt);
        const char* nA = has_next ? g.a_base(nxt) : cA; const char* nB = has_next ? g.b_base(nxt) : cB;
        for (int t = 0; t < nt; t += 2) {
            const bool last = (t == nt - 2);
            const char* a1 = cA + (long)(t + 1) * kstep;
            const char* a2 = last ? nA : cA + (long)(t + 2) * kstep; const char* b2 = last ? nB : cB + (long)(t + 2) * kstep;
            const char* a3 = a2 + kstep; const char* b3 = b2 + kstep;
            PG8_LDB(B0, 0, 0); PG8_LDB(B1, 0, 1); PG8_SCHED; PG8_LDA(At, 0, 0); PG8_STAGE(PG8_SA(1, 1), a1 + hstepA, voffA);
            PG8_WAIT_V(8); PG8_WAIT_L(0); PG8_BAR; PG8_MMA(0, 0, At, B0); PG8_MMA(0, 1, At, B1); PG8_BAR; PG8_SCHED;
            PG8_LDA(At, 0, 1); PG8_STAGE(PG8_SB(0, 0), b2, voffB); PG8_STAGE(PG8_SB(0, 1), b2 + hstepB, voffB); PG8_STAGE(PG8_SA(0, 0), a2, voffA);
            PG8_WAIT_V(8); PG8_WAIT_L(0); PG8_BAR; PG8_MMA(1, 0, At, B0); PG8_MMA(1, 1, At, B1); PG8_BAR; PG8_SCHED;
            PG8_LDB(B0, 1, 0); PG8_LDB(B1, 1, 1); PG8_SCHED; PG8_LDA(At, 1, 0); PG8_STAGE(PG8_SA(0, 1), a2 + hstepA, voffA);
            PG8_WAIT_V(8); PG8_WAIT_L(0); PG8_BAR; PG8_MMA(0, 0, At, B0); PG8_MMA(0, 1, At, B1); PG8_BAR; PG8_SCHED;
            PG8_LDA(At, 1, 1); PG8_STAGE(PG8_SB(1, 0), b3, voffB); PG8_STAGE(PG8_SB(1, 1), b3 + hstepB, voffB); PG8_STAGE(PG8_SA(1, 0), a3, voffA);
            PG8_WAIT_V(8); PG8_WAIT_L(0); PG8_BAR; PG8_MMA(1, 0, At, B0); PG8_MMA(1, 1, At, B1); PG8_BAR; PG8_SCHED;
        }
        if constexpr (ALIGN_EPI) { if (wr == 0) PG8_BAR; }
        {
            Unit ue = cur; int fr_e = fr, fq_e = fq; asm volatile("" : "+s"(ue.pm), "+s"(ue.pn), "+v"(fr_e), "+v"(fq_e));
            E(acc, ue, wr, wc, fr_e, fq_e); }
        if (!has_next) break;
#pragma unroll
        for (int a = 0; a < 2; ++a)
#pragma unroll
            for (int b = 0; b < 2; ++b)
#pragma unroll
                for (int m = 0; m < 4; ++m)
#pragma unroll
                    for (int n = 0; n < 2; ++n) acc[a][b][m][n] = (f32x4){0.f, 0.f, 0.f, 0.f};
        cur = nxt; cA = nA; cB = nB; ++ui;
        if constexpr (ALIGN_EPI) { if (wr == 1) PG8_BAR; }
    }
    PG8_WAIT_V(0);
    if constexpr (!ALIGN_EPI) { if (wr == 0) PG8_BAR; }
    PG8_BAR;
#undef PG8_SA
#undef PG8_SB
#undef PG8_STAGE
#undef PG8_LDA
#undef PG8_LDB
#undef PG8_MMA
#undef PG8_WAIT_V
#undef PG8_WAIT_L
#undef PG8_BAR
#undef PG8_SCHED
}
}

using pg8::Unit;
struct EpiSwiGLU {
    static constexpr bool PERM = true;
    bf16_t* H;
    __device__ __forceinline__ void operator()(const f32x4 (&acc)[2][2][4][2], const Unit& u, int wr, int wc, int fr, int fq) const {
        const int row0 = u.pm * 256 + wr * 64 + fr, col0 = u.pn * 128 + wc * 32 + 8 * fq;
#pragma unroll
        for (int ai = 0; ai < 2; ++ai)
#pragma unroll
            for (int m = 0; m < 4; ++m) {
                bf16_t* rowp = H + (size_t)(row0 + ai * 128 + m * 16) * D_FF + col0;
                const f32x4 g0 = acc[ai][0][m][0], g1 = acc[ai][0][m][1], u0 = acc[ai][1][m][0], u1 = acc[ai][1][m][1];
                u32x4 w;
                w.x = cvt_pk_bf16(siluf_(g0[0]) * u0[0], siluf_(g0[1]) * u0[1]); w.y = cvt_pk_bf16(siluf_(g0[2]) * u0[2], siluf_(g0[3]) * u0[3]);
                w.z = cvt_pk_bf16(siluf_(g1[0]) * u1[0], siluf_(g1[1]) * u1[1]); w.w = cvt_pk_bf16(siluf_(g1[2]) * u1[2], siluf_(g1[3]) * u1[3]);
                *(u32x4*)rowp = w;
            }
    }
};
struct EpiResid {
    static constexpr bool PERM = false;
    const float* res; float* out; float scale;
    __device__ __forceinline__ void operator()(const f32x4 (&acc)[2][2][4][2], const Unit& u, int wr, int wc, int fr, int fq) const {
        const int row0 = u.pm * 256 + wr * 64 + fr, col0 = u.pn * 256 + wc * 32 + 4 * fq;
#pragma unroll
        for (int ai = 0; ai < 2; ++ai)
#pragma unroll
            for (int m = 0; m < 4; ++m) {
                const size_t off = (size_t)(row0 + ai * 128 + m * 16) * D_MODEL + col0;
#pragma unroll
                for (int bj = 0; bj < 2; ++bj)
#pragma unroll
                    for (int n = 0; n < 2; ++n) { const f32x4 r = *(const f32x4*)(res + off + bj * 128 + n * 16); *(f32x4*)(out + off + bj * 128 + n * 16) = r * DN_ALPHA + acc[ai][bj][m][n] * scale; }
            }
    }
};
struct EpiInproj {
    static constexpr bool PERM = true;
    bf16_t *U5, *QKV, *Z, *LX, *LG; float* AB;
    __device__ __forceinline__ void operator()(const f32x4 (&acc)[2][2][4][2], const Unit& u, int wr, int wc, int fr, int fq) const {
        const int row0 = u.pm * 256 + wr * 64 + fr;
        const int pn = u.pn;
#pragma unroll
        for (int ai = 0; ai < 2; ++ai)
#pragma unroll
            for (int m = 0; m < 4; ++m) {
                const int row = row0 + ai * 128 + m * 16;
#pragma unroll
                for (int bj = 0; bj < 2; ++bj) {
                    const int c = pn * 256 + bj * 128 + wc * 32 + 8 * fq;
                    const f32x4 v0 = acc[ai][bj][m][0], v1 = acc[ai][bj][m][1];
                    if (pn == 22) {
                        if (bj == 0 && wc == 0 && fq < 2) { float* p = AB + (size_t)row * 16 + 8 * fq; *(f32x4*)p = v0; *(f32x4*)(p + 4) = v1; }
                    } else {
                        u32x4 w; w.x = cvt_pk_bf16(v0[0], v0[1]); w.y = cvt_pk_bf16(v0[2], v0[3]); w.z = cvt_pk_bf16(v1[0], v1[1]); w.w = cvt_pk_bf16(v1[2], v1[3]);
                        bf16_t* p;
                        if (pn < 2) { const int g = c >> 4, hf = c & 8; p = U5 + ((size_t)g * M_TOK + row) * 16 + hf; }
                        else if (pn < 14) p = QKV + (size_t)row * 3072 + (c - 512);
                        else if (pn < 18) p = Z + (size_t)row * 1024 + (c - 3584);
                        else if (pn < 20) p = LX + (size_t)row * 512 + (c - 4608);
                        else p = LG + (size_t)row * 512 + (c - 5120);
                        *(u32x4*)p = w;
                    }
                }
            }
    }
};
struct EpiS5S {
    static constexpr bool PERM = false;
    float* S;
    __device__ __forceinline__ void operator()(const f32x4 (&acc)[2][2][4][2], const Unit& u, int wr, int wc, int fr, int fq) const {
        const int g = u.pm, row0 = wr * 64 + fr, col0 = wc * 32 + 4 * fq;
#pragma unroll
        for (int ai = 0; ai < 2; ++ai)
#pragma unroll
            for (int m = 0; m < 4; ++m) { float* p = S + ((size_t)g * NCHT + row0 + ai * 128 + m * 16) * 128 + col0;
#pragma unroll
                for (int n = 0; n < 2; ++n) *(f32x4*)(p + n * 16) = acc[ai][0][m][n]; }
    }
};
struct EpiS5Intra {
    static constexpr bool PERM = false;
    float* Y;
    __device__ __forceinline__ void operator()(const f32x4 (&acc)[2][2][4][2], const Unit& u, int wr, int wc, int fr, int fq) const {
        const int g = u.pm, j = u.pn, row0 = wr * 64 + fr;
#pragma unroll
        for (int ai = 0; ai < 2; ++ai)
#pragma unroll
            for (int m = 0; m < 4; ++m) { const int bc = row0 + ai * 128 + m * 16;
#pragma unroll
                for (int bj = 0; bj < 2; ++bj)
#pragma unroll
                    for (int n = 0; n < 2; ++n) { const int col = j * 256 + bj * 128 + wc * 32 + 16 * n + 4 * fq, t = col >> 4, p = col & 15;
                        *(f32x4*)(Y + ((size_t)bc * CH + t) * S5_W + g * 16 + p) = acc[ai][bj][m][n]; }
            }
    }
};
struct EpiS5Inter {
    static constexpr bool PERM = false;
    const float* Y; const bf16_t* U5; const float* dvec; bf16_t* YACT;
    __device__ __forceinline__ void operator()(const f32x4 (&acc)[2][2][4][2], const Unit& u, int wr, int wc, int fr, int fq) const {
        const int g = u.pm, j = u.pn, row0 = wr * 64 + fr;
#pragma unroll
        for (int ai = 0; ai < 2; ++ai)
#pragma unroll
            for (int m = 0; m < 4; ++m) { const int bc = row0 + ai * 128 + m * 16;
#pragma unroll
                for (int bj = 0; bj < 2; ++bj)
#pragma unroll
                    for (int n = 0; n < 2; ++n) { const int col = j * 256 + bj * 128 + wc * 32 + 16 * n + 4 * fq, t = col >> 4, p = col & 15;
                        const size_t tok = (size_t)bc * CH + t; const int ch = g * 16 + p;
                        const f32x4 y0 = *(const f32x4*)(Y + tok * S5_W + ch);
                        const u32x2 uu = *(const u32x2*)(U5 + ((size_t)g * M_TOK + tok) * 16 + p);
                        const f32x4 d0 = *(const f32x4*)(dvec + ch);
                        const f32x4 a0 = acc[ai][bj][m][n];
                        const float o0 = gelu_tanh(a0[0] + y0[0] + d0[0] * bflo(uu.x)), o1 = gelu_tanh(a0[1] + y0[1] + d0[1] * bfhi(uu.x));
                        const float o2 = gelu_tanh(a0[2] + y0[2] + d0[2] * bflo(uu.y)), o3 = gelu_tanh(a0[3] + y0[3] + d0[3] * bfhi(uu.y));
                        u32x2 w; w.x = cvt_pk_bf16(o0, o1); w.y = cvt_pk_bf16(o2, o3);
                        *(u32x2*)(YACT + tok * S5_W + ch) = w; }
                asm volatile("" ::: "memory");
            }
    }
};
struct EpiGLU {
    static constexpr bool PERM = true;
    const bf16_t* YACT; const float* bglu; bf16_t* CAT;
    __device__ __forceinline__ void operator()(const f32x4 (&acc)[2][2][4][2], const Unit& u, int wr, int wc, int fr, int fq) const {
        const int row0 = u.pm * 256 + wr * 64 + fr;
#pragma unroll
        for (int ai = 0; ai < 2; ++ai)
#pragma unroll
            for (int m = 0; m < 4; ++m) { const size_t row = (size_t)(row0 + ai * 128 + m * 16);
#pragma unroll
                for (int bj = 0; bj < 2; ++bj) { const int col = u.pn * 256 + bj * 128 + wc * 32 + 8 * fq;
                    const u32x4 yy = *(const u32x4*)(YACT + row * S5_W + col);
                    const f32x4 b0 = *(const f32x4*)(bglu + col), b1 = *(const f32x4*)(bglu + col + 4);
                    const f32x4 a0 = acc[ai][bj][m][0] + b0, a1 = acc[ai][bj][m][1] + b1;
                    u32x4 w;
                    w.x = cvt_pk_bf16(bflo(yy.x) * sigmoidf_(a0[0]), bfhi(yy.x) * sigmoidf_(a0[1])); w.y = cvt_pk_bf16(bflo(yy.y) * sigmoidf_(a0[2]), bfhi(yy.y) * sigmoidf_(a0[3]));
                    w.z = cvt_pk_bf16(bflo(yy.z) * sigmoidf_(a1[0]), bfhi(yy.z) * sigmoidf_(a1[1])); w.w = cvt_pk_bf16(bflo(yy.w) * sigmoidf_(a1[2]), bfhi(yy.w) * sigmoidf_(a1[3]));
                    *(u32x4*)(CAT + row * D_MODEL + col) = w; }
            }
    }
};
struct EpiLRU {
    static constexpr bool PERM = true;
    const bf16_t* XC; const float *ba, *bx, *lam; float *LA, *LB;
    __device__ __forceinline__ void operator()(const f32x4 (&acc)[2][2][4][2], const Unit& u, int wr, int wc, int fr, int fq) const {
        const int row0 = u.pm * 256 + wr * 64 + fr, ch = u.pn * 128 + wc * 32 + 8 * fq;
        float sp[8], bav[8], bxv[8];
#pragma unroll
        for (int e = 0; e < 8; ++e) { sp[e] = -8.0f * softplusf_(-lam[ch + e]); bav[e] = ba[ch + e]; bxv[e] = bx[ch + e]; }
#pragma unroll
        for (int ai = 0; ai < 2; ++ai)
#pragma unroll
            for (int m = 0; m < 4; ++m) { const size_t row = (size_t)(row0 + ai * 128 + m * 16);
                const u32x4 xx = *(const u32x4*)(XC + row * LRU_W + ch);
                float xc[8] = {bflo(xx.x), bfhi(xx.x), bflo(xx.y), bfhi(xx.y), bflo(xx.z), bfhi(xx.z), bflo(xx.w), bfhi(xx.w)};
                float av[8], bv[8];
#pragma unroll
                for (int e = 0; e < 8; ++e) { const float ra = acc[ai][0][m][e >> 2][e & 3] + bav[e], rx = acc[ai][1][m][e >> 2][e & 3] + bxv[e];
                    const float r = sigmoidf_(ra), ig = sigmoidf_(rx), la = sp[e] * r; av[e] = __expf(la); bv[e] = sqrtf_(fmaxf(-expm1_neg(2.0f * la), 0.f)) * (ig * xc[e]); }
                *(f32x4*)(LA + row * LRU_W + ch) = (f32x4){av[0], av[1], av[2], av[3]}; *(f32x4*)(LA + row * LRU_W + ch + 4) = (f32x4){av[4], av[5], av[6], av[7]};
                *(f32x4*)(LB + row * LRU_W + ch) = (f32x4){bv[0], bv[1], bv[2], bv[3]}; *(f32x4*)(LB + row * LRU_W + ch + 4) = (f32x4){bv[4], bv[5], bv[6], bv[7]};
            }
    }
};

#define XB_TMO      128
#define XB_XCNT(j)  (256  + 64 * (j))
#define XB_XSUB(j)  (1280 + 64 * (j))
#define XB_XGEN(j)  (2304 + 64 * (j))
#define XB_TOP      3328
#define XB_TOPGEN   3392
#define XCD_BAR_WORDS 3456
#define XB_SPIN_CAP (1u << 22)
__device__ __forceinline__ unsigned xb_ld(unsigned* p)              { return __hip_atomic_load(p, __ATOMIC_RELAXED, __HIP_MEMORY_SCOPE_AGENT); }
__device__ __forceinline__ unsigned xb_add(unsigned* p, unsigned v) { return __hip_atomic_fetch_add(p, v, __ATOMIC_RELAXED, __HIP_MEMORY_SCOPE_AGENT); }
__device__ __forceinline__ unsigned xb_xcc_id() { return (unsigned)__builtin_amdgcn_s_getreg((3 << 11) | 20) & 0xFu; }
#define XB_SPIN(cond, bar) do { unsigned _sp = 0; while (cond) { __builtin_amdgcn_s_sleep(1); \
    if ((++_sp & 255u) == 0u) { if (xb_ld(&(bar)[XB_TMO])) break; if (_sp > XB_SPIN_CAP) { atomicAdd(&(bar)[XB_TMO], 1u); break; } } } } while (0)
struct XcdBarrier { unsigned* bar; unsigned x; volatile LAS unsigned* st; };
__device__ __forceinline__ XcdBarrier xcd_barrier_post(unsigned* bar, volatile LAS unsigned* st) {
    XcdBarrier b; b.bar = bar; b.x = xb_xcc_id(); b.st = st;
    if (threadIdx.x == 0) (void)xb_add(&bar[XB_XCNT(b.x)], 1u);
    return b;
}
__device__ __forceinline__ void xcd_barrier_complete(unsigned* bar, unsigned x, unsigned& nloc, unsigned& nx) {
    const unsigned G = gridDim.x * gridDim.y * gridDim.z;
    unsigned sum, cnt, mine, sp = 0u;
    for (;;) {
        sum = 0u; cnt = 0u; mine = 0u;
#pragma unroll
        for (unsigned j = 0; j < 16; ++j) { const unsigned c = xb_ld(&bar[XB_XCNT(j)]); sum += c; cnt += (c > 0u) ? 1u : 0u; mine = (j == x) ? c : mine; }
        if (sum == G) break;
        __builtin_amdgcn_s_sleep(1);
        if ((++sp & 255u) == 0u) { if (xb_ld(&bar[XB_TMO])) break; if (sp > XB_SPIN_CAP) { atomicAdd(&bar[XB_TMO], 1u); break; } }
    }
    nloc = mine > 0u ? mine : 1u; nx = cnt > 0u ? cnt : 1u;
}
__device__ __forceinline__ void xcd_barrier(const XcdBarrier& b) {
    asm volatile("s_waitcnt vmcnt(0)" ::: "memory");
    __syncthreads();
    if (threadIdx.x == 0) {
        unsigned* bar = b.bar; unsigned bx = b.x;
        __builtin_amdgcn_s_waitcnt(0);
        unsigned nloc = b.st[0], nx = b.st[1];
        if (nloc == 0u) { xcd_barrier_complete(bar, bx, nloc, nx); b.st[0] = nloc; b.st[1] = nx; }
        const unsigned old = xb_add(&bar[XB_XSUB(bx)], 1u);
        const unsigned gen = old / nloc;
        if (old + 1u == (gen + 1u) * nloc) {
            __builtin_amdgcn_fence(__ATOMIC_RELEASE, "agent");
            asm volatile("s_waitcnt vmcnt(0)" ::: "memory");
            const unsigned og = xb_add(&bar[XB_TOP], 1u);
            const unsigned tg = og / nx;
            if (og + 1u == (tg + 1u) * nx) xb_add(&bar[XB_TOPGEN], 1u);
            else XB_SPIN(xb_ld(&bar[XB_TOPGEN]) == tg, bar);
            __builtin_amdgcn_fence(__ATOMIC_ACQUIRE, "agent");
            xb_add(&bar[XB_XGEN(bx)], 1u);
            asm volatile("s_waitcnt vmcnt(0)" ::: "memory");
        } else {
            XB_SPIN(xb_ld(&bar[XB_XGEN(bx)]) == gen, bar);
            __builtin_amdgcn_fence(__ATOMIC_ACQUIRE, "agent");
            asm volatile("s_waitcnt vmcnt(0)" ::: "memory");
        }
    }
    __syncthreads();
}

constexpr size_t al256(size_t x) { return (x + 255) & ~(size_t)255; }
constexpr size_t WS_CTL = 0, CTL_BYTES = 1u << 20;
constexpr size_t SZ_WGU = (size_t)2 * D_FF * D_MODEL * 2, SZ_WD = (size_t)D_MODEL * D_FF * 2, SZ_WIN = (size_t)N_IN_PAD * D_MODEL * 2, SZ_WOUT = (size_t)D_MODEL * D_MODEL * 2;
constexpr size_t WS_WGU1 = WS_CTL + CTL_BYTES, WS_WGU2 = WS_WGU1 + SZ_WGU, WS_WD1 = WS_WGU2 + SZ_WGU, WS_WD2 = WS_WD1 + SZ_WD, WS_WIN = WS_WD2 + SZ_WD, WS_WOUT = WS_WIN + SZ_WIN;
constexpr size_t WS_WGLU = WS_WOUT + SZ_WOUT, WS_WLRU = WS_WGLU + (size_t)512 * 512 * 2;
constexpr size_t WS_KTAB = WS_WLRU + (size_t)1024 * 512 * 2;
constexpr size_t WS_PTAB = WS_KTAB + (size_t)32 * 16 * 128 * 16 * 2;
constexpr size_t WS_QTAB = WS_PTAB + (size_t)32 * 256 * 1024 * 2;
constexpr size_t WS_XN = WS_QTAB + (size_t)32 * 1024 * 256 * 2;
constexpr size_t WS_H = WS_XN + (size_t)M_TOK * D_MODEL * 2;
constexpr size_t WS_U5 = WS_H + (size_t)M_TOK * D_FF * 2;
constexpr size_t WS_QKV = WS_U5 + (size_t)M_TOK * 512 * 2;
constexpr size_t WS_Z = WS_QKV + (size_t)M_TOK * 3072 * 2;
constexpr size_t WS_AB = WS_Z + (size_t)M_TOK * 1024 * 2;
constexpr size_t WS_LX = WS_AB + (size_t)M_TOK * 16 * 4;
constexpr size_t WS_LG = WS_LX + (size_t)M_TOK * 512 * 2;
constexpr size_t WS_XC = WS_LG + (size_t)M_TOK * 512 * 2;
constexpr int NUNIT = BATCH * GDN_H * NCH;
constexpr size_t WS_GU = WS_XC + (size_t)M_TOK * 512 * 2;
constexpr size_t WS_GW = WS_GU + (size_t)NUNIT * 64 * 128 * 4;
constexpr size_t WS_GQD = WS_GW + (size_t)NUNIT * 16384;
constexpr size_t WS_GKD = WS_GQD + (size_t)NUNIT * 16384;
constexpr size_t WS_GQK = WS_GKD + (size_t)NUNIT * 16384;
constexpr size_t WS_GL = WS_GQK + (size_t)NUNIT * 8192;
constexpr size_t WS_GO = WS_GL + al256((size_t)NUNIT * 4);
constexpr size_t WS_S5S = WS_GO + (size_t)M_TOK * 1024 * 4;
constexpr size_t WS_HEXT = WS_S5S + (size_t)32 * 256 * 128 * 4;
constexpr size_t WS_YIN = WS_HEXT + (size_t)32 * 256 * 256 * 2;
constexpr size_t WS_YACT = WS_YIN + (size_t)M_TOK * 512 * 4;
constexpr size_t WS_LA = WS_YACT + (size_t)M_TOK * 512 * 2;
constexpr size_t WS_LB = WS_LA + (size_t)M_TOK * 512 * 4;
constexpr size_t WS_CA = WS_LB + (size_t)M_TOK * 512 * 4;
constexpr size_t WS_CB = WS_CA + (size_t)NCHT * 512 * 4;
constexpr size_t WS_CIN = WS_CB + (size_t)NCHT * 512 * 4;
constexpr size_t WS_CAT = WS_CIN + (size_t)NCHT * 512 * 4;
constexpr size_t WS_END = WS_CAT + (size_t)M_TOK * D_MODEL * 2;
constexpr int CW_BAR = 4096;

constexpr int RING_BYTES = 131072, LDSCTL_OFF = RING_BYTES, MISC_OFF = LDSCTL_OFF + 320, LDS_BYTES = 147456;
constexpr int NWAVES = 8;

struct Params { const float* in[36]; float* out; unsigned char* ws; };
typedef const __attribute__((address_space(4))) unsigned char* kptr_t;
__device__ __forceinline__ kptr_t karg_base() { kptr_t k = (kptr_t)__builtin_amdgcn_kernarg_segment_ptr(); asm volatile("" : "+s"(k)); return k; }
__device__ __forceinline__ const float* KIN(int i) { return *(const float* const __attribute__((address_space(4)))*)(karg_base() + 8 * i); }
__device__ __forceinline__ float* KOUT() { return *(float* const __attribute__((address_space(4)))*)(karg_base() + 8 * 36); }
__device__ __forceinline__ unsigned char* KWS() { return *(unsigned char* const __attribute__((address_space(4)))*)(karg_base() + 8 * 37); }
struct Frame {
    LAS unsigned char* lds; int tid, lane, wave, G, bid;
    __device__ __forceinline__ int gw() const { return bid * NWAVES + wave; }
    __device__ __forceinline__ int ngw() const { return G * NWAVES; }
    __device__ __forceinline__ int gt() const { return bid * (NWAVES * 64) + tid; }
    __device__ __forceinline__ int ngt() const { return G * NWAVES * 64; }
};
#define LDS_WAIT() asm volatile("s_waitcnt lgkmcnt(0)" ::: "memory")
__device__ __forceinline__ Frame fresh(const Frame& F0) { Frame F = F0; int w = F0.wave; asm volatile("" : "+s"(w)); int ln = (int)__builtin_amdgcn_mbcnt_hi(~0u, __builtin_amdgcn_mbcnt_lo(~0u, 0u)); asm volatile("" : "+v"(ln));
    F.wave = w; F.lane = ln; F.tid = w * 64 + ln;
    int b = blockIdx.x, g = gridDim.x; asm volatile("" : "+s"(b), "+s"(g)); F.bid = b; F.G = g; return F; }

struct MapId { __device__ __forceinline__ int operator()(int n) const { return n; } };
struct MapGU { int half; __device__ __forceinline__ int operator()(int n) const { return 256 * (n >> 7) + 128 * half + (n & 127); } };
struct MapIn { __device__ __forceinline__ int operator()(int n) const { return n < 4608 ? n : (n < 4624 ? 5632 + (n - 4608) : n - 16); } };
template <int K, int N, class Map>
__device__ __forceinline__ void transpose_item(const float* W, bf16_t* WT, LAS float* scr, int item, int lane, const Map map) {
    const int nblk = (N + 31) >> 5, kb = item / nblk, nb = item - kb * nblk, k0 = 64 * kb, n0 = 32 * nb;
    const int nn = n0 + (lane & 31); const bool nok = nn < N;
#pragma unroll 8
    for (int i = 0; i < 32; ++i) { const int kk = 2 * i + (lane >> 5); scr[kk * 33 + (lane & 31)] = nok ? W[(size_t)(k0 + kk) * N + nn] : 0.f; }
    LDS_WAIT(); asm volatile("" ::: "memory");
    const int c = lane & 7;
#pragma unroll
    for (int j = 0; j < 4; ++j) { const int n = (lane >> 3) + 8 * j; const LAS float* s = scr + (8 * c) * 33 + n;
        u32x4 o; o.x = cvt_pk_bf16(s[0 * 33], s[1 * 33]); o.y = cvt_pk_bf16(s[2 * 33], s[3 * 33]); o.z = cvt_pk_bf16(s[4 * 33], s[5 * 33]); o.w = cvt_pk_bf16(s[6 * 33], s[7 * 33]);
        if (n0 + n < N) *(u32x4*)(WT + (size_t)map(n0 + n) * K + k0 + 8 * c) = o; }
    LDS_WAIT(); asm volatile("" ::: "memory");
}
__device__ __forceinline__ void cplx_pow(float lre, float lim, float dt, int d, float& zr, float& zi) {
    const float mag = __expf((float)d * lre * dt);
    const double rev = (double)d * ((double)dt * (double)lim) * 0.15915494309189535;
    const float r = (float)(rev - rint(rev));
    zr = mag * __builtin_amdgcn_cosf(r); zi = mag * __builtin_amdgcn_sinf(r);
}
__device__ __forceinline__ void s5_coef(float lre, float lim, float dt, float& cr, float& ci) {
    const float a = lre * dt; const double rev = ((double)dt * (double)lim) * 0.15915494309189535; const float r = (float)(rev - rint(rev));
    const float cb = __builtin_amdgcn_cosf(r), sb = __builtin_amdgcn_sinf(r), sh = __builtin_amdgcn_sinf(0.5f * r);
    const float er = expm1_neg(a) * cb - 2.0f * sh * sh, ei = __expf(a) * sb;
    const float den = rcpf_(lre * lre + lim * lim);
    cr = (er * lre + ei * lim) * den; ci = (ei * lre - er * lim) * den;
}
__device__ __forceinline__ void phase_convert(const Frame& F, int l) {
    unsigned char* ws = KWS();
    LAS float* scr = (LAS float*)(F.lds + F.wave * 8448);
    const int gw = F.gw(), NGW = F.ngw();
    constexpr int I_GU = (D_MODEL / 64) * (D_FF / 32), I_DN = (D_FF / 64) * (D_MODEL / 32), I_IN = (D_MODEL / 64) * ((D_IN + 31) / 32), I_OUT = (D_MODEL / 64) * (D_MODEL / 32), I_GLU = (512 / 64) * (512 / 32);
    constexpr int NITEMS = 4 * I_GU + 2 * I_DN + I_IN + I_OUT + I_GLU;
    const size_t oGU = (size_t)l * D_MODEL * D_FF, oIN = (size_t)l * D_MODEL * D_IN, oOUT = (size_t)l * D_MODEL * D_MODEL, oGLU = (size_t)l * 512 * 512;
    for (int it = gw; it < NITEMS; it += NGW) {
        int r = it;
        if (r < I_GU) { transpose_item<D_MODEL, D_FF>(KIN(1) + oGU, (bf16_t*)(ws + WS_WGU1), scr, r, F.lane, MapGU{0}); continue; } r -= I_GU;
        if (r < I_GU) { transpose_item<D_MODEL, D_FF>(KIN(2) + oGU, (bf16_t*)(ws + WS_WGU1), scr, r, F.lane, MapGU{1}); continue; } r -= I_GU;
        if (r < I_DN) { transpose_item<D_FF, D_MODEL>(KIN(3) + oGU, (bf16_t*)(ws + WS_WD1), scr, r, F.lane, MapId{}); continue; } r -= I_DN;
        if (r < I_GU) { transpose_item<D_MODEL, D_FF>(KIN(31) + oGU, (bf16_t*)(ws + WS_WGU2), scr, r, F.lane, MapGU{0}); continue; } r -= I_GU;
        if (r < I_GU) { transpose_item<D_MODEL, D_FF>(KIN(32) + oGU, (bf16_t*)(ws + WS_WGU2), scr, r, F.lane, MapGU{1}); continue; } r -= I_GU;
        if (r < I_DN) { transpose_item<D_FF, D_MODEL>(KIN(33) + oGU, (bf16_t*)(ws + WS_WD2), scr, r, F.lane, MapId{}); continue; } r -= I_DN;
        if (r < I_IN) { transpose_item<D_MODEL, D_IN>(KIN(6) + oIN, (bf16_t*)(ws + WS_WIN), scr, r, F.lane, MapIn{}); continue; } r -= I_IN;
        if (r < I_OUT) { transpose_item<D_MODEL, D_MODEL>(KIN(28) + oOUT, (bf16_t*)(ws + WS_WOUT), scr, r, F.lane, MapId{}); continue; } r -= I_OUT;
        transpose_item<512, 512>(KIN(15) + oGLU, (bf16_t*)(ws + WS_WGLU), scr, r, F.lane, MapId{});
    }
    const int gt = F.gt(), NGT = F.ngt();
    { const float* wa = KIN(23) + (size_t)l * 8 * 64 * 64; const float* wx = KIN(25) + (size_t)l * 8 * 64 * 64; bf16_t* WL = (bf16_t*)(ws + WS_WLRU);
      for (int idx = gt; idx < 1024 * 512; idx += NGT) { const int row = idx >> 9, k = idx & 511, pn = row >> 8, bj = (row >> 7) & 1, j = row & 127, c = 128 * pn + j, h = c >> 6;
          float v = 0.f; if ((k >> 6) == h) v = (bj ? wx : wa)[(h * 64 + (k & 63)) * 64 + (c & 63)];
          WL[idx] = (bf16_t)f2bf(v); } }
    const float* lre_ = KIN(7) + l * 2048; const float* lim_ = KIN(8) + l * 2048; const float* bre = KIN(9) + (size_t)l * 32768; const float* bim = KIN(10) + (size_t)l * 32768;
    const float* cre = KIN(11) + (size_t)l * 32768; const float* cim = KIN(12) + (size_t)l * 32768; const float* lstep = KIN(14) + l * 32;
    { bf16_t* KT = (bf16_t*)(ws + WS_KTAB);
      for (int idx = gt; idx < 32 * 16 * 128 * 16; idx += NGT) { const int g = idx >> 15, p = (idx >> 11) & 15, e = (idx >> 4) & 127, q = idx & 15;
          float acc = 0.f;
          if (e < 64) { const int d = 63 - e; const float dt = __expf(lstep[g]);
              for (int n = 0; n < 64; ++n) { const float lre = fminf(lre_[g * 64 + n], -1e-4f), lim = lim_[g * 64 + n];
                  float zr, zi, cr, ci; cplx_pow(lre, lim, dt, d, zr, zi); s5_coef(lre, lim, dt, cr, ci);
                  const float br = bre[(g * 64 + n) * 16 + q], bi = bim[(g * 64 + n) * 16 + q];
                  const float bbr = cr * br - ci * bi, bbi = cr * bi + ci * br;
                  const float wr_ = zr * bbr - zi * bbi, wi_ = zr * bbi + zi * bbr;
                  const float c_r = cre[(g * 16 + p) * 64 + n], c_i = cim[(g * 16 + p) * 64 + n];
                  acc += c_r * wr_ - c_i * wi_; } }
          KT[idx] = (bf16_t)f2bf(acc); } }
    { bf16_t* PT = (bf16_t*)(ws + WS_PTAB);
      for (int idx = gt; idx < 32 * 128 * 1024; idx += NGT) { const int g = idx >> 17, r = (idx >> 10) & 127, k = idx & 1023, n = r >> 1, ri = r & 1, s = k >> 4, q = k & 15;
          const float dt = __expf(lstep[g]); const float lre = fminf(lre_[g * 64 + n], -1e-4f), lim = lim_[g * 64 + n];
          float zr, zi, cr, ci; cplx_pow(lre, lim, dt, 63 - s, zr, zi); s5_coef(lre, lim, dt, cr, ci);
          const float br = bre[(g * 64 + n) * 16 + q], bi = bim[(g * 64 + n) * 16 + q];
          const float bbr = cr * br - ci * bi, bbi = cr * bi + ci * br;
          const float v = ri ? (zr * bbi + zi * bbr) : (zr * bbr - zi * bbi);
          PT[((size_t)g * 256 + r) * 1024 + k] = (bf16_t)f2bf(v); } }
    { bf16_t* QT = (bf16_t*)(ws + WS_QTAB);
      for (int idx = gt; idx < 32 * 1024 * 256; idx += NGT) { const int g = idx >> 18, row = (idx >> 8) & 1023, r = idx & 255, t = row >> 4, p = row & 15;
          float v = 0.f;
          if (r < 128) { const int n = r >> 1, ri = r & 1; const float dt = __expf(lstep[g]); const float lre = fminf(lre_[g * 64 + n], -1e-4f), lim = lim_[g * 64 + n];
              float zr, zi; cplx_pow(lre, lim, dt, t + 1, zr, zi);
              const float c_r = cre[(g * 16 + p) * 64 + n], c_i = cim[(g * 16 + p) * 64 + n];
              v = ri ? -(c_r * zi + c_i * zr) : (c_r * zr - c_i * zi); }
          QT[idx] = (bf16_t)f2bf(v); } }
}
__device__ __forceinline__ void phase_x_to_bf16(const Frame& F, const float* x, bf16_t* XN) {
    const size_t n8 = (size_t)M_TOK * D_MODEL / 8;
    for (size_t i = F.gt(); i < n8; i += F.ngt()) { const f32x4 a = *(const f32x4*)(x + i * 8), b = *(const f32x4*)(x + i * 8 + 4);
        u32x4 w; w.x = cvt_pk_bf16(a[0], a[1]); w.y = cvt_pk_bf16(a[2], a[3]); w.z = cvt_pk_bf16(b[0], b[1]); w.w = cvt_pk_bf16(b[2], b[3]); *(u32x4*)(XN + i * 8) = w; }
}
__device__ __forceinline__ void phase_ln(const Frame& F, float* X, const float* gam, const float* bet, bf16_t* XN) {
    f32x4 gv[8], bv[8];
#pragma unroll
    for (int j = 0; j < 8; ++j) { gv[j] = *(const f32x4*)(gam + 4 * F.lane + 256 * j); bv[j] = *(const f32x4*)(bet + 4 * F.lane + 256 * j); }
    for (int m = F.gw(); m < M_TOK; m += F.ngw()) {
        float* xr = X + (size_t)m * D_MODEL + 4 * F.lane; f32x4 v[8]; float s = 0.f;
#pragma unroll
        for (int j = 0; j < 8; ++j) { v[j] = *(const f32x4*)(xr + 256 * j); s += (v[j][0] + v[j][1]) + (v[j][2] + v[j][3]); }
        const float mean = wave_sum(s) * (1.f / D_MODEL); float s2 = 0.f;
#pragma unroll
        for (int j = 0; j < 8; ++j) { v[j] = v[j] - mean; s2 += (v[j][0] * v[j][0] + v[j][1] * v[j][1]) + (v[j][2] * v[j][2] + v[j][3] * v[j][3]); }
        const float rstd = rsqf_(wave_sum(s2) * (1.f / D_MODEL) + LN_EPS);
        bf16_t* xo = XN + (size_t)m * D_MODEL + 4 * F.lane;
#pragma unroll
        for (int j = 0; j < 8; ++j) { const f32x4 o = v[j] * rstd * gv[j] + bv[j]; *(f32x4*)(xr + 256 * j) = o;
            u32x2 w; w.x = cvt_pk_bf16(o[0], o[1]); w.y = cvt_pk_bf16(o[2], o[3]); *(u32x2*)(xo + 256 * j) = w; }
    }
}

__device__ __forceinline__ void phase_lru_conv(const Frame& F, const bf16_t* LX, const float* cw, const float* cb, bf16_t* XC) {
    const int nitems = M_TOK * 64;
    for (int it = F.gt(); it < nitems; it += F.ngt()) {
        const int row = it >> 6, c8 = (it & 63) * 8, t = row & (SEQ - 1);
        float acc[8];
#pragma unroll
        for (int e = 0; e < 8; ++e) acc[e] = cb[c8 + e];
#pragma unroll
        for (int k = 0; k < 4; ++k) { const int dt_ = 3 - k; if (t - dt_ >= 0) {
                const u32x4 xx = *(const u32x4*)(LX + (size_t)(row - dt_) * LRU_W + c8);
                const f32x4 w0 = *(const f32x4*)(cw + k * LRU_W + c8), w1 = *(const f32x4*)(cw + k * LRU_W + c8 + 4);
                acc[0] += w0[0] * bflo(xx.x); acc[1] += w0[1] * bfhi(xx.x); acc[2] += w0[2] * bflo(xx.y); acc[3] += w0[3] * bfhi(xx.y);
                acc[4] += w1[0] * bflo(xx.z); acc[5] += w1[1] * bfhi(xx.z); acc[6] += w1[2] * bflo(xx.w); acc[7] += w1[3] * bfhi(xx.w); } }
        u32x4 w; w.x = cvt_pk_bf16(acc[0], acc[1]); w.y = cvt_pk_bf16(acc[2], acc[3]); w.z = cvt_pk_bf16(acc[4], acc[5]); w.w = cvt_pk_bf16(acc[6], acc[7]);
        *(u32x4*)(XC + (size_t)row * LRU_W + c8) = w;
    }
}
__device__ __forceinline__ void phase_lru_p1(const Frame& F, const float* LA, const float* LB, float* CA, float* CB) {
    for (int it = F.gt(); it < NCHT * LRU_W; it += F.ngt()) {
        const int bc = it >> 9, ch = it & 511; const size_t base = (size_t)bc * CH * LRU_W + ch;
        float A = 1.f, B = 0.f;
#pragma unroll 8
        for (int t = 0; t < CH; ++t) { const float a = LA[base + (size_t)t * LRU_W], b = LB[base + (size_t)t * LRU_W]; B = a * B + b; A *= a; }
        CA[it] = A; CB[it] = B;
    }
}
__device__ __forceinline__ void phase_lru_p2(const Frame& F, const float* CA, const float* CB, float* CIN) {
    const int it = F.gt();
    if (it < BATCH * LRU_W) { const int b = it >> 9, ch = it & 511; float h = 0.f;
        for (int c = 0; c < NCH; ++c) { const int o = (b * NCH + c) * LRU_W + ch; CIN[o] = h; h = CA[o] * h + CB[o]; } }
}
__device__ __forceinline__ void phase_lru_p3(const Frame& F, const float* LA, const float* LB, const float* CIN, const bf16_t* LG, bf16_t* CAT) {
    for (int it = F.gt(); it < NCHT * LRU_W; it += F.ngt()) {
        const int bc = it >> 9, ch = it & 511; const size_t row0 = (size_t)bc * CH;
        float h = CIN[it];
#pragma unroll 8
        for (int t = 0; t < CH; ++t) { const size_t row = row0 + t; h = LA[row * LRU_W + ch] * h + LB[row * LRU_W + ch];
            const float gt_ = bf2f(LG[row * LRU_W + ch]); CAT[row * D_MODEL + 1536 + ch] = (bf16_t)f2bf(h * gelu_tanh(gt_)); }
    }
}

__device__ __forceinline__ void phase_s5_carry(int tix, const float* lre_, const float* lim_, const float* lstep, const float* S5S, bf16_t* HEXT) {
    if (tix < 0 || tix >= BATCH * 32 * 64) return;
    const int b = tix >> 11, g = (tix >> 6) & 31, n = tix & 63;
    const float dt = __expf(lstep[g]); const float lre = fminf(lre_[g * 64 + n], -1e-4f), lim = lim_[g * 64 + n];
    float ar, ai; cplx_pow(lre, lim, dt, 64, ar, ai);
    float hr = 0.f, hi = 0.f;
    for (int c = 0; c < NCH; ++c) { const size_t rowi = (size_t)g * NCHT + b * NCH + c;
        *(unsigned*)(HEXT + rowi * 256 + 2 * n) = cvt_pk_bf16(hr, hi); *(unsigned*)(HEXT + rowi * 256 + 128 + 2 * n) = 0u;
        const f32x2 s = *(const f32x2*)(S5S + rowi * 128 + 2 * n);
        const float nr = ar * hr - ai * hi + s[0], ni = ar * hi + ai * hr + s[1]; hr = nr; hi = ni; }
}

__device__ __forceinline__ int fragoff(int m, int k, int KS) { const int idx = k & 31, g = (idx & 15) >> 2, j = (idx & 3) + 4 * (idx >> 4); return ((((m >> 4) * KS + (k >> 5)) * 64) + 16 * g + (m & 15)) * 8 + j; }
__device__ __forceinline__ bf16x8 ldsfrag(LAS unsigned char* lds, int base, int stride, int row0, int k0, int lane) { return *(const LAS bf16x8*)(lds + base + (row0 + (lane & 15)) * stride + (k0 + 8 * (lane >> 4)) * 2); }
constexpr int GP_QS = 0, GP_KS = 18432, GP_VT = 36864, GP_KBT = 57344, GP_ST = 77824, GP_TB = 110592, GP_MISC = 120832, GP_TMP = GP_MISC + 1024;
__device__ __forceinline__ void gdn_prep_unit(const Frame& F, int l, int unit) {
    unsigned char* ws = KWS(); LAS unsigned char* lds = F.lds;
    const int tid = F.tid, lane = F.lane, wave = F.wave;
    const int c = unit & (NCH - 1), bh = unit >> 7, h = bh & 7, b = bh >> 3, t0 = c * CH; const size_t tok0 = (size_t)b * SEQ + t0;
    const bf16_t* QKV = (const bf16_t*)(ws + WS_QKV); const float* AB = (const float*)(ws + WS_AB);
    LAS float* gcs = (LAS float*)(lds + GP_MISC); LAS float* betas = gcs + 64; LAS float* egs = gcs + 128; LAS float* egls = gcs + 192;
    LAS float* Mf = (LAS float*)(lds + GP_ST); LAS float* Xf = (LAS float*)(lds + GP_KS); LAS float* Tmp = (LAS float*)(lds + GP_TMP);
    if (wave == 0) {
        const float al = AB[(tok0 + lane) * 16 + h], bl = AB[(tok0 + lane) * 16 + 8 + h];
        float g = -__expf(KIN(18)[l * 8 + h]) * softplusf_(al + KIN(19)[l * 8 + h]);
#pragma unroll
        for (int o = 1; o < 64; o <<= 1) { const float t = __shfl_up(g, o); if (lane >= o) g += t; }
        const float glast = __shfl(g, 63);
        gcs[lane] = g; betas[lane] = sigmoidf_(bl); egs[lane] = __expf(g); egls[lane] = __expf(glast - g);
        if (lane == 0) ((float*)(ws + WS_GL))[unit] = __expf(glast);
    }
    __syncthreads();
    {
        const float* convw = KIN(17) + (size_t)l * 4 * 3072;
        float cw[3][4][2];
#pragma unroll
        for (int sg = 0; sg < 3; ++sg)
#pragma unroll
            for (int k = 0; k < 4; ++k) { const f32x2 w = *(const f32x2*)(convw + k * 3072 + sg * 1024 + h * 128 + 2 * lane); cw[sg][k][0] = w[0]; cw[sg][k][1] = w[1]; }
        float xw[3][3][2];
        const int i0 = wave * 8;
#pragma unroll
        for (int j = 0; j < 3; ++j) { const int tt = t0 + i0 - 3 + j;
#pragma unroll
            for (int sg = 0; sg < 3; ++sg) { unsigned v = 0u; if (tt >= 0) v = *(const unsigned*)(QKV + ((size_t)b * SEQ + tt) * 3072 + sg * 1024 + h * 128 + 2 * lane); xw[sg][j][0] = bflo(v); xw[sg][j][1] = bfhi(v); } }
#pragma unroll
        for (int ii = 0; ii < 8; ++ii) { const int i = i0 + ii; float y[3][2];
#pragma unroll
            for (int sg = 0; sg < 3; ++sg) { const unsigned v = *(const unsigned*)(QKV + (tok0 + i) * 3072 + sg * 1024 + h * 128 + 2 * lane); const float x0 = bflo(v), x1 = bfhi(v);
                y[sg][0] = siluf_(cw[sg][0][0] * xw[sg][0][0] + cw[sg][1][0] * xw[sg][1][0] + cw[sg][2][0] * xw[sg][2][0] + cw[sg][3][0] * x0);
                y[sg][1] = siluf_(cw[sg][0][1] * xw[sg][0][1] + cw[sg][1][1] * xw[sg][1][1] + cw[sg][2][1] * xw[sg][2][1] + cw[sg][3][1] * x1);
                xw[sg][0][0] = xw[sg][1][0]; xw[sg][0][1] = xw[sg][1][1]; xw[sg][1][0] = xw[sg][2][0]; xw[sg][1][1] = xw[sg][2][1]; xw[sg][2][0] = x0; xw[sg][2][1] = x1; }
            const float ssq = wave_sum(y[0][0] * y[0][0] + y[0][1] * y[0][1]), ssk = wave_sum(y[1][0] * y[1][0] + y[1][1] * y[1][1]);
            const float rq = rsqf_(ssq + RMS_EPS) * 0.08838834764831845f, rk = rsqf_(ssk + RMS_EPS);
            const float q0 = y[0][0] * rq, q1 = y[0][1] * rq, k0 = y[1][0] * rk, k1 = y[1][1] * rk;
            const float be = betas[i], eg = egs[i], egl = egls[i];
            *(LAS unsigned*)(lds + GP_QS + i * 288 + lane * 4) = cvt_pk_bf16(q0, q1);
            *(LAS unsigned*)(lds + GP_KS + i * 288 + lane * 4) = cvt_pk_bf16(k0, k1);
            *(LAS bf16_t*)(lds + GP_VT + (2 * lane) * 160 + i * 2) = (bf16_t)f2bf(y[2][0] * be); *(LAS bf16_t*)(lds + GP_VT + (2 * lane + 1) * 160 + i * 2) = (bf16_t)f2bf(y[2][1] * be);
            *(LAS bf16_t*)(lds + GP_KBT + (2 * lane) * 160 + i * 2) = (bf16_t)f2bf(k0 * be * eg); *(LAS bf16_t*)(lds + GP_KBT + (2 * lane + 1) * 160 + i * 2) = (bf16_t)f2bf(k1 * be * eg);
            *(LAS unsigned*)(lds + GP_ST + fragoff(i, 2 * lane, 4) * 2) = cvt_pk_bf16(q0 * eg, q1 * eg);
            *(LAS bf16_t*)(lds + GP_ST + 16384 + fragoff(2 * lane, i, 2) * 2) = (bf16_t)f2bf(k0 * egl);
            *(LAS bf16_t*)(lds + GP_ST + 16384 + fragoff(2 * lane + 1, i, 2) * 2) = (bf16_t)f2bf(k1 * egl);
        }
    }
    __syncthreads();
    {
        u32x4* dq = (u32x4*)(ws + WS_GQD + (size_t)unit * 16384); u32x4* dk = (u32x4*)(ws + WS_GKD + (size_t)unit * 16384);
        const LAS u32x4* sq = (const LAS u32x4*)(lds + GP_ST); const LAS u32x4* sk = (const LAS u32x4*)(lds + GP_ST + 16384);
        dq[tid] = sq[tid]; dq[tid + 512] = sq[tid + 512]; dk[tid] = sk[tid]; dk[tid + 512] = sk[tid + 512];
    }
    __syncthreads();
    {
        const int ti = wave >> 1, tj0 = (wave & 1) * 2;
        f32x4 kk[2], qk[2];
#pragma unroll
        for (int jj = 0; jj < 2; ++jj) { kk[jj] = (f32x4){0.f, 0.f, 0.f, 0.f}; qk[jj] = (f32x4){0.f, 0.f, 0.f, 0.f}; }
#pragma unroll
        for (int s = 0; s < 4; ++s) { const bf16x8 aK = ldsfrag(lds, GP_KS, 288, 16 * ti, 32 * s, lane), aQ = ldsfrag(lds, GP_QS, 288, 16 * ti, 32 * s, lane);
#pragma unroll
            for (int jj = 0; jj < 2; ++jj) { const bf16x8 bK = ldsfrag(lds, GP_KS, 288, 16 * (tj0 + jj), 32 * s, lane);
                kk[jj] = __builtin_amdgcn_mfma_f32_16x16x32_bf16(aK, bK, kk[jj], 0, 0, 0); qk[jj] = __builtin_amdgcn_mfma_f32_16x16x32_bf16(aQ, bK, qk[jj], 0, 0, 0); } }
        LDS_WAIT(); __syncthreads();
#pragma unroll
        for (int jj = 0; jj < 2; ++jj)
#pragma unroll
            for (int r = 0; r < 4; ++r) { const int ii = 16 * ti + 4 * (lane >> 4) + r, jx = 16 * (tj0 + jj) + (lane & 15);
                const float dec = (ii >= jx) ? __expf(gcs[ii] - gcs[jx]) : 0.f;
                Mf[ii * 64 + jx] = (ii > jx) ? betas[ii] * kk[jj][r] * dec : 0.f;
                *(LAS bf16_t*)(lds + GP_ST + 16384 + fragoff(ii, jx, 2) * 2) = (bf16_t)f2bf(qk[jj][r] * dec); }
    }
    __syncthreads();
    {
        for (int e = tid; e < 6 * 256; e += 512) { const int blk = e >> 8, i = (e >> 4) & 15, j = e & 15; const int br = blk < 3 ? 0 : (blk < 5 ? 1 : 2), bc = blk < 3 ? blk + 1 : (blk < 5 ? blk - 1 : 3);
            Xf[(16 * br + i) * 64 + 16 * bc + j] = 0.f; }
        if (wave == 0) { const int bb = lane >> 4, cc = lane & 15; float x[16];
#pragma unroll
            for (int i = 0; i < 16; ++i) { float s = (i == cc) ? 1.f : 0.f;
#pragma unroll
                for (int j = 0; j < i; ++j) s -= Mf[(16 * bb + i) * 64 + 16 * bb + j] * x[j];
                x[i] = s; }
#pragma unroll
            for (int i = 0; i < 16; ++i) Xf[(16 * bb + i) * 64 + 16 * bb + cc] = x[i]; }
    }
    __syncthreads();
    { const int pr = tid >> 8, i = (tid >> 4) & 15, j = tid & 15, lo = 32 * pr, hi = lo + 16; float s = 0.f;
#pragma unroll
      for (int k = 0; k < 16; ++k) s += Mf[(hi + i) * 64 + lo + k] * Xf[(lo + k) * 64 + lo + j];
      Tmp[pr * 256 + i * 16 + j] = s; }
    __syncthreads();
    { const int pr = tid >> 8, i = (tid >> 4) & 15, j = tid & 15, lo = 32 * pr, hi = lo + 16; float s = 0.f;
#pragma unroll
      for (int k = 0; k < 16; ++k) s += Xf[(hi + i) * 64 + hi + k] * Tmp[pr * 256 + k * 16 + j];
      Xf[(hi + i) * 64 + lo + j] = -s; }
    __syncthreads();
#pragma unroll
    for (int rep = 0; rep < 2; ++rep) { const int e = tid + 512 * rep, i = e >> 5, j = e & 31; float s = 0.f;
#pragma unroll 8
        for (int k = 0; k < 32; ++k) s += Mf[(32 + i) * 64 + k] * Xf[k * 64 + j];
        Tmp[i * 32 + j] = s; }
    __syncthreads();
#pragma unroll
    for (int rep = 0; rep < 2; ++rep) { const int e = tid + 512 * rep, i = e >> 5, j = e & 31; float s = 0.f;
#pragma unroll 8
        for (int k = 0; k < 32; ++k) s += Xf[(32 + i) * 64 + 32 + k] * Tmp[k * 32 + j];
        Xf[(32 + i) * 64 + j] = -s; }
    __syncthreads();
    { const int row = tid >> 3, c0 = (tid & 7) * 8; const LAS float* s = Xf + row * 64 + c0;
      u32x4 w; w.x = cvt_pk_bf16(s[0], s[1]); w.y = cvt_pk_bf16(s[2], s[3]); w.z = cvt_pk_bf16(s[4], s[5]); w.w = cvt_pk_bf16(s[6], s[7]);
      *(LAS u32x4*)(lds + GP_TB + row * 160 + c0 * 2) = w; }
    __syncthreads();
    {
        float* GU = (float*)(ws + WS_GU);
#pragma unroll
        for (int i = 0; i < 4; ++i) { f32x4 au = (f32x4){0.f, 0.f, 0.f, 0.f}, aw = (f32x4){0.f, 0.f, 0.f, 0.f};
#pragma unroll
            for (int s = 0; s < 2; ++s) { const bf16x8 a = ldsfrag(lds, GP_TB, 160, 16 * i, 32 * s, lane);
                au = __builtin_amdgcn_mfma_f32_16x16x32_bf16(a, ldsfrag(lds, GP_VT, 160, 16 * wave, 32 * s, lane), au, 0, 0, 0);
                aw = __builtin_amdgcn_mfma_f32_16x16x32_bf16(a, ldsfrag(lds, GP_KBT, 160, 16 * wave, 32 * s, lane), aw, 0, 0, 0); }
            *(f32x4*)(GU + ((((size_t)unit * 8 + wave) * 4 + i) * 64 + lane) * 4) = au;
#pragma unroll
            for (int r = 0; r < 4; ++r) *(LAS bf16_t*)(lds + GP_QS + fragoff(16 * i + 4 * (lane >> 4) + r, 16 * wave + (lane & 15), 4) * 2) = (bf16_t)f2bf(aw[r]); }
    }
    __syncthreads();
    {
        u32x4* dw = (u32x4*)(ws + WS_GW + (size_t)unit * 16384); u32x4* dq = (u32x4*)(ws + WS_GQK + (size_t)unit * 8192);
        const LAS u32x4* sw = (const LAS u32x4*)(lds + GP_QS); const LAS u32x4* sq = (const LAS u32x4*)(lds + GP_ST + 16384);
        dw[tid] = sw[tid]; dw[tid + 512] = sw[tid + 512]; dq[tid] = sq[tid];
    }
    __syncthreads();
}
__device__ __forceinline__ bf16x8 pack2(const f32x4& a, const f32x4& b) { u32x4 w; w.x = cvt_pk_bf16(a[0], a[1]); w.y = cvt_pk_bf16(a[2], a[3]); w.z = cvt_pk_bf16(b[0], b[1]); w.w = cvt_pk_bf16(b[2], b[3]); return __builtin_bit_cast(bf16x8, w); }
__device__ __forceinline__ void gdn_scan_wave(int bh, int sl, int lane) {
    unsigned char* ws = KWS(); const int b = bh >> 3, h = bh & 7;
    f32x4 S[8];
#pragma unroll
    for (int j = 0; j < 8; ++j) S[j] = (f32x4){0.f, 0.f, 0.f, 0.f};
    float* GO = (float*)(ws + WS_GO);
    for (int c = 0; c < NCH; ++c) {
        const int unit = bh * NCH + c;
        const bf16x8* Wp = (const bf16x8*)(ws + WS_GW + (size_t)unit * 16384) + lane; const bf16x8* QDp = (const bf16x8*)(ws + WS_GQD + (size_t)unit * 16384) + lane;
        const bf16x8* KDp = (const bf16x8*)(ws + WS_GKD + (size_t)unit * 16384) + lane; const bf16x8* QKp = (const bf16x8*)(ws + WS_GQK + (size_t)unit * 8192) + lane;
        const f32x4* Up = (const f32x4*)(ws + WS_GU) + (((size_t)unit * 8 + sl) * 4) * 64 + lane;
        const float gl = ((const float*)(ws + WS_GL))[unit];
        bf16x8 Sb[4];
#pragma unroll
        for (int s = 0; s < 4; ++s) Sb[s] = pack2(S[2 * s], S[2 * s + 1]);
        f32x4 vn[4], o[4];
#pragma unroll
        for (int i = 0; i < 4; ++i) { f32x4 p = (f32x4){0.f, 0.f, 0.f, 0.f}; o[i] = (f32x4){0.f, 0.f, 0.f, 0.f};
#pragma unroll
            for (int s = 0; s < 4; ++s) { p = __builtin_amdgcn_mfma_f32_16x16x32_bf16(Wp[(i * 4 + s) * 64], Sb[s], p, 0, 0, 0); o[i] = __builtin_amdgcn_mfma_f32_16x16x32_bf16(QDp[(i * 4 + s) * 64], Sb[s], o[i], 0, 0, 0); }
            vn[i] = Up[i * 64] - p; }
        bf16x8 vb[2];
        vb[0] = pack2(vn[0], vn[1]); vb[1] = pack2(vn[2], vn[3]);
#pragma unroll
        for (int i = 0; i < 4; ++i)
#pragma unroll
            for (int s = 0; s < 2; ++s) o[i] = __builtin_amdgcn_mfma_f32_16x16x32_bf16(QKp[(i * 2 + s) * 64], vb[s], o[i], 0, 0, 0);
#pragma unroll
        for (int j = 0; j < 8; ++j) { S[j] = S[j] * gl;
#pragma unroll
            for (int s = 0; s < 2; ++s) S[j] = __builtin_amdgcn_mfma_f32_16x16x32_bf16(KDp[(j * 2 + s) * 64], vb[s], S[j], 0, 0, 0); }
#pragma unroll
        for (int i = 0; i < 4; ++i)
#pragma unroll
            for (int r = 0; r < 4; ++r) GO[((size_t)b * SEQ + c * CH + 16 * i + 4 * (lane >> 4) + r) * GDN_W + h * GDN_D + 16 * sl + (lane & 15)] = o[i][r];
    }
}
__device__ __forceinline__ void phase_gdn_post(const Frame& F, const float* GO, const bf16_t* Z, const float* ng, bf16_t* CAT) {
    const int d0 = (F.lane & 7) * 16;
    float gv[16];
#pragma unroll
    for (int e = 0; e < 16; ++e) gv[e] = ng[d0 + e];
    for (int m = F.gw(); m < M_TOK; m += F.ngw()) {
        const float* op = GO + (size_t)m * GDN_W + F.lane * 16; float v[16]; float ss = 0.f;
#pragma unroll
        for (int q = 0; q < 4; ++q) { const f32x4 t = *(const f32x4*)(op + 4 * q); v[4 * q] = t[0]; v[4 * q + 1] = t[1]; v[4 * q + 2] = t[2]; v[4 * q + 3] = t[3]; ss += (t[0] * t[0] + t[1] * t[1]) + (t[2] * t[2] + t[3] * t[3]); }
        ss += __shfl_xor(ss, 1); ss += __shfl_xor(ss, 2); ss += __shfl_xor(ss, 4);
        const float rn = rsqf_(ss * (1.0f / GDN_D) + RMS_EPS);
        const u32x4 z0 = *(const u32x4*)(Z + (size_t)m * GDN_W + F.lane * 16), z1 = *(const u32x4*)(Z + (size_t)m * GDN_W + F.lane * 16 + 8);
        const float zz[16] = {bflo(z0.x), bfhi(z0.x), bflo(z0.y), bfhi(z0.y), bflo(z0.z), bfhi(z0.z), bflo(z0.w), bfhi(z0.w), bflo(z1.x), bfhi(z1.x), bflo(z1.y), bfhi(z1.y), bflo(z1.z), bfhi(z1.z), bflo(z1.w), bfhi(z1.w)};
        float o[16];
#pragma unroll
        for (int e = 0; e < 16; ++e) o[e] = v[e] * rn * gv[e] * siluf_(zz[e]);
        u32x4 w0, w1; w0.x = cvt_pk_bf16(o[0], o[1]); w0.y = cvt_pk_bf16(o[2], o[3]); w0.z = cvt_pk_bf16(o[4], o[5]); w0.w = cvt_pk_bf16(o[6], o[7]);
        w1.x = cvt_pk_bf16(o[8], o[9]); w1.y = cvt_pk_bf16(o[10], o[11]); w1.z = cvt_pk_bf16(o[12], o[13]); w1.w = cvt_pk_bf16(o[14], o[15]);
        bf16_t* cp = CAT + (size_t)m * D_MODEL + 512 + F.lane * 16; *(u32x4*)cp = w0; *(u32x4*)(cp + 8) = w1;
    }
}

struct DiagOrder { int nunits, G, c; __device__ bool next(int i, Unit& u) const { if (c < 0) return false; const long L = (long)i * G + c; if (L >= nunits) return false; u.pm = (int)L; u.pn = (int)L; return true; } };
struct GeoS5Intra {
    const char* U5; const char* KT;
    __device__ __forceinline__ int nt() const { return 16; }
    __device__ __forceinline__ int a_voff(int R, int C) const { return (R * 1024 + C) * 2; }
    __device__ __forceinline__ int b_voff(int R, int C) const { return (((R & 15) * 128 - (R >> 4)) * 16 + C) * 2; }
    __device__ __forceinline__ long a_hstep() const { return (long)128 * 1024 * 2; }
    __device__ __forceinline__ long b_hstep() const { return -256; }
    __device__ __forceinline__ const char* a_base(const Unit& u) const { return U5 + (size_t)u.pm * 256 * 1024 * 2; }
    __device__ __forceinline__ const char* b_base(const Unit& u) const { return KT + (size_t)u.pm * (16 * 128 * 16 * 2) + (63 - 16 * u.pn) * 32; }
};
struct GeoS5Inter {
    const char* HX; const char* QT;
    __device__ __forceinline__ int nt() const { return 4; }
    __device__ __forceinline__ int a_voff(int R, int C) const { return (R * 256 + C) * 2; }
    __device__ __forceinline__ int b_voff(int R, int C) const { return (R * 256 + C) * 2; }
    __device__ __forceinline__ long a_hstep() const { return (long)128 * 256 * 2; }
    __device__ __forceinline__ long b_hstep() const { return (long)128 * 256 * 2; }
    __device__ __forceinline__ const char* a_base(const Unit& u) const { return HX + (size_t)u.pm * 256 * 256 * 2; }
    __device__ __forceinline__ const char* b_base(const Unit& u) const { return QT + ((size_t)u.pm * 4 + u.pn) * 256 * 256 * 2; }
};

#define PHASE_FN static __device__ __forceinline__ void
extern __shared__ __attribute__((aligned(16))) unsigned char lds_raw[];
#define UNI(x) x = __builtin_amdgcn_readfirstlane(x)
__device__ __forceinline__ Frame make_frame() { Frame F; F.lds = (LAS unsigned char*)lds_raw;
    int t = threadIdx.x; asm volatile("" : "+v"(t)); F.tid = t; F.lane = t & 63; F.wave = __builtin_amdgcn_readfirstlane(t >> 6);
    int b = blockIdx.x, g = gridDim.x; asm volatile("" : "+s"(b), "+s"(g)); F.bid = b; F.G = g; return F; }
PHASE_FN ph_convert(int l) { UNI(l); const Frame F = make_frame(); unsigned char* const ws = KWS();
    phase_convert(F, l);
    if (l == 0) phase_x_to_bf16(F, KIN(0), (bf16_t*)(ws + WS_XN)); }
PHASE_FN ph_ffn_up(int sb) { UNI(sb); const Frame F = make_frame(); unsigned char* const ws = KWS();
    pg8::GeoStd g{(const char*)(ws + WS_XN), (const char*)(ws + (sb ? WS_WGU2 : WS_WGU1)), D_MODEL, D_MODEL, D_MODEL};
    pg8::StaticOrder S; S.init(M_TOK, 2 * D_FF, F.G, F.bid); EpiSwiGLU E{(bf16_t*)(ws + WS_H)};
    pg8::gemm_phase<pg8::GeoStd, EpiSwiGLU, pg8::StaticOrder, true>(F.lds, F.wave, g, S, E); }
PHASE_FN ph_ffn_down(int sb, int first) { UNI(sb); UNI(first); const Frame F = make_frame(); unsigned char* const ws = KWS();
    pg8::GeoStd g{(const char*)(ws + WS_H), (const char*)(ws + (sb ? WS_WD2 : WS_WD1)), D_FF, D_FF, D_FF};
    float* out = KOUT();
    pg8::StaticOrder S; S.init(M_TOK, D_MODEL, F.G, F.bid); EpiResid E{first ? KIN(0) : out, out, 0.5f};
    pg8::gemm_phase<pg8::GeoStd, EpiResid, pg8::StaticOrder, true>(F.lds, F.wave, g, S, E); }
PHASE_FN ph_ln(int l, int which) { UNI(l); UNI(which); const Frame F = make_frame(); unsigned char* const ws = KWS();
    const float* g = (which == 0 ? KIN(4) : which == 1 ? KIN(29) : KIN(34)) + l * D_MODEL; const float* b = (which == 0 ? KIN(5) : which == 1 ? KIN(30) : KIN(35)) + l * D_MODEL;
    phase_ln(F, KOUT(), g, b, (bf16_t*)(ws + WS_XN)); }
PHASE_FN ph_inproj() { const Frame F = make_frame(); unsigned char* const ws = KWS();
    pg8::GeoStd g{(const char*)(ws + WS_XN), (const char*)(ws + WS_WIN), D_MODEL, D_MODEL, D_MODEL};
    pg8::StaticOrder S; S.init(M_TOK, N_IN_PAD, F.G, F.bid);
    EpiInproj E{(bf16_t*)(ws + WS_U5), (bf16_t*)(ws + WS_QKV), (bf16_t*)(ws + WS_Z), (bf16_t*)(ws + WS_LX), (bf16_t*)(ws + WS_LG), (float*)(ws + WS_AB)};
    pg8::gemm_phase<pg8::GeoStd, EpiInproj, pg8::StaticOrder, true>(F.lds, F.wave, g, S, E); }
PHASE_FN ph_gdn_prep(int l) { UNI(l); const Frame F = make_frame();
    for (int uu = F.bid; uu < NUNIT / 8; uu += F.G)
        for (int u8 = 0; u8 < 8; ++u8) gdn_prep_unit(F, l, uu * 8 + u8); }
PHASE_FN ph_lru_conv(int l) { UNI(l); const Frame F = make_frame(); unsigned char* const ws = KWS();
    phase_lru_conv(F, (const bf16_t*)(ws + WS_LX), KIN(21) + l * 4 * LRU_W, KIN(22) + l * LRU_W, (bf16_t*)(ws + WS_XC)); }
PHASE_FN ph_s5_state() { const Frame F = make_frame(); unsigned char* const ws = KWS();
    pg8::GeoStd g{(const char*)(ws + WS_U5), (const char*)(ws + WS_PTAB), 1024, 1024, 1024};
    DiagOrder S{32, F.G, F.bid}; EpiS5S E{(float*)(ws + WS_S5S)};
    pg8::gemm_phase<pg8::GeoStd, EpiS5S, DiagOrder, false>(F.lds, F.wave, g, S, E); }
PHASE_FN ph_s5_intra() { const Frame F = make_frame(); unsigned char* const ws = KWS();
    GeoS5Intra g{(const char*)(ws + WS_U5), (const char*)(ws + WS_KTAB)};
    pg8::GroupOrder S{128, 4, F.G, F.bid - 32}; EpiS5Intra E{(float*)(ws + WS_YIN)};
    pg8::gemm_phase<GeoS5Intra, EpiS5Intra, pg8::GroupOrder, false>(F.lds, F.wave, g, S, E); }
PHASE_FN ph_gdn_scan() { const Frame F = make_frame();
    if (F.wave == 0) { const int xcd = F.bid & 7, q = F.bid >> 3; gdn_scan_wave(xcd * 2 + (q >> 3), q & 7, F.lane); } }
PHASE_FN ph_s5_carry_lru_gates(int l) { UNI(l); const Frame F = make_frame(); unsigned char* const ws = KWS();
    phase_s5_carry((F.bid - 128) * (NWAVES * 64) + F.tid, KIN(7) + l * 2048, KIN(8) + l * 2048, KIN(14) + l * 32, (const float*)(ws + WS_S5S), (bf16_t*)(ws + WS_HEXT));
    pg8::GeoStd g{(const char*)(ws + WS_XC), (const char*)(ws + WS_WLRU), LRU_W, LRU_W, LRU_W};
    pg8::StaticOrder S; S.init(M_TOK, 1024, F.G - 128, F.bid - 128);
    EpiLRU E{(const bf16_t*)(ws + WS_XC), KIN(24) + l * LRU_W, KIN(26) + l * LRU_W, KIN(27) + l * LRU_W, (float*)(ws + WS_LA), (float*)(ws + WS_LB)};
    pg8::gemm_phase<pg8::GeoStd, EpiLRU, pg8::StaticOrder, false>(F.lds, F.wave, g, S, E); }
PHASE_FN ph_gdn_post(int l) { UNI(l); const Frame F = make_frame(); unsigned char* const ws = KWS();
    phase_gdn_post(F, (const float*)(ws + WS_GO), (const bf16_t*)(ws + WS_Z), KIN(20) + l * GDN_D, (bf16_t*)(ws + WS_CAT)); }
PHASE_FN ph_s5_inter(int l) { UNI(l); const Frame F = make_frame(); unsigned char* const ws = KWS();
    GeoS5Inter g{(const char*)(ws + WS_HEXT), (const char*)(ws + WS_QTAB)};
    pg8::GroupOrder S{128, 4, F.G, F.bid}; EpiS5Inter E{(const float*)(ws + WS_YIN), (const bf16_t*)(ws + WS_U5), KIN(13) + l * S5_W, (bf16_t*)(ws + WS_YACT)};
    pg8::gemm_phase<GeoS5Inter, EpiS5Inter, pg8::GroupOrder, false>(F.lds, F.wave, g, S, E); }
PHASE_FN ph_lru_p1() { const Frame F = make_frame(); unsigned char* const ws = KWS();
    phase_lru_p1(F, (const float*)(ws + WS_LA), (const float*)(ws + WS_LB), (float*)(ws + WS_CA), (float*)(ws + WS_CB)); }
PHASE_FN ph_s5_glu(int l) { UNI(l); const Frame F = make_frame(); unsigned char* const ws = KWS();
    pg8::GeoStd g{(const char*)(ws + WS_YACT), (const char*)(ws + WS_WGLU), S5_W, S5_W, S5_W};
    pg8::StaticOrder S; S.init(M_TOK, S5_W, F.G, F.bid); EpiGLU E{(const bf16_t*)(ws + WS_YACT), KIN(16) + l * S5_W, (bf16_t*)(ws + WS_CAT)};
    pg8::gemm_phase<pg8::GeoStd, EpiGLU, pg8::StaticOrder, false>(F.lds, F.wave, g, S, E); }
PHASE_FN ph_lru_p2() { Frame F = make_frame(); unsigned char* const ws = KWS();
    if (F.bid >= F.G - 2) { F.bid -= (F.G - 2); phase_lru_p2(F, (const float*)(ws + WS_CA), (const float*)(ws + WS_CB), (float*)(ws + WS_CIN)); } }
PHASE_FN ph_lru_p3() { const Frame F = make_frame(); unsigned char* const ws = KWS();
    phase_lru_p3(F, (const float*)(ws + WS_LA), (const float*)(ws + WS_LB), (const float*)(ws + WS_CIN), (const bf16_t*)(ws + WS_LG), (bf16_t*)(ws + WS_CAT)); }
PHASE_FN ph_outproj() { const Frame F = make_frame(); unsigned char* const ws = KWS();
    pg8::GeoStd g{(const char*)(ws + WS_CAT), (const char*)(ws + WS_WOUT), D_MODEL, D_MODEL, D_MODEL};
    float* out = KOUT();
    pg8::StaticOrder S; S.init(M_TOK, D_MODEL, F.G, F.bid); EpiResid E{out, out, 1.0f};
    pg8::gemm_phase<pg8::GeoStd, EpiResid, pg8::StaticOrder, true>(F.lds, F.wave, g, S, E); }
PHASE_FN ph_grid_bar() { XcdBarrier b; b.bar = (unsigned*)(KWS() + WS_CTL) + CW_BAR; b.x = xb_xcc_id(); b.st = (volatile LAS unsigned*)((LAS unsigned char*)lds_raw + MISC_OFF) + 8; xcd_barrier(b); }

__global__ void __launch_bounds__(NWAVES * 64, 2) fwd_kernel(Params Pdummy) {
    LAS unsigned char* lds = (LAS unsigned char*)lds_raw;
    for (int u = threadIdx.x; u < (LDS_BYTES - LDSCTL_OFF) / 4; u += NWAVES * 64) ((LAS unsigned*)(lds + LDSCTL_OFF))[u] = 0u;
    __syncthreads();
    LAS unsigned* st = (LAS unsigned*)(lds + MISC_OFF) + 8;
    unsigned* barw = (unsigned*)(KWS() + WS_CTL) + CW_BAR;
    (void)xcd_barrier_post(barw, (volatile LAS unsigned*)st);
    const int bid = blockIdx.x;
#define GRID_BAR() ph_grid_bar()
#pragma unroll
    for (int l = 0; l < DEPTH; ++l) {
        ph_convert(l);
        GRID_BAR();
#pragma unroll
        for (int sb = 0; sb < 2; ++sb) {
            ph_ffn_up(sb);
            GRID_BAR();
            ph_ffn_down(sb, (l == 0 && sb == 0) ? 1 : 0);
            GRID_BAR();
            ph_ln(l, sb ? 2 : 0);
            GRID_BAR();
            if (sb == 0) {
                ph_inproj();
                GRID_BAR();
                ph_gdn_prep(l);
                ph_lru_conv(l);
                ph_s5_state();
                ph_s5_intra();
                GRID_BAR();
                if (bid < 128) ph_gdn_scan(); else ph_s5_carry_lru_gates(l);
                GRID_BAR();
                ph_gdn_post(l);
                ph_s5_inter(l);
                ph_lru_p1();
                GRID_BAR();
                ph_s5_glu(l);
                ph_lru_p2();
                GRID_BAR();
                ph_lru_p3();
                GRID_BAR();
                ph_outproj();
                GRID_BAR();
                ph_ln(l, 1);
                GRID_BAR();
            }
        }
    }
#undef GRID_BAR
}

extern "C" void kernel_launch(void* const* d_in, const int* in_sizes, int n_in, void* d_out, int out_size, void* d_ws, size_t ws_size, hipStream_t stream) {
    static int grid = 0;
    if (grid == 0) {
        if (n_in != 36 || in_sizes[0] != M_TOK * D_MODEL || out_size != M_TOK * D_MODEL || ws_size < WS_END) { fprintf(stderr, "kernel_launch: unexpected shapes (n_in %d, ws %zu < %zu?)\n", n_in, ws_size, (size_t)WS_END); grid = -1; return; }
        int dev = 0, cus = 0, per_cu = 0;
        if (hipGetDevice(&dev) != hipSuccess || hipDeviceGetAttribute(&cus, hipDeviceAttributeMultiprocessorCount, dev) != hipSuccess) { grid = -1; return; }
        if (hipFuncSetAttribute((const void*)fwd_kernel, hipFuncAttributeMaxDynamicSharedMemorySize, LDS_BYTES) != hipSuccess) { fprintf(stderr, "kernel_launch: hipFuncSetAttribute failed\n"); grid = -1; return; }
        if (hipOccupancyMaxActiveBlocksPerMultiprocessor(&per_cu, (const void*)fwd_kernel, NWAVES * 64, LDS_BYTES) != hipSuccess || per_cu < 1) { fprintf(stderr, "kernel_launch: occupancy query reports %d\n", per_cu); }
        (void)hipGetLastError();
        if (cus < 256) { fprintf(stderr, "kernel_launch: needs 256 CUs, device has %d\n", cus); grid = -1; return; }
        grid = 256;
    }
    if (grid < 0) return;
    (void)hipMemsetAsync((char*)d_ws + WS_CTL, 0, CTL_BYTES, stream);
    Params p{};
    for (int i = 0; i < 36; ++i) p.in[i] = (const float*)d_in[i];
    p.out = (float*)d_out; p.ws = (unsigned char*)d_ws;
    hipLaunchKernelGGL(fwd_kernel, dim3(grid), dim3(NWAVES * 64), LDS_BYTES, stream, p);
}
```

```cpp
#include <hip/hip_runtime.h>
#include <cstdio>
#include <cstdint>

#define LAS __attribute__((address_space(3)))
#define GAS __attribute__((address_space(1)))
typedef unsigned short bf16_t;
typedef short bf16x8 __attribute__((ext_vector_type(8)));
typedef float f32x4 __attribute__((ext_vector_type(4)));
typedef float f32x2 __attribute__((ext_vector_type(2)));
typedef unsigned u32x4 __attribute__((ext_vector_type(4)));
typedef unsigned u32x2 __attribute__((ext_vector_type(2)));

constexpr int D_MODEL = 2048, BATCH = 2, SEQ = 8192, DEPTH = 4, M_TOK = BATCH * SEQ;
constexpr int D_FF = 5632, S5_W = 512, S5_G = 32, S5_P = 16, S5_N = 64;
constexpr int GDN_W = 1024, GDN_H = 8, GDN_D = 128, CH = 64, NCH = SEQ / CH  , NCHT = BATCH * NCH  ;
constexpr int LRU_W = 512;
constexpr int D_IN = 5648;
constexpr int N_IN_PAD = 5888;
constexpr float LN_EPS = 1e-5f, RMS_EPS = 1e-6f;
constexpr float DN_ALPHA = 1.6817928305074290f;

__device__ __forceinline__ unsigned cvt_pk_bf16(float lo, float hi) { unsigned r; asm volatile("v_cvt_pk_bf16_f32 %0, %1, %2" : "=v"(r) : "v"(lo), "v"(hi)); return r; }
__device__ __forceinline__ unsigned f2bf(float f) { unsigned u = __builtin_bit_cast(unsigned, f); return (u + 0x7fffu + ((u >> 16) & 1u)) >> 16; }
__device__ __forceinline__ float bf2f(unsigned h) { return __builtin_bit_cast(float, h << 16); }
__device__ __forceinline__ float bflo(unsigned w) { return __builtin_bit_cast(float, w << 16); }
__device__ __forceinline__ float bfhi(unsigned w) { return __builtin_bit_cast(float, w & 0xffff0000u); }
__device__ __forceinline__ float rcpf_(float x) { return __builtin_amdgcn_rcpf(x); }
__device__ __forceinline__ float rsqf_(float x) { return __builtin_amdgcn_rsqf(x); }
__device__ __forceinline__ float sqrtf_(float x) { return __builtin_amdgcn_sqrtf(x); }
__device__ __forceinline__ float sigmoidf_(float x) { return rcpf_(1.0f + __expf(-x)); }
__device__ __forceinline__ float siluf_(float x) { return x * rcpf_(1.0f + __expf(-x)); }
__device__ __forceinline__ float gelu_tanh(float x) { const float u = 0.7978845608028654f * (x + 0.044715f * x * x * x); return x * rcpf_(1.0f + __expf(-2.0f * u)); }
__device__ __forceinline__ float log1p_small(float e) { return e < 0.01f ? e * (1.0f - e * (0.5f - e * (1.0f / 3.0f))) : __logf(1.0f + e); }
__device__ __forceinline__ float softplusf_(float x) { return fmaxf(x, 0.f) + log1p_small(__expf(-fabsf(x))); }
__device__ __forceinline__ float expm1_neg(float z) {
    return fabsf(z) < 0.1f ? z * (1.0f + z * (0.5f + z * ((1.0f / 6.0f) + z * ((1.0f / 24.0f) + z * (1.0f / 120.0f))))) : __expf(z) - 1.0f; }
__device__ __forceinline__ float wave_sum(float v) {
#pragma unroll
    for (int o = 1; o < 64; o <<= 1) v += __shfl_xor(v, o);
    return v;
}

namespace pg8 {
constexpr int BM = 256, BK = 64, HALF = 128, HTB = HALF * BK * 2, STAGE_BYTES = 8 * HTB, NXCD = 8, WGM = 8;
__host__ __device__ __forceinline__ int lds_byte(int r, int c) { const int st = (r >> 4) * 2 + (c >> 5), rr = r & 15, cc = c & 31, ob = rr * 64 + cc * 2; return st * 1024 + (ob ^ (((ob >> 9) & 1) << 5)); }
__host__ __device__ __forceinline__ void stage_rc(int b, int& R, int& C) { const int st = b / 1024, sb = b % 1024, swz = sb ^ (((sb >> 9) & 1) << 5); R = (st >> 1) * 16 + swz / 64; C = (st & 1) * 32 + (swz % 64) / 2; }
__host__ __device__ __forceinline__ int perm32(int rho) { const int n = rho >> 4, i = rho & 15; return 8 * (i >> 2) + 4 * n + (i & 3); }

struct Unit { int pm, pn; };

struct GeoStd {
    const char* A; const char* B; int lda, ldb, K;
    __device__ __forceinline__ int nt() const { return K / BK; }
    __device__ __forceinline__ int a_voff(int R, int C) const { return (R * lda + C) * 2; }
    __device__ __forceinline__ int b_voff(int R, int C) const { return (R * ldb + C) * 2; }
    __device__ __forceinline__ long a_hstep() const { return (long)HALF * lda * 2; }
    __device__ __forceinline__ long b_hstep() const { return (long)HALF * ldb * 2; }
    __device__ __forceinline__ const char* a_base(const Unit& u) const { return A + (size_t)u.pm * BM * lda * 2; }
    __device__ __forceinline__ const char* b_base(const Unit& u) const { return B + (size_t)u.pn * BM * ldb * 2; }
};

struct StaticOrder {
    int nM, nN, nwg, G, c;
    __device__ void init(int M, int N, int G_, int c_) { nM = M / BM; nN = N / BM; nwg = nM * nN; G = G_; c = c_; }
    __device__ bool next(int i, Unit& u) const {
        if (c < 0) return false;
        const long L = (long)i * G + c; if (L >= nwg) return false;
        int wgid = (int)L; { const int q = nwg / NXCD, r = nwg % NXCD, xcd = wgid % NXCD, off = wgid / NXCD; wgid = (xcd < r ? xcd * (q + 1) : r * (q + 1) + (xcd - r) * q) + off; }
        const int nig = WGM * nN, gid = wgid / nig, fm = gid * WGM, gsz = (nM - fm) < WGM ? (nM - fm) : WGM;
        u.pm = fm + ((wgid % nig) % gsz); u.pn = (wgid % nig) / gsz; return true;
    }
};
struct GroupOrder {
    int nunits, per, G, c;
    __device__ bool next(int i, Unit& u) const { if (c < 0) return false; const long L = (long)i * G + c; if (L >= nunits) return false; u.pm = (int)L / per; u.pn = (int)L % per; return true; }
};

template <class Geo, class Epi, class Sched, bool ALIGN_EPI>
__device__ __forceinline__ void gemm_phase(LAS unsigned char* lds, int wave_id, const Geo& g, const Sched& S, const Epi& E) {
    int tid = threadIdx.x; asm volatile("" : "+v"(tid));
    const int wid = __builtin_amdgcn_readfirstlane(tid >> 6), lane = tid & 63, wr = wid >> 2, wc = wid & 3, fr = lane & 15, fq = lane >> 4;
    const int nt = g.nt();
    int voffA[2], voffB[2];
#pragma unroll
    for (int i = 0; i < 2; ++i) { int R, C; stage_rc(tid * 16 + i * 8192, R, C); const int Rb = Epi::PERM ? ((R & ~31) + perm32(R & 31)) : R;
        voffA[i] = g.a_voff(R, C); voffB[i] = g.b_voff(Rb, C); }
    const long kstep = (long)(BK * 2);
    const long hstepA = g.a_hstep(), hstepB = g.b_hstep();
    const unsigned ldsw = (unsigned)wid * 1024u;
    const int aoff = lds_byte(wr * 64 + fr, fq * 8), boff = lds_byte(wc * 32 + fr, fq * 8);
#define PG8_SA(b, h) (((b) * 2 + (h)) * HTB)
#define PG8_SB(b, h) ((4 + (b) * 2 + (h)) * HTB)
#define PG8_STAGE(bufoff, gbase, voff) do { _Pragma("unroll") for (int _i = 0; _i < 2; ++_i) \
        __builtin_amdgcn_global_load_lds((const unsigned*)((const char*)(gbase) + (voff)[_i]), (LAS unsigned*)(lds + (bufoff) + ldsw + _i * 8192), 16, 0, 0); } while (0)
#define PG8_LDA(dst, b, h) do { _Pragma("unroll") for (int m = 0; m < 4; ++m) _Pragma("unroll") for (int k = 0; k < 2; ++k) dst[m][k] = *(const LAS bf16x8*)(lds + PG8_SA(b, h) + aoff + m * 2048 + k * 1024); } while (0)
#define PG8_LDB(dst, b, h) do { _Pragma("unroll") for (int n = 0; n < 2; ++n) _Pragma("unroll") for (int k = 0; k < 2; ++k) dst[n][k] = *(const LAS bf16x8*)(lds + PG8_SB(b, h) + boff + n * 2048 + k * 1024); } while (0)
#define PG8_MMA(ai, bj, At, Bt) do { __builtin_amdgcn_s_setprio(1); _Pragma("unroll") for (int m = 0; m < 4; ++m) _Pragma("unroll") for (int n = 0; n < 2; ++n) _Pragma("unroll") for (int k = 0; k < 2; ++k) \
        acc[ai][bj][m][n] = __builtin_amdgcn_mfma_f32_16x16x32_bf16(Bt[n][k], At[m][k], acc[ai][bj][m][n], 0, 0, 0); __builtin_amdgcn_s_setprio(0); } while (0)
#define PG8_WAIT_V(n) asm volatile("s_waitcnt vmcnt(" #n ")" ::: "memory")
#define PG8_WAIT_L(n) asm volatile("s_waitcnt lgkmcnt(" #n ")" ::: "memory")
#define PG8_BAR __builtin_amdgcn_s_barrier()
#define PG8_SCHED __builtin_amdgcn_sched_barrier(0)
    Unit cur, nxt; int ui = 0;
    if (!S.next(0, cur)) return;
    f32x4 acc[2][2][4][2];
#pragma unroll
    for (int a = 0; a < 2; ++a)
#pragma unroll
        for (int b = 0; b < 2; ++b)
#pragma unroll
            for (int m = 0; m < 4; ++m)
#pragma unroll
                for (int n = 0; n < 2; ++n) acc[a][b][m][n] = (f32x4){0.f, 0.f, 0.f, 0.f};
    bf16x8 At[4][2], B0[2][2], B1[2][2];
    const char* cA = g.a_base(cur); const char* cB = g.b_base(cur);
    PG8_STAGE(PG8_SB(0, 0), cB, voffB); PG8_STAGE(PG8_SB(0, 1), cB + hstepB, voffB); PG8_STAGE(PG8_SA(0, 0), cA, voffA); PG8_STAGE(PG8_SA(0, 1), cA + hstepA, voffA);
    if (wr == 1) PG8_BAR;
    PG8_WAIT_V(2); PG8_BAR;
    PG8_STAGE(PG8_SB(1, 0), cB + kstep, voffB); PG8_STAGE(PG8_SA(1, 0), cA + kstep, voffA); PG8_STAGE(PG8_SB(1, 1), cB + hstepB + kstep, voffB);
    PG8_WAIT_V(6); PG8_BAR;
    for (;;) {
        const bool has_next = S.next(ui + 1, nxt);
        const char* nA = has_next ? g.a_base(nxt) : cA; const char* nB = has_next ? g.b_base(nxt) : cB;
        for (int t = 0; t < nt; t += 2) {
            const bool last = (t == nt - 2);
            const char* a1 = cA + (long)(t + 1) * kstep;
            const char* a2 = last ? nA : cA + (long)(t + 2) * kstep; const char* b2 = last ? nB : cB + (long)(t + 2) * kstep;
            const char* a3 = a2 + kstep; const char* b3 = b2 + kstep;
            PG8_LDB(B0, 0, 0); PG8_LDB(B1, 0, 1); PG8_SCHED; PG8_LDA(At, 0, 0); PG8_STAGE(PG8_SA(1, 1), a1 + hstepA, voffA);
            PG8_WAIT_V(8); PG8_WAIT_L(0); PG8_BAR; PG8_MMA(0, 0, At, B0); PG8_MMA(0, 1, At, B1); PG8_BAR; PG8_SCHED;
            PG8_LDA(At, 0, 1); PG8_STAGE(PG8_SB(0, 0), b2, voffB); PG8_STAGE(PG8_SB(0, 1), b2 + hstepB, voffB); PG8_STAGE(PG8_SA(0, 0), a2, voffA);
            PG8_WAIT_V(8); PG8_WAIT_L(0); PG8_BAR; PG8_MMA(1, 0, At, B0); PG8_MMA(1, 1, At, B1); PG8_BAR; PG8_SCHED;
            PG8_LDB(B0, 1, 0); PG8_LDB(B1, 1, 1); PG8_SCHED; PG8_LDA(At, 1, 0); PG8_STAGE(PG8_SA(0, 1), a2 + hstepA, voffA);
            PG8_WAIT_V(8); PG8_WAIT_L(0); PG8_BAR; PG8_MMA(0, 0, At, B0); PG8_MMA(0, 1, At, B1); PG8_BAR; PG8_SCHED;
            PG8_LDA(At, 1, 1); PG8_STAGE(PG8_SB(1, 0), b3, voffB); PG8_STAGE(PG8_SB(1, 1), b3 + hstepB, voffB); PG8_STAGE(PG8_SA(1, 0), a3, voffA);
            PG8_WAIT_V(8); PG8_WAIT_L(0); PG8_BAR; PG8_MMA(1, 0, At, B0); PG8_MMA(1, 1, At, B1); PG8_BAR; PG8_SCHED;
        }
        if constexpr (ALIGN_EPI) { if (wr == 0) PG8_BAR; }
        {
            Unit ue = cur; int fr_e = fr, fq_e = fq; asm volatile("" : "+s"(ue.pm), "+s"(ue.pn), "+v"(fr_e), "+v"(fq_e));
            E(acc, ue, wr, wc, fr_e, fq_e); }
        if (!has_next) break;
#pragma unroll
        for (int a = 0; a < 2; ++a)
#pragma unroll
            for (int b = 0; b < 2; ++b)
#pragma unroll
                for (int m = 0; m < 4; ++m)
#pragma unroll
                    for (int n = 0; n < 2; ++n) acc[a][b][m][n] = (f32x4){0.f, 0.f, 0.f, 0.f};
        cur = nxt; cA = nA; cB = nB; ++ui;
        if constexpr (ALIGN_EPI) { if (wr == 1) PG8_BAR; }
    }
    PG8_WAIT_V(0);
    if constexpr (!ALIGN_EPI) { if (wr == 0) PG8_BAR; }
    PG8_BAR;
#undef PG8_SA
#undef PG8_SB
#undef PG8_STAGE
#undef PG8_LDA
#undef PG8_LDB
#undef PG8_MMA
#undef PG8_WAIT_V
#undef PG8_WAIT_L
#undef PG8_BAR
#undef PG8_SCHED
}
}

using pg8::Unit;
struct EpiSwiGLU {
    static constexpr bool PERM = true;
    bf16_t* H;
    __device__ __forceinline__ void operator()(const f32x4 (&acc)[2][2][4][2], const Unit& u, int wr, int wc, int fr, int fq) const {
        const int row0 = u.pm * 256 + wr * 64 + fr, col0 = u.pn * 128 + wc * 32 + 8 * fq;
#pragma unroll
        for (int ai = 0; ai < 2; ++ai)
#pragma unroll
            for (int m = 0; m < 4; ++m) {
                bf16_t* rowp = H + (size_t)(row0 + ai * 128 + m * 16) * D_FF + col0;
                const f32x4 g0 = acc[ai][0][m][0], g1 = acc[ai][0][m][1], u0 = acc[ai][1][m][0], u1 = acc[ai][1][m][1];
                u32x4 w;
                w.x = cvt_pk_bf16(siluf_(g0[0]) * u0[0], siluf_(g0[1]) * u0[1]); w.y = cvt_pk_bf16(siluf_(g0[2]) * u0[2], siluf_(g0[3]) * u0[3]);
                w.z = cvt_pk_bf16(siluf_(g1[0]) * u1[0], siluf_(g1[1]) * u1[1]); w.w = cvt_pk_bf16(siluf_(g1[2]) * u1[2], siluf_(g1[3]) * u1[3]);
                *(u32x4*)rowp = w;
            }
    }
};
struct EpiResid {
    static constexpr bool PERM = false;
    const float* res; float* out; float scale;
    __device__ __forceinline__ void operator()(const f32x4 (&acc)[2][2][4][2], const Unit& u, int wr, int wc, int fr, int fq) const {
        const int row0 = u.pm * 256 + wr * 64 + fr, col0 = u.pn * 256 + wc * 32 + 4 * fq;
#pragma unroll
        for (int ai = 0; ai < 2; ++ai)
#pragma unroll
            for (int m = 0; m < 4; ++m) {
                const size_t off = (size_t)(row0 + ai * 128 + m * 16) * D_MODEL + col0;
#pragma unroll
                for (int bj = 0; bj < 2; ++bj)
#pragma unroll
                    for (int n = 0; n < 2; ++n) { const f32x4 r = *(const f32x4*)(res + off + bj * 128 + n * 16); *(f32x4*)(out + off + bj * 128 + n * 16) = r * DN_ALPHA + acc[ai][bj][m][n] * scale; }
            }
    }
};
struct EpiInproj {
    static constexpr bool PERM = true;
    bf16_t *U5, *QKV, *Z, *LX, *LG; float* AB;
    __device__ __forceinline__ void operator()(const f32x4 (&acc)[2][2][4][2], const Unit& u, int wr, int wc, int fr, int fq) const {
        const int row0 = u.pm * 256 + wr * 64 + fr;
        const int pn = u.pn;
#pragma unroll
        for (int ai = 0; ai < 2; ++ai)
#pragma unroll
            for (int m = 0; m < 4; ++m) {
                const int row = row0 + ai * 128 + m * 16;
#pragma unroll
                for (int bj = 0; bj < 2; ++bj) {
                    const int c = pn * 256 + bj * 128 + wc * 32 + 8 * fq;
                    const f32x4 v0 = acc[ai][bj][m][0], v1 = acc[ai][bj][m][1];
                    if (pn == 22) {
                        if (bj == 0 && wc == 0 && fq < 2) { float* p = AB + (size_t)row * 16 + 8 * fq; *(f32x4*)p = v0; *(f32x4*)(p + 4) = v1; }
                    } else {
                        u32x4 w; w.x = cvt_pk_bf16(v0[0], v0[1]); w.y = cvt_pk_bf16(v0[2], v0[3]); w.z = cvt_pk_bf16(v1[0], v1[1]); w.w = cvt_pk_bf16(v1[2], v1[3]);
                        bf16_t* p;
                        if (pn < 2) { const int g = c >> 4, hf = c & 8; p = U5 + ((size_t)g * M_TOK + row) * 16 + hf; }
                        else if (pn < 14) p = QKV + (size_t)row * 3072 + (c - 512);
                        else if (pn < 18) p = Z + (size_t)row * 1024 + (c - 3584);
                        else if (pn < 20) p = LX + (size_t)row * 512 + (c - 4608);
                        else p = LG + (size_t)row * 512 + (c - 5120);
                        *(u32x4*)p = w;
                    }
                }
            }
    }
};
struct EpiS5S {
    static constexpr bool PERM = false;
    float* S;
    __device__ __forceinline__ void operator()(const f32x4 (&acc)[2][2][4][2], const Unit& u, int wr, int wc, int fr, int fq) const {
        const int g = u.pm, row0 = wr * 64 + fr, col0 = wc * 32 + 4 * fq;
#pragma unroll
        for (int ai = 0; ai < 2; ++ai)
#pragma unroll
            for (int m = 0; m < 4; ++m) { float* p = S + ((size_t)g * NCHT + row0 + ai * 128 + m * 16) * 128 + col0;
#pragma unroll
                for (int n = 0; n < 2; ++n) *(f32x4*)(p + n * 16) = acc[ai][0][m][n]; }
    }
};
struct EpiS5Intra {
    static constexpr bool PERM = false;
    float* Y;
    __device__ __forceinline__ void operator()(const f32x4 (&acc)[2][2][4][2], const Unit& u, int wr, int wc, int fr, int fq) const {
        const int g = u.pm, j = u.pn, row0 = wr * 64 + fr;
#pragma unroll
        for (int ai = 0; ai < 2; ++ai)
#pragma unroll
            for (int m = 0; m < 4; ++m) { const int bc = row0 + ai * 128 + m * 16;
#pragma unroll
                for (int bj = 0; bj < 2; ++bj)
#pragma unroll
                    for (int n = 0; n < 2; ++n) { const int col = j * 256 + bj * 128 + wc * 32 + 16 * n + 4 * fq, t = col >> 4, p = col & 15;
                        *(f32x4*)(Y + ((size_t)bc * CH + t) * S5_W + g * 16 + p) = acc[ai][bj][m][n]; }
            }
    }
};
struct EpiS5Inter {
    static constexpr bool PERM = false;
    const float* Y; const bf16_t* U5; const float* dvec; bf16_t* YACT;
    __device__ __forceinline__ void operator()(const f32x4 (&acc)[2][2][4][2], const Unit& u, int wr, int wc, int fr, int fq) const {
        const int g = u.pm, j = u.pn, row0 = wr * 64 + fr;
#pragma unroll
        for (int ai = 0; ai < 2; ++ai)
#pragma unroll
            for (int m = 0; m < 4; ++m) { const int bc = row0 + ai * 128 + m * 16;
#pragma unroll
                for (int bj = 0; bj < 2; ++bj)
#pragma unroll
                    for (int n = 0; n < 2; ++n) { const int col = j * 256 + bj * 128 + wc * 32 + 16 * n + 4 * fq, t = col >> 4, p = col & 15;
                        const size_t tok = (size_t)bc * CH + t; const int ch = g * 16 + p;
                        const f32x4 y0 = *(const f32x4*)(Y + tok * S5_W + ch);
                        const u32x2 uu = *(const u32x2*)(U5 + ((size_t)g * M_TOK + tok) * 16 + p);
                        const f32x4 d0 = *(const f32x4*)(dvec + ch);
                        const f32x4 a0 = acc[ai][bj][m][n];
                        const float o0 = gelu_tanh(a0[0] + y0[0] + d0[0] * bflo(uu.x)), o1 = gelu_tanh(a0[1] + y0[1] + d0[1] * bfhi(uu.x));
                        const float o2 = gelu_tanh(a0[2] + y0[2] + d0[2] * bflo(uu.y)), o3 = gelu_tanh(a0[3] + y0[3] + d0[3] * bfhi(uu.y));
                        u32x2 w; w.x = cvt_pk_bf16(o0, o1); w.y = cvt_pk_bf16(o2, o3);
                        *(u32x2*)(YACT + tok * S5_W + ch) = w; }
                asm volatile("" ::: "memory");
            }
    }
};
struct EpiGLU {
    static constexpr bool PERM = true;
    const bf16_t* YACT; const float* bglu; bf16_t* CAT;
    __device__ __forceinline__ void operator()(const f32x4 (&acc)[2][2][4][2], const Unit& u, int wr, int wc, int fr, int fq) const {
        const int row0 = u.pm * 256 + wr * 64 + fr;
#pragma unroll
        for (int ai = 0; ai < 2; ++ai)
#pragma unroll
            for (int m = 0; m < 4; ++m) { const size_t row = (size_t)(row0 + ai * 128 + m * 16);
#pragma unroll
                for (int bj = 0; bj < 2; ++bj) { const int col = u.pn * 256 + bj * 128 + wc * 32 + 8 * fq;
                    const u32x4 yy = *(const u32x4*)(YACT + row * S5_W + col);
                    const f32x4 b0 = *(const f32x4*)(bglu + col), b1 = *(const f32x4*)(bglu + col + 4);
                    const f32x4 a0 = acc[ai][bj][m][0] + b0, a1 = acc[ai][bj][m][1] + b1;
                    u32x4 w;
                    w.x = cvt_pk_bf16(bflo(yy.x) * sigmoidf_(a0[0]), bfhi(yy.x) * sigmoidf_(a0[1])); w.y = cvt_pk_bf16(bflo(yy.y) * sigmoidf_(a0[2]), bfhi(yy.y) * sigmoidf_(a0[3]));
                    w.z = cvt_pk_bf16(bflo(yy.z) * sigmoidf_(a1[0]), bfhi(yy.z) * sigmoidf_(a1[1])); w.w = cvt_pk_bf16(bflo(yy.w) * sigmoidf_(a1[2]), bfhi(yy.w) * sigmoidf_(a1[3]));
                    *(u32x4*)(CAT + row * D_MODEL + col) = w; }
            }
    }
};
struct EpiLRU {
    static constexpr bool PERM = true;
    const bf16_t* XC; const float *ba, *bx, *lam; float *LA, *LB;
    __device__ __forceinline__ void operator()(const f32x4 (&acc)[2][2][4][2], const Unit& u, int wr, int wc, int fr, int fq) const {
        const int row0 = u.pm * 256 + wr * 64 + fr, ch = u.pn * 128 + wc * 32 + 8 * fq;
        float sp[8], bav[8], bxv[8];
#pragma unroll
        for (int e = 0; e < 8; ++e) { sp[e] = -8.0f * softplusf_(-lam[ch + e]); bav[e] = ba[ch + e]; bxv[e] = bx[ch + e]; }
#pragma unroll
        for (int ai = 0; ai < 2; ++ai)
#pragma unroll
            for (int m = 0; m < 4; ++m) { const size_t row = (size_t)(row0 + ai * 128 + m * 16);
                const u32x4 xx = *(const u32x4*)(XC + row * LRU_W + ch);
                float xc[8] = {bflo(xx.x), bfhi(xx.x), bflo(xx.y), bfhi(xx.y), bflo(xx.z), bfhi(xx.z), bflo(xx.w), bfhi(xx.w)};
                float av[8], bv[8];
#pragma unroll
                for (int e = 0; e < 8; ++e) { const float ra = acc[ai][0][m][e >> 2][e & 3] + bav[e], rx = acc[ai][1][m][e >> 2][e & 3] + bxv[e];
                    const float r = sigmoidf_(ra), ig = sigmoidf_(rx), la = sp[e] * r; av[e] = __expf(la); bv[e] = sqrtf_(fmaxf(-expm1_neg(2.0f * la), 0.f)) * (ig * xc[e]); }
                *(f32x4*)(LA + row * LRU_W + ch) = (f32x4){av[0], av[1], av[2], av[3]}; *(f32x4*)(LA + row * LRU_W + ch + 4) = (f32x4){av[4], av[5], av[6], av[7]};
                *(f32x4*)(LB + row * LRU_W + ch) = (f32x4){bv[0], bv[1], bv[2], bv[3]}; *(f32x4*)(LB + row * LRU_W + ch + 4) = (f32x4){bv[4], bv[5], bv[6], bv[7]};
            }
    }
};

#define XB_TMO      128
#define XB_XCNT(j)  (256  + 64 * (j))
#define XB_XSUB(j)  (1280 + 64 * (j))
#define XB_XGEN(j)  (2304 + 64 * (j))
#define XB_TOP      3328
#define XB_TOPGEN   3392
#define XCD_BAR_WORDS 3456
#define XB_SPIN_CAP (1u << 22)
__device__ __forceinline__ unsigned xb_ld(unsigned* p)              { return __hip_atomic_load(p, __ATOMIC_RELAXED, __HIP_MEMORY_SCOPE_AGENT); }
__device__ __forceinline__ unsigned xb_add(unsigned* p, unsigned v) { return __hip_atomic_fetch_add(p, v, __ATOMIC_RELAXED, __HIP_MEMORY_SCOPE_AGENT); }
__device__ __forceinline__ unsigned xb_xcc_id() { return (unsigned)__builtin_amdgcn_s_getreg((3 << 11) | 20) & 0xFu; }
#define XB_SPIN(cond, bar) do { unsigned _sp = 0; while (cond) { __builtin_amdgcn_s_sleep(1); \
    if ((++_sp & 255u) == 0u) { if (xb_ld(&(bar)[XB_TMO])) break; if (_sp > XB_SPIN_CAP) { atomicAdd(&(bar)[XB_TMO], 1u); break; } } } } while (0)
struct XcdBarrier { unsigned* bar; unsigned x; volatile LAS unsigned* st; };
__device__ __forceinline__ XcdBarrier xcd_barrier_post(unsigned* bar, volatile LAS unsigned* st) {
    XcdBarrier b; b.bar = bar; b.x = xb_xcc_id(); b.st = st;
    if (threadIdx.x == 0) (void)xb_add(&bar[XB_XCNT(b.x)], 1u);
    return b;
}
__device__ __forceinline__ void xcd_barrier_complete(unsigned* bar, unsigned x, unsigned& nloc, unsigned& nx) {
    const unsigned G = gridDim.x * gridDim.y * gridDim.z;
    unsigned sum, cnt, mine, sp = 0u;
    for (;;) {
        sum = 0u; cnt = 0u; mine = 0u;
#pragma unroll
        for (unsigned j = 0; j < 16; ++j) { const unsigned c = xb_ld(&bar[XB_XCNT(j)]); sum += c; cnt += (c > 0u) ? 1u : 0u; mine = (j == x) ? c : mine; }
        if (sum == G) break;
        __builtin_amdgcn_s_sleep(1);
        if ((++sp & 255u) == 0u) { if (xb_ld(&bar[XB_TMO])) break; if (sp > XB_SPIN_CAP) { atomicAdd(&bar[XB_TMO], 1u); break; } }
    }
    nloc = mine > 0u ? mine : 1u; nx = cnt > 0u ? cnt : 1u;
}
__device__ __forceinline__ void xcd_barrier(const XcdBarrier& b) {
    asm volatile("s_waitcnt vmcnt(0)" ::: "memory");
    __syncthreads();
    if (threadIdx.x == 0) {
        unsigned* bar = b.bar; unsigned bx = b.x;
        __builtin_amdgcn_s_waitcnt(0);
        unsigned nloc = b.st[0], nx = b.st[1];
        if (nloc == 0u) { xcd_barrier_complete(bar, bx, nloc, nx); b.st[0] = nloc; b.st[1] = nx; }
        const unsigned old = xb_add(&bar[XB_XSUB(bx)], 1u);
        const unsigned gen = old / nloc;
        if (old + 1u == (gen + 1u) * nloc) {
            __builtin_amdgcn_fence(__ATOMIC_RELEASE, "agent");
            asm volatile("s_waitcnt vmcnt(0)" ::: "memory");
            const unsigned og = xb_add(&bar[XB_TOP], 1u);
            const unsigned tg = og / nx;
            if (og + 1u == (tg + 1u) * nx) xb_add(&bar[XB_TOPGEN], 1u);
            else XB_SPIN(xb_ld(&bar[XB_TOPGEN]) == tg, bar);
            __builtin_amdgcn_fence(__ATOMIC_ACQUIRE, "agent");
            xb_add(&bar[XB_XGEN(bx)], 1u);
            asm volatile("s_waitcnt vmcnt(0)" ::: "memory");
        } else {
            XB_SPIN(xb_ld(&bar[XB_XGEN(bx)]) == gen, bar);
            __builtin_amdgcn_fence(__ATOMIC_ACQUIRE, "agent");
            asm volatile("s_waitcnt vmcnt(0)" ::: "memory");
        }
    }
    __syncthreads();
}

constexpr size_t al256(size_t x) { return (x + 255) & ~(size_t)255; }
constexpr size_t WS_CTL = 0, CTL_BYTES = 1u << 20;
constexpr size_t SZ_WGU = (size_t)2 * D_FF * D_MODEL * 2, SZ_WD = (size_t)D_MODEL * D_FF * 2, SZ_WIN = (size_t)N_IN_PAD * D_MODEL * 2, SZ_WOUT = (size_t)D_MODEL * D_MODEL * 2;
constexpr size_t WS_WGU1 = WS_CTL + CTL_BYTES, WS_WGU2 = WS_WGU1 + SZ_WGU, WS_WD1 = WS_WGU2 + SZ_WGU, WS_WD2 = WS_WD1 + SZ_WD, WS_WIN = WS_WD2 + SZ_WD, WS_WOUT = WS_WIN + SZ_WIN;
constexpr size_t WS_WGLU = WS_WOUT + SZ_WOUT, WS_WLRU = WS_WGLU + (size_t)512 * 512 * 2;
constexpr size_t WS_KTAB = WS_WLRU + (size_t)1024 * 512 * 2;
constexpr size_t WS_PTAB = WS_KTAB + (size_t)32 * 16 * 128 * 16 * 2;
constexpr size_t WS_QTAB = WS_PTAB + (size_t)32 * 256 * 1024 * 2;
constexpr size_t WS_XN = WS_QTAB + (size_t)32 * 1024 * 256 * 2;
constexpr size_t WS_H = WS_XN + (size_t)M_TOK * D_MODEL * 2;
constexpr size_t WS_U5 = WS_H + (size_t)M_TOK * D_FF * 2;
constexpr size_t WS_QKV = WS_U5 + (size_t)M_TOK * 512 * 2;
constexpr size_t WS_Z = WS_QKV + (size_t)M_TOK * 3072 * 2;
constexpr size_t WS_AB = WS_Z + (size_t)M_TOK * 1024 * 2;
constexpr size_t WS_LX = WS_AB + (size_t)M_TOK * 16 * 4;
constexpr size_t WS_LG = WS_LX + (size_t)M_TOK * 512 * 2;
constexpr size_t WS_XC = WS_LG + (size_t)M_TOK * 512 * 2;
constexpr int NUNIT = BATCH * GDN_H * NCH;
constexpr size_t WS_GU = WS_XC + (size_t)M_TOK * 512 * 2;
constexpr size_t WS_GW = WS_GU + (size_t)NUNIT * 64 * 128 * 4;
constexpr size_t WS_GQD = WS_GW + (size_t)NUNIT * 16384;
constexpr size_t WS_GKD = WS_GQD + (size_t)NUNIT * 16384;
constexpr size_t WS_GQK = WS_GKD + (size_t)NUNIT * 16384;
constexpr size_t WS_GL = WS_GQK + (size_t)NUNIT * 8192;
constexpr size_t WS_GO = WS_GL + al256((size_t)NUNIT * 4);
constexpr size_t WS_S5S = WS_GO + (size_t)M_TOK * 1024 * 4;
constexpr size_t WS_HEXT = WS_S5S + (size_t)32 * 256 * 128 * 4;
constexpr size_t WS_YIN = WS_HEXT + (size_t)32 * 256 * 256 * 2;
constexpr size_t WS_YACT = WS_YIN + (size_t)M_TOK * 512 * 4;
constexpr size_t WS_LA = WS_YACT + (size_t)M_TOK * 512 * 2;
constexpr size_t WS_LB = WS_LA + (size_t)M_TOK * 512 * 4;
constexpr size_t WS_CA = WS_LB + (size_t)M_TOK * 512 * 4;
constexpr size_t WS_CB = WS_CA + (size_t)NCHT * 512 * 4;
constexpr size_t WS_CIN = WS_CB + (size_t)NCHT * 512 * 4;
constexpr size_t WS_CAT = WS_CIN + (size_t)NCHT * 512 * 4;
constexpr size_t WS_END = WS_CAT + (size_t)M_TOK * D_MODEL * 2;
constexpr int CW_BAR = 4096;

constexpr int RING_BYTES = 131072, LDSCTL_OFF = RING_BYTES, MISC_OFF = LDSCTL_OFF + 320, LDS_BYTES = 147456;
constexpr int NWAVES = 8;

struct Params { const float* in[36]; float* out; unsigned char* ws; };
typedef const __attribute__((address_space(4))) unsigned char* kptr_t;
__device__ __forceinline__ kptr_t karg_base() { kptr_t k = (kptr_t)__builtin_amdgcn_kernarg_segment_ptr(); asm volatile("" : "+s"(k)); return k; }
__device__ __forceinline__ const float* KIN(int i) { return *(const float* const __attribute__((address_space(4)))*)(karg_base() + 8 * i); }
__device__ __forceinline__ float* KOUT() { return *(float* const __attribute__((address_space(4)))*)(karg_base() + 8 * 36); }
__device__ __forceinline__ unsigned char* KWS() { return *(unsigned char* const __attribute__((address_space(4)))*)(karg_base() + 8 * 37); }
struct Frame {
    LAS unsigned char* lds; int tid, lane, wave, G, bid;
    __device__ __forceinline__ int gw() const { return bid * NWAVES + wave; }
    __device__ __forceinline__ int ngw() const { return G * NWAVES; }
    __device__ __forceinline__ int gt() const { return bid * (NWAVES * 64) + tid; }
    __device__ __forceinline__ int ngt() const { return G * NWAVES * 64; }
};
#define LDS_WAIT() asm volatile("s_waitcnt lgkmcnt(0)" ::: "memory")
__device__ __forceinline__ Frame fresh(const Frame& F0) { Frame F = F0; int w = F0.wave; asm volatile("" : "+s"(w)); int ln = (int)__builtin_amdgcn_mbcnt_hi(~0u, __builtin_amdgcn_mbcnt_lo(~0u, 0u)); asm volatile("" : "+v"(ln));
    F.wave = w; F.lane = ln; F.tid = w * 64 + ln;
    int b = blockIdx.x, g = gridDim.x; asm volatile("" : "+s"(b), "+s"(g)); F.bid = b; F.G = g; return F; }

struct MapId { __device__ __forceinline__ int operator()(int n) const { return n; } };
struct MapGU { int half; __device__ __forceinline__ int operator()(int n) const { return 256 * (n >> 7) + 128 * half + (n & 127); } };
struct MapIn { __device__ __forceinline__ int operator()(int n) const { return n < 4608 ? n : (n < 4624 ? 5632 + (n - 4608) : n - 16); } };
template <int K, int N, class Map>
__device__ __forceinline__ void transpose_item(const float* W, bf16_t* WT, LAS float* scr, int item, int lane, const Map map) {
    const int nblk = (N + 31) >> 5, kb = item / nblk, nb = item - kb * nblk, k0 = 64 * kb, n0 = 32 * nb;
    const int nn = n0 + (lane & 31); const bool nok = nn < N;
#pragma unroll 8
    for (int i = 0; i < 32; ++i) { const int kk = 2 * i + (lane >> 5); scr[kk * 33 + (lane & 31)] = nok ? W[(size_t)(k0 + kk) * N + nn] : 0.f; }
    LDS_WAIT(); asm volatile("" ::: "memory");
    const int c = lane & 7;
#pragma unroll
    for (int j = 0; j < 4; ++j) { const int n = (lane >> 3) + 8 * j; const LAS float* s = scr + (8 * c) * 33 + n;
        u32x4 o; o.x = cvt_pk_bf16(s[0 * 33], s[1 * 33]); o.y = cvt_pk_bf16(s[2 * 33], s[3 * 33]); o.z = cvt_pk_bf16(s[4 * 33], s[5 * 33]); o.w = cvt_pk_bf16(s[6 * 33], s[7 * 33]);
        if (n0 + n < N) *(u32x4*)(WT + (size_t)map(n0 + n) * K + k0 + 8 * c) = o; }
    LDS_WAIT(); asm volatile("" ::: "memory");
}
__device__ __forceinline__ void cplx_pow(float lre, float lim, float dt, int d, float& zr, float& zi) {
    const float mag = __expf((float)d * lre * dt);
    const double rev = (double)d * ((double)dt * (double)lim) * 0.15915494309189535;
    const float r = (float)(rev - rint(rev));
    zr = mag * __builtin_amdgcn_cosf(r); zi = mag * __builtin_amdgcn_sinf(r);
}
__device__ __forceinline__ void s5_coef(float lre, float lim, float dt, float& cr, float& ci) {
    const float a = lre * dt; const double rev = ((double)dt * (double)lim) * 0.15915494309189535; const float r = (float)(rev - rint(rev));
    const float cb = __builtin_amdgcn_cosf(r), sb = __builtin_amdgcn_sinf(r), sh = __builtin_amdgcn_sinf(0.5f * r);
    const float er = expm1_neg(a) * cb - 2.0f * sh * sh, ei = __expf(a) * sb;
    const float den = rcpf_(lre * lre + lim * lim);
    cr = (er * lre + ei * lim) * den; ci = (ei * lre - er * lim) * den;
}
__device__ __forceinline__ void phase_convert(const Frame& F, int l) {
    unsigned char* ws = KWS();
    LAS float* scr = (LAS float*)(F.lds + F.wave * 8448);
    const int gw = F.gw(), NGW = F.ngw();
    constexpr int I_GU = (D_MODEL / 64) * (D_FF / 32), I_DN = (D_FF / 64) * (D_MODEL / 32), I_IN = (D_MODEL / 64) * ((D_IN + 31) / 32), I_OUT = (D_MODEL / 64) * (D_MODEL / 32), I_GLU = (512 / 64) * (512 / 32);
    constexpr int NITEMS = 4 * I_GU + 2 * I_DN + I_IN + I_OUT + I_GLU;
    const size_t oGU = (size_t)l * D_MODEL * D_FF, oIN = (size_t)l * D_MODEL * D_IN, oOUT = (size_t)l * D_MODEL * D_MODEL, oGLU = (size_t)l * 512 * 512;
    for (int it = gw; it < NITEMS; it += NGW) {
        int r = it;
        if (r < I_GU) { transpose_item<D_MODEL, D_FF>(KIN(1) + oGU, (bf16_t*)(ws + WS_WGU1), scr, r, F.lane, MapGU{0}); continue; } r -= I_GU;
        if (r < I_GU) { transpose_item<D_MODEL, D_FF>(KIN(2) + oGU, (bf16_t*)(ws + WS_WGU1), scr, r, F.lane, MapGU{1}); continue; } r -= I_GU;
        if (r < I_DN) { transpose_item<D_FF, D_MODEL>(KIN(3) + oGU, (bf16_t*)(ws + WS_WD1), scr, r, F.lane, MapId{}); continue; } r -= I_DN;
        if (r < I_GU) { transpose_item<D_MODEL, D_FF>(KIN(31) + oGU, (bf16_t*)(ws + WS_WGU2), scr, r, F.lane, MapGU{0}); continue; } r -= I_GU;
        if (r < I_GU) { transpose_item<D_MODEL, D_FF>(KIN(32) + oGU, (bf16_t*)(ws + WS_WGU2), scr, r, F.lane, MapGU{1}); continue; } r -= I_GU;
        if (r < I_DN) { transpose_item<D_FF, D_MODEL>(KIN(33) + oGU, (bf16_t*)(ws + WS_WD2), scr, r, F.lane, MapId{}); continue; } r -= I_DN;
        if (r < I_IN) { transpose_item<D_MODEL, D_IN>(KIN(6) + oIN, (bf16_t*)(ws + WS_WIN), scr, r, F.lane, MapIn{}); continue; } r -= I_IN;
        if (r < I_OUT) { transpose_item<D_MODEL, D_MODEL>(KIN(28) + oOUT, (bf16_t*)(ws + WS_WOUT), scr, r, F.lane, MapId{}); continue; } r -= I_OUT;
        transpose_item<512, 512>(KIN(15) + oGLU, (bf16_t*)(ws + WS_WGLU), scr, r, F.lane, MapId{});
    }
    const int gt = F.gt(), NGT = F.ngt();
    { const float* wa = KIN(23) + (size_t)l * 8 * 64 * 64; const float* wx = KIN(25) + (size_t)l * 8 * 64 * 64; bf16_t* WL = (bf16_t*)(ws + WS_WLRU);
      for (int idx = gt; idx < 1024 * 512; idx += NGT) { const int row = idx >> 9, k = idx & 511, pn = row >> 8, bj = (row >> 7) & 1, j = row & 127, c = 128 * pn + j, h = c >> 6;
          float v = 0.f; if ((k >> 6) == h) v = (bj ? wx : wa)[(h * 64 + (k & 63)) * 64 + (c & 63)];
          WL[idx] = (bf16_t)f2bf(v); } }
    const float* lre_ = KIN(7) + l * 2048; const float* lim_ = KIN(8) + l * 2048; const float* bre = KIN(9) + (size_t)l * 32768; const float* bim = KIN(10) + (size_t)l * 32768;
    const float* cre = KIN(11) + (size_t)l * 32768; const float* cim = KIN(12) + (size_t)l * 32768; const float* lstep = KIN(14) + l * 32;
    { bf16_t* KT = (bf16_t*)(ws + WS_KTAB);
      for (int idx = gt; idx < 32 * 16 * 128 * 16; idx += NGT) { const int g = idx >> 15, p = (idx >> 11) & 15, e = (idx >> 4) & 127, q = idx & 15;
          float acc = 0.f;
          if (e < 64) { const int d = 63 - e; const float dt = __expf(lstep[g]);
              for (int n = 0; n < 64; ++n) { const float lre = fminf(lre_[g * 64 + n], -1e-4f), lim = lim_[g * 64 + n];
                  float zr, zi, cr, ci; cplx_pow(lre, lim, dt, d, zr, zi); s5_coef(lre, lim, dt, cr, ci);
                  const float br = bre[(g * 64 + n) * 16 + q], bi = bim[(g * 64 + n) * 16 + q];
                  const float bbr = cr * br - ci * bi, bbi = cr * bi + ci * br;
                  const float wr_ = zr * bbr - zi * bbi, wi_ = zr * bbi + zi * bbr;
                  const float c_r = cre[(g * 16 + p) * 64 + n], c_i = cim[(g * 16 + p) * 64 + n];
                  acc += c_r * wr_ - c_i * wi_; } }
          KT[idx] = (bf16_t)f2bf(acc); } }
    { bf16_t* PT = (bf16_t*)(ws + WS_PTAB);
      for (int idx = gt; idx < 32 * 128 * 1024; idx += NGT) { const int g = idx >> 17, r = (idx >> 10) & 127, k = idx & 1023, n = r >> 1, ri = r & 1, s = k >> 4, q = k & 15;
          const float dt = __expf(lstep[g]); const float lre = fminf(lre_[g * 64 + n], -1e-4f), lim = lim_[g * 64 + n];
          float zr, zi, cr, ci; cplx_pow(lre, lim, dt, 63 - s, zr, zi); s5_coef(lre, lim, dt, cr, ci);
          const float br = bre[(g * 64 + n) * 16 + q], bi = bim[(g * 64 + n) * 16 + q];
          const float bbr = cr * br - ci * bi, bbi = cr * bi + ci * br;
          const float v = ri ? (zr * bbi + zi * bbr) : (zr * bbr - zi * bbi);
          PT[((size_t)g * 256 + r) * 1024 + k] = (bf16_t)f2bf(v); } }
    { bf16_t* QT = (bf16_t*)(ws + WS_QTAB);
      for (int idx = gt; idx < 32 * 1024 * 256; idx += NGT) { const int g = idx >> 18, row = (idx >> 8) & 1023, r = idx & 255, t = row >> 4, p = row & 15;
          float v = 0.f;
          if (r < 128) { const int n = r >> 1, ri = r & 1; const float dt = __expf(lstep[g]); const float lre = fminf(lre_[g * 64 + n], -1e-4f), lim = lim_[g * 64 + n];
              float zr, zi; cplx_pow(lre, lim, dt, t + 1, zr, zi);
              const float c_r = cre[(g * 16 + p) * 64 + n], c_i = cim[(g * 16 + p) * 64 + n];
              v = ri ? -(c_r * zi + c_i * zr) : (c_r * zr - c_i * zi); }
          QT[idx] = (bf16_t)f2bf(v); } }
}
__device__ __forceinline__ void phase_x_to_bf16(const Frame& F, const float* x, bf16_t* XN) {
    const size_t n8 = (size_t)M_TOK * D_MODEL / 8;
    for (size_t i = F.gt(); i < n8; i += F.ngt()) { const f32x4 a = *(const f32x4*)(x + i * 8), b = *(const f32x4*)(x + i * 8 + 4);
        u32x4 w; w.x = cvt_pk_bf16(a[0], a[1]); w.y = cvt_pk_bf16(a[2], a[3]); w.z = cvt_pk_bf16(b[0], b[1]); w.w = cvt_pk_bf16(b[2], b[3]); *(u32x4*)(XN + i * 8) = w; }
}
__device__ __forceinline__ void phase_ln(const Frame& F, float* X, const float* gam, const float* bet, bf16_t* XN) {
    f32x4 gv[8], bv[8];
#pragma unroll
    for (int j = 0; j < 8; ++j) { gv[j] = *(const f32x4*)(gam + 4 * F.lane + 256 * j); bv[j] = *(const f32x4*)(bet + 4 * F.lane + 256 * j); }
    for (int m = F.gw(); m < M_TOK; m += F.ngw()) {
        float* xr = X + (size_t)m * D_MODEL + 4 * F.lane; f32x4 v[8]; float s = 0.f;
#pragma unroll
        for (int j = 0; j < 8; ++j) { v[j] = *(const f32x4*)(xr + 256 * j); s += (v[j][0] + v[j][1]) + (v[j][2] + v[j][3]); }
        const float mean = wave_sum(s) * (1.f / D_MODEL); float s2 = 0.f;
#pragma unroll
        for (int j = 0; j < 8; ++j) { v[j] = v[j] - mean; s2 += (v[j][0] * v[j][0] + v[j][1] * v[j][1]) + (v[j][2] * v[j][2] + v[j][3] * v[j][3]); }
        const float rstd = rsqf_(wave_sum(s2) * (1.f / D_MODEL) + LN_EPS);
        bf16_t* xo = XN + (size_t)m * D_MODEL + 4 * F.lane;
#pragma unroll
        for (int j = 0; j < 8; ++j) { const f32x4 o = v[j] * rstd * gv[j] + bv[j]; *(f32x4*)(xr + 256 * j) = o;
            u32x2 w; w.x = cvt_pk_bf16(o[0], o[1]); w.y = cvt_pk_bf16(o[2], o[3]); *(u32x2*)(xo + 256 * j) = w; }
    }
}

__device__ __forceinline__ void phase_lru_conv(const Frame& F, const bf16_t* LX, const float* cw, const float* cb, bf16_t* XC) {
    const int nitems = M_TOK * 64;
    for (int it = F.gt(); it < nitems; it += F.ngt()) {
        const int row = it >> 6, c8 = (it & 63) * 8, t = row & (SEQ - 1);
        float acc[8];
#pragma unroll
        for (int e = 0; e < 8; ++e) acc[e] = cb[c8 + e];
#pragma unroll
        for (int k = 0; k < 4; ++k) { const int dt_ = 3 - k; if (t - dt_ >= 0) {
                const u32x4 xx = *(const u32x4*)(LX + (size_t)(row - dt_) * LRU_W + c8);
                const f32x4 w0 = *(const f32x4*)(cw + k * LRU_W + c8), w1 = *(const f32x4*)(cw + k * LRU_W + c8 + 4);
                acc[0] += w0[0] * bflo(xx.x); acc[1] += w0[1] * bfhi(xx.x); acc[2] += w0[2] * bflo(xx.y); acc[3] += w0[3] * bfhi(xx.y);
                acc[4] += w1[0] * bflo(xx.z); acc[5] += w1[1] * bfhi(xx.z); acc[6] += w1[2] * bflo(xx.w); acc[7] += w1[3] * bfhi(xx.w); } }
        u32x4 w; w.x = cvt_pk_bf16(acc[0], acc[1]); w.y = cvt_pk_bf16(acc[2], acc[3]); w.z = cvt_pk_bf16(acc[4], acc[5]); w.w = cvt_pk_bf16(acc[6], acc[7]);
        *(u32x4*)(XC + (size_t)row * LRU_W + c8) = w;
    }
}
__device__ __forceinline__ void phase_lru_p1(const Frame& F, const float* LA, const float* LB, float* CA, float* CB) {
    for (int it = F.gt(); it < NCHT * LRU_W; it += F.ngt()) {
        const int bc = it >> 9, ch = it & 511; const size_t base = (size_t)bc * CH * LRU_W + ch;
        float A = 1.f, B = 0.f;
#pragma unroll 8
        for (int t = 0; t < CH; ++t) { const float a = LA[base + (size_t)t * LRU_W], b = LB[base + (size_t)t * LRU_W]; B = a * B + b; A *= a; }
        CA[it] = A; CB[it] = B;
    }
}
__device__ __forceinline__ void phase_lru_p2(const Frame& F, const float* CA, const float* CB, float* CIN) {
    const int it = F.gt();
    if (it < BATCH * LRU_W) { const int b = it >> 9, ch = it & 511; float h = 0.f;
        for (int c0 = 0; c0 < NCH; c0 += 16) { float av[16], bv[16];
#pragma unroll
            for (int k = 0; k < 16; ++k) { const int o = (b * NCH + c0 + k) * LRU_W + ch; av[k] = CA[o]; bv[k] = CB[o]; }
#pragma unroll
            for (int k = 0; k < 16; ++k) { const int o = (b * NCH + c0 + k) * LRU_W + ch; CIN[o] = h; h = av[k] * h + bv[k]; } } }
}
__device__ __forceinline__ void phase_lru_p3(const Frame& F, const float* LA, const float* LB, const float* CIN, const bf16_t* LG, bf16_t* CAT) {
    for (int it = F.gt(); it < NCHT * LRU_W; it += F.ngt()) {
        const int bc = it >> 9, ch = it & 511; const size_t row0 = (size_t)bc * CH;
        float h = CIN[it];
#pragma unroll 8
        for (int t = 0; t < CH; ++t) { const size_t row = row0 + t; h = LA[row * LRU_W + ch] * h + LB[row * LRU_W + ch];
            const float gt_ = bf2f(LG[row * LRU_W + ch]); CAT[row * D_MODEL + 1536 + ch] = (bf16_t)f2bf(h * gelu_tanh(gt_)); }
    }
}

__device__ __forceinline__ void phase_s5_carry(int tix, const float* lre_, const float* lim_, const float* lstep, const float* S5S, bf16_t* HEXT) {
    if (tix < 0 || tix >= BATCH * 32 * 64) return;
    const int b = tix >> 11, g = (tix >> 6) & 31, n = tix & 63;
    const float dt = __expf(lstep[g]); const float lre = fminf(lre_[g * 64 + n], -1e-4f), lim = lim_[g * 64 + n];
    float ar, ai; cplx_pow(lre, lim, dt, 64, ar, ai);
    float hr = 0.f, hi = 0.f;
    for (int c0 = 0; c0 < NCH; c0 += 16) {
        f32x2 sv[16];
#pragma unroll
        for (int k = 0; k < 16; ++k) sv[k] = *(const f32x2*)(S5S + ((size_t)g * NCHT + b * NCH + c0 + k) * 128 + 2 * n);
#pragma unroll
        for (int k = 0; k < 16; ++k) { const size_t rowi = (size_t)g * NCHT + b * NCH + c0 + k;
            *(unsigned*)(HEXT + rowi * 256 + 2 * n) = cvt_pk_bf16(hr, hi); *(unsigned*)(HEXT + rowi * 256 + 128 + 2 * n) = 0u;
            const float nr = ar * hr - ai * hi + sv[k][0], ni = ar * hi + ai * hr + sv[k][1]; hr = nr; hi = ni; } }
}

__device__ __forceinline__ int fragoff(int m, int k, int KS) { const int idx = k & 31, g = (idx & 15) >> 2, j = (idx & 3) + 4 * (idx >> 4); return ((((m >> 4) * KS + (k >> 5)) * 64) + 16 * g + (m & 15)) * 8 + j; }
__device__ __forceinline__ bf16x8 ldsfrag(LAS unsigned char* lds, int base, int stride, int row0, int k0, int lane) { return *(const LAS bf16x8*)(lds + base + (row0 + (lane & 15)) * stride + (k0 + 8 * (lane >> 4)) * 2); }
constexpr int GP_QS = 0, GP_KS = 18432, GP_VT = 36864, GP_KBT = 57344, GP_ST = 77824, GP_TB = 110592, GP_MISC = 120832, GP_TMP = GP_MISC + 1024;
__device__ __forceinline__ void gdn_prep_unit(const Frame& F, int l, int unit) {
    unsigned char* ws = KWS(); LAS unsigned char* lds = F.lds;
    const int tid = F.tid, lane = F.lane, wave = F.wave;
    const int c = unit & (NCH - 1), bh = unit >> 7, h = bh & 7, b = bh >> 3, t0 = c * CH; const size_t tok0 = (size_t)b * SEQ + t0;
    const bf16_t* QKV = (const bf16_t*)(ws + WS_QKV); const float* AB = (const float*)(ws + WS_AB);
    LAS float* gcs = (LAS float*)(lds + GP_MISC); LAS float* betas = gcs + 64; LAS float* egs = gcs + 128; LAS float* egls = gcs + 192;
    LAS float* Mf = (LAS float*)(lds + GP_ST); LAS float* Xf = (LAS float*)(lds + GP_KS); LAS float* Tmp = (LAS float*)(lds + GP_TMP);
    if (wave == 0) {
        const float al = AB[(tok0 + lane) * 16 + h], bl = AB[(tok0 + lane) * 16 + 8 + h];
        float g = -__expf(KIN(18)[l * 8 + h]) * softplusf_(al + KIN(19)[l * 8 + h]);
#pragma unroll
        for (int o = 1; o < 64; o <<= 1) { const float t = __shfl_up(g, o); if (lane >= o) g += t; }
        const float glast = __shfl(g, 63);
        gcs[lane] = g; betas[lane] = sigmoidf_(bl); egs[lane] = __expf(g); egls[lane] = __expf(glast - g);
        if (lane == 0) ((float*)(ws + WS_GL))[unit] = __expf(glast);
    }
    __syncthreads();
    {
        const float* convw = KIN(17) + (size_t)l * 4 * 3072;
        float cw[3][4][2];
#pragma unroll
        for (int sg = 0; sg < 3; ++sg)
#pragma unroll
            for (int k = 0; k < 4; ++k) { const f32x2 w = *(const f32x2*)(convw + k * 3072 + sg * 1024 + h * 128 + 2 * lane); cw[sg][k][0] = w[0]; cw[sg][k][1] = w[1]; }
        float xw[3][3][2];
        const int i0 = wave * 8;
#pragma unroll
        for (int j = 0; j < 3; ++j) { const int tt = t0 + i0 - 3 + j;
#pragma unroll
            for (int sg = 0; sg < 3; ++sg) { unsigned v = 0u; if (tt >= 0) v = *(const unsigned*)(QKV + ((size_t)b * SEQ + tt) * 3072 + sg * 1024 + h * 128 + 2 * lane); xw[sg][j][0] = bflo(v); xw[sg][j][1] = bfhi(v); } }
#pragma unroll
        for (int ii = 0; ii < 8; ++ii) { const int i = i0 + ii; float y[3][2];
#pragma unroll
            for (int sg = 0; sg < 3; ++sg) { const unsigned v = *(const unsigned*)(QKV + (tok0 + i) * 3072 + sg * 1024 + h * 128 + 2 * lane); const float x0 = bflo(v), x1 = bfhi(v);
                y[sg][0] = siluf_(cw[sg][0][0] * xw[sg][0][0] + cw[sg][1][0] * xw[sg][1][0] + cw[sg][2][0] * xw[sg][2][0] + cw[sg][3][0] * x0);
                y[sg][1] = siluf_(cw[sg][0][1] * xw[sg][0][1] + cw[sg][1][1] * xw[sg][1][1] + cw[sg][2][1] * xw[sg][2][1] + cw[sg][3][1] * x1);
                xw[sg][0][0] = xw[sg][1][0]; xw[sg][0][1] = xw[sg][1][1]; xw[sg][1][0] = xw[sg][2][0]; xw[sg][1][1] = xw[sg][2][1]; xw[sg][2][0] = x0; xw[sg][2][1] = x1; }
            const float ssq = wave_sum(y[0][0] * y[0][0] + y[0][1] * y[0][1]), ssk = wave_sum(y[1][0] * y[1][0] + y[1][1] * y[1][1]);
            const float rq = rsqf_(ssq + RMS_EPS) * 0.08838834764831845f, rk = rsqf_(ssk + RMS_EPS);
            const float q0 = y[0][0] * rq, q1 = y[0][1] * rq, k0 = y[1][0] * rk, k1 = y[1][1] * rk;
            const float be = betas[i], eg = egs[i], egl = egls[i];
            *(LAS unsigned*)(lds + GP_QS + i * 288 + lane * 4) = cvt_pk_bf16(q0, q1);
            *(LAS unsigned*)(lds + GP_KS + i * 288 + lane * 4) = cvt_pk_bf16(k0, k1);
            *(LAS bf16_t*)(lds + GP_VT + (2 * lane) * 160 + i * 2) = (bf16_t)f2bf(y[2][0] * be); *(LAS bf16_t*)(lds + GP_VT + (2 * lane + 1) * 160 + i * 2) = (bf16_t)f2bf(y[2][1] * be);
            *(LAS bf16_t*)(lds + GP_KBT + (2 * lane) * 160 + i * 2) = (bf16_t)f2bf(k0 * be * eg); *(LAS bf16_t*)(lds + GP_KBT + (2 * lane + 1) * 160 + i * 2) = (bf16_t)f2bf(k1 * be * eg);
            *(LAS unsigned*)(lds + GP_ST + fragoff(i, 2 * lane, 4) * 2) = cvt_pk_bf16(q0 * eg, q1 * eg);
            *(LAS bf16_t*)(lds + GP_ST + 16384 + fragoff(2 * lane, i, 2) * 2) = (bf16_t)f2bf(k0 * egl);
            *(LAS bf16_t*)(lds + GP_ST + 16384 + fragoff(2 * lane + 1, i, 2) * 2) = (bf16_t)f2bf(k1 * egl);
        }
    }
    __syncthreads();
    {
        u32x4* dq = (u32x4*)(ws + WS_GQD + (size_t)unit * 16384); u32x4* dk = (u32x4*)(ws + WS_GKD + (size_t)unit * 16384);
        const LAS u32x4* sq = (const LAS u32x4*)(lds + GP_ST); const LAS u32x4* sk = (const LAS u32x4*)(lds + GP_ST + 16384);
        dq[tid] = sq[tid]; dq[tid + 512] = sq[tid + 512]; dk[tid] = sk[tid]; dk[tid + 512] = sk[tid + 512];
    }
    __syncthreads();
    {
        const int ti = wave >> 1, tj0 = (wave & 1) * 2;
        f32x4 kk[2], qk[2];
#pragma unroll
        for (int jj = 0; jj < 2; ++jj) { kk[jj] = (f32x4){0.f, 0.f, 0.f, 0.f}; qk[jj] = (f32x4){0.f, 0.f, 0.f, 0.f}; }
#pragma unroll
        for (int s = 0; s < 4; ++s) { const bf16x8 aK = ldsfrag(lds, GP_KS, 288, 16 * ti, 32 * s, lane), aQ = ldsfrag(lds, GP_QS, 288, 16 * ti, 32 * s, lane);
#pragma unroll
            for (int jj = 0; jj < 2; ++jj) { const bf16x8 bK = ldsfrag(lds, GP_KS, 288, 16 * (tj0 + jj), 32 * s, lane);
                kk[jj] = __builtin_amdgcn_mfma_f32_16x16x32_bf16(aK, bK, kk[jj], 0, 0, 0); qk[jj] = __builtin_amdgcn_mfma_f32_16x16x32_bf16(aQ, bK, qk[jj], 0, 0, 0); } }
        LDS_WAIT(); __syncthreads();
#pragma unroll
        for (int jj = 0; jj < 2; ++jj)
#pragma unroll
            for (int r = 0; r < 4; ++r) { const int ii = 16 * ti + 4 * (lane >> 4) + r, jx = 16 * (tj0 + jj) + (lane & 15);
                const float dec = (ii >= jx) ? __expf(gcs[ii] - gcs[jx]) : 0.f;
                Mf[ii * 64 + jx] = (ii > jx) ? betas[ii] * kk[jj][r] * dec : 0.f;
                *(LAS bf16_t*)(lds + GP_ST + 16384 + fragoff(ii, jx, 2) * 2) = (bf16_t)f2bf(qk[jj][r] * dec); }
    }
    __syncthreads();
    {
        for (int e = tid; e < 6 * 256; e += 512) { const int blk = e >> 8, i = (e >> 4) & 15, j = e & 15; const int br = blk < 3 ? 0 : (blk < 5 ? 1 : 2), bc = blk < 3 ? blk + 1 : (blk < 5 ? blk - 1 : 3);
            Xf[(16 * br + i) * 64 + 16 * bc + j] = 0.f; }
        if (wave == 0) { const int bb = lane >> 4, cc = lane & 15; float x[16];
#pragma unroll
            for (int i = 0; i < 16; ++i) { float s = (i == cc) ? 1.f : 0.f;
#pragma unroll
                for (int j = 0; j < i; ++j) s -= Mf[(16 * bb + i) * 64 + 16 * bb + j] * x[j];
                x[i] = s; }
#pragma unroll
            for (int i = 0; i < 16; ++i) Xf[(16 * bb + i) * 64 + 16 * bb + cc] = x[i]; }
    }
    __syncthreads();
    { const int pr = tid >> 8, i = (tid >> 4) & 15, j = tid & 15, lo = 32 * pr, hi = lo + 16; float s = 0.f;
#pragma unroll
      for (int k = 0; k < 16; ++k) s += Mf[(hi + i) * 64 + lo + k] * Xf[(lo + k) * 64 + lo + j];
      Tmp[pr * 256 + i * 16 + j] = s; }
    __syncthreads();
    { const int pr = tid >> 8, i = (tid >> 4) & 15, j = tid & 15, lo = 32 * pr, hi = lo + 16; float s = 0.f;
#pragma unroll
      for (int k = 0; k < 16; ++k) s += Xf[(hi + i) * 64 + hi + k] * Tmp[pr * 256 + k * 16 + j];
      Xf[(hi + i) * 64 + lo + j] = -s; }
    __syncthreads();
#pragma unroll
    for (int rep = 0; rep < 2; ++rep) { const int e = tid + 512 * rep, i = e >> 5, j = e & 31; float s = 0.f;
#pragma unroll 8
        for (int k = 0; k < 32; ++k) s += Mf[(32 + i) * 64 + k] * Xf[k * 64 + j];
        Tmp[i * 32 + j] = s; }
    __syncthreads();
#pragma unroll
    for (int rep = 0; rep < 2; ++rep) { const int e = tid + 512 * rep, i = e >> 5, j = e & 31; float s = 0.f;
#pragma unroll 8
        for (int k = 0; k < 32; ++k) s += Xf[(32 + i) * 64 + 32 + k] * Tmp[k * 32 + j];
        Xf[(32 + i) * 64 + j] = -s; }
    __syncthreads();
    { const int row = tid >> 3, c0 = (tid & 7) * 8; const LAS float* s = Xf + row * 64 + c0;
      u32x4 w; w.x = cvt_pk_bf16(s[0], s[1]); w.y = cvt_pk_bf16(s[2], s[3]); w.z = cvt_pk_bf16(s[4], s[5]); w.w = cvt_pk_bf16(s[6], s[7]);
      *(LAS u32x4*)(lds + GP_TB + row * 160 + c0 * 2) = w; }
    __syncthreads();
    {
        float* GU = (float*)(ws + WS_GU);
#pragma unroll
        for (int i = 0; i < 4; ++i) { f32x4 au = (f32x4){0.f, 0.f, 0.f, 0.f}, aw = (f32x4){0.f, 0.f, 0.f, 0.f};
#pragma unroll
            for (int s = 0; s < 2; ++s) { const bf16x8 a = ldsfrag(lds, GP_TB, 160, 16 * i, 32 * s, lane);
                au = __builtin_amdgcn_mfma_f32_16x16x32_bf16(a, ldsfrag(lds, GP_VT, 160, 16 * wave, 32 * s, lane), au, 0, 0, 0);
                aw = __builtin_amdgcn_mfma_f32_16x16x32_bf16(a, ldsfrag(lds, GP_KBT, 160, 16 * wave, 32 * s, lane), aw, 0, 0, 0); }
            *(f32x4*)(GU + ((((size_t)unit * 8 + wave) * 4 + i) * 64 + lane) * 4) = au;
#pragma unroll
            for (int r = 0; r < 4; ++r) *(LAS bf16_t*)(lds + GP_QS + fragoff(16 * i + 4 * (lane >> 4) + r, 16 * wave + (lane & 15), 4) * 2) = (bf16_t)f2bf(aw[r]); }
    }
    __syncthreads();
    {
        u32x4* dw = (u32x4*)(ws + WS_GW + (size_t)unit * 16384); u32x4* dq = (u32x4*)(ws + WS_GQK + (size_t)unit * 8192);
        const LAS u32x4* sw = (const LAS u32x4*)(lds + GP_QS); const LAS u32x4* sq = (const LAS u32x4*)(lds + GP_ST + 16384);
        dw[tid] = sw[tid]; dw[tid + 512] = sw[tid + 512]; dq[tid] = sq[tid];
    }
    __syncthreads();
}
__device__ __forceinline__ bf16x8 pack2(const f32x4& a, const f32x4& b) { u32x4 w; w.x = cvt_pk_bf16(a[0], a[1]); w.y = cvt_pk_bf16(a[2], a[3]); w.z = cvt_pk_bf16(b[0], b[1]); w.w = cvt_pk_bf16(b[2], b[3]); return __builtin_bit_cast(bf16x8, w); }
constexpr int SC_BUF = 61440, SC_W = 0, SC_QD = 16384, SC_KD = 32768, SC_QK = 49152, SC_U = 57344, SC_OST = 2 * SC_BUF;
__device__ __forceinline__ void gdn_scan_wg(LAS unsigned char* lds, int wave, int lane, int bh, int sl) {
    unsigned char* ws = KWS(); const int b = bh >> 3, h = bh & 7;
    const int role = wave - 1;
    const unsigned char* src0 = ws; size_t ustr0 = 16384; int off0 = 0, n0 = 8;
    if (role == 0 || role == 1) { src0 = ws + WS_GW + (role & 1) * 8192; off0 = SC_W + (role & 1) * 8192; }
    else if (role == 2 || role == 3) { src0 = ws + WS_GQD + (role & 1) * 8192; off0 = SC_QD + (role & 1) * 8192; }
    else if (role == 4 || role == 5) { src0 = ws + WS_GKD + (role & 1) * 8192; off0 = SC_KD + (role & 1) * 8192; }
    else if (role == 6) { src0 = ws + WS_GQK; ustr0 = 8192; off0 = SC_QK; }
    const unsigned char* srcU = ws + WS_GU + (size_t)sl * 4096;
#define SC_LOAD(c_) do { const int unit_ = bh * NCH + (c_); const int bo_ = ((c_) & 1) * SC_BUF; \
        const unsigned char* p_ = src0 + (size_t)unit_ * ustr0 + lane * 16; \
        _Pragma("unroll") for (int k_ = 0; k_ < 8; ++k_) __builtin_amdgcn_global_load_lds((const unsigned*)(p_ + k_ * 1024), (LAS unsigned*)(lds + bo_ + off0 + k_ * 1024), 16, 0, 0); \
        if (role == 6) { const unsigned char* q_ = srcU + (size_t)unit_ * 32768 + lane * 16; \
            _Pragma("unroll") for (int k_ = 0; k_ < 4; ++k_) __builtin_amdgcn_global_load_lds((const unsigned*)(q_ + k_ * 1024), (LAS unsigned*)(lds + bo_ + SC_U + k_ * 1024), 16, 0, 0); } } while (0)
    f32x4 S[8];
#pragma unroll
    for (int j = 0; j < 8; ++j) S[j] = (f32x4){0.f, 0.f, 0.f, 0.f};
    if (wave != 0) { SC_LOAD(0); asm volatile("s_waitcnt vmcnt(0)" ::: "memory"); }
    asm volatile("" ::: "memory"); __builtin_amdgcn_s_barrier(); asm volatile("" ::: "memory");
    float* GO = (float*)(ws + WS_GO);
    for (int c = 0; c < NCH; ++c) {
        if (wave != 0) {
            if (c + 1 < NCH) { SC_LOAD(c + 1); asm volatile("s_waitcnt vmcnt(0)" ::: "memory"); }
        } else {
            const int unit = bh * NCH + c;
            LAS unsigned char* bb = lds + (c & 1) * SC_BUF + lane * 16;
            const float gl = ((const float*)(ws + WS_GL))[unit];
            bf16x8 Sb[4];
#pragma unroll
            for (int s = 0; s < 4; ++s) Sb[s] = pack2(S[2 * s], S[2 * s + 1]);
            f32x4 vn[4], o[4];
#pragma unroll
            for (int i = 0; i < 4; ++i) { f32x4 p = (f32x4){0.f, 0.f, 0.f, 0.f}; o[i] = (f32x4){0.f, 0.f, 0.f, 0.f};
#pragma unroll
                for (int s = 0; s < 4; ++s) { p = __builtin_amdgcn_mfma_f32_16x16x32_bf16(*(const LAS bf16x8*)(bb + SC_W + (i * 4 + s) * 1024), Sb[s], p, 0, 0, 0);
                    o[i] = __builtin_amdgcn_mfma_f32_16x16x32_bf16(*(const LAS bf16x8*)(bb + SC_QD + (i * 4 + s) * 1024), Sb[s], o[i], 0, 0, 0); }
                vn[i] = *(const LAS f32x4*)(bb + SC_U + i * 1024) - p; }
            bf16x8 vb[2];
            vb[0] = pack2(vn[0], vn[1]); vb[1] = pack2(vn[2], vn[3]);
#pragma unroll
            for (int i = 0; i < 4; ++i)
#pragma unroll
                for (int s = 0; s < 2; ++s) o[i] = __builtin_amdgcn_mfma_f32_16x16x32_bf16(*(const LAS bf16x8*)(bb + SC_QK + (i * 2 + s) * 1024), vb[s], o[i], 0, 0, 0);
#pragma unroll
            for (int j = 0; j < 8; ++j) { S[j] = S[j] * gl;
#pragma unroll
                for (int s = 0; s < 2; ++s) S[j] = __builtin_amdgcn_mfma_f32_16x16x32_bf16(*(const LAS bf16x8*)(bb + SC_KD + (j * 2 + s) * 1024), vb[s], S[j], 0, 0, 0); }
            LAS float* ost = (LAS float*)(lds + SC_OST);
#pragma unroll
            for (int i = 0; i < 4; ++i)
#pragma unroll
                for (int r = 0; r < 4; ++r) ost[(16 * i + 4 * (lane >> 4) + r) * 16 + (lane & 15)] = o[i][r];
            LDS_WAIT();
#pragma unroll
            for (int k = 0; k < 4; ++k) { const int row = 16 * k + (lane >> 2); const f32x4 v = *(const LAS f32x4*)(ost + row * 16 + (lane & 3) * 4);
                *(f32x4*)(GO + ((size_t)b * SEQ + c * CH + row) * GDN_W + h * GDN_D + 16 * sl + (lane & 3) * 4) = v; }
            LDS_WAIT();
        }
        asm volatile("" ::: "memory"); __builtin_amdgcn_s_barrier(); asm volatile("" ::: "memory");
    }
#undef SC_LOAD
}
__device__ __forceinline__ void phase_gdn_post(const Frame& F, const float* GO, const bf16_t* Z, const float* ng, bf16_t* CAT) {
    const int d0 = (F.lane & 7) * 16;
    float gv[16];
#pragma unroll
    for (int e = 0; e < 16; ++e) gv[e] = ng[d0 + e];
    for (int m = F.gw(); m < M_TOK; m += F.ngw()) {
        const float* op = GO + (size_t)m * GDN_W + F.lane * 16; float v[16]; float ss = 0.f;
#pragma unroll
        for (int q = 0; q < 4; ++q) { const f32x4 t = *(const f32x4*)(op + 4 * q); v[4 * q] = t[0]; v[4 * q + 1] = t[1]; v[4 * q + 2] = t[2]; v[4 * q + 3] = t[3]; ss += (t[0] * t[0] + t[1] * t[1]) + (t[2] * t[2] + t[3] * t[3]); }
        ss += __shfl_xor(ss, 1); ss += __shfl_xor(ss, 2); ss += __shfl_xor(ss, 4);
        const float rn = rsqf_(ss * (1.0f / GDN_D) + RMS_EPS);
        const u32x4 z0 = *(const u32x4*)(Z + (size_t)m * GDN_W + F.lane * 16), z1 = *(const u32x4*)(Z + (size_t)m * GDN_W + F.lane * 16 + 8);
        const float zz[16] = {bflo(z0.x), bfhi(z0.x), bflo(z0.y), bfhi(z0.y), bflo(z0.z), bfhi(z0.z), bflo(z0.w), bfhi(z0.w), bflo(z1.x), bfhi(z1.x), bflo(z1.y), bfhi(z1.y), bflo(z1.z), bfhi(z1.z), bflo(z1.w), bfhi(z1.w)};
        float o[16];
#pragma unroll
        for (int e = 0; e < 16; ++e) o[e] = v[e] * rn * gv[e] * siluf_(zz[e]);
        u32x4 w0, w1; w0.x = cvt_pk_bf16(o[0], o[1]); w0.y = cvt_pk_bf16(o[2], o[3]); w0.z = cvt_pk_bf16(o[4], o[5]); w0.w = cvt_pk_bf16(o[6], o[7]);
        w1.x = cvt_pk_bf16(o[8], o[9]); w1.y = cvt_pk_bf16(o[10], o[11]); w1.z = cvt_pk_bf16(o[12], o[13]); w1.w = cvt_pk_bf16(o[14], o[15]);
        bf16_t* cp = CAT + (size_t)m * D_MODEL + 512 + F.lane * 16; *(u32x4*)cp = w0; *(u32x4*)(cp + 8) = w1;
    }
}

struct DiagOrder { int nunits, G, c; __device__ bool next(int i, Unit& u) const { if (c < 0) return false; const long L = (long)i * G + c; if (L >= nunits) return false; u.pm = (int)L; u.pn = (int)L; return true; } };
struct GeoS5Intra {
    const char* U5; const char* KT;
    __device__ __forceinline__ int nt() const { return 16; }
    __device__ __forceinline__ int a_voff(int R, int C) const { return (R * 1024 + C) * 2; }
    __device__ __forceinline__ int b_voff(int R, int C) const { return (((R & 15) * 128 - (R >> 4)) * 16 + C) * 2; }
    __device__ __forceinline__ long a_hstep() const { return (long)128 * 1024 * 2; }
    __device__ __forceinline__ long b_hstep() const { return -256; }
    __device__ __forceinline__ const char* a_base(const Unit& u) const { return U5 + (size_t)u.pm * 256 * 1024 * 2; }
    __device__ __forceinline__ const char* b_base(const Unit& u) const { return KT + (size_t)u.pm * (16 * 128 * 16 * 2) + (63 - 16 * u.pn) * 32; }
};
struct GeoS5Inter {
    const char* HX; const char* QT;
    __device__ __forceinline__ int nt() const { return 4; }
    __device__ __forceinline__ int a_voff(int R, int C) const { return (R * 256 + C) * 2; }
    __device__ __forceinline__ int b_voff(int R, int C) const { return (R * 256 + C) * 2; }
    __device__ __forceinline__ long a_hstep() const { return (long)128 * 256 * 2; }
    __device__ __forceinline__ long b_hstep() const { return (long)128 * 256 * 2; }
    __device__ __forceinline__ const char* a_base(const Unit& u) const { return HX + (size_t)u.pm * 256 * 256 * 2; }
    __device__ __forceinline__ const char* b_base(const Unit& u) const { return QT + ((size_t)u.pm * 4 + u.pn) * 256 * 256 * 2; }
};

#define PHASE_FN static __device__ __forceinline__ void
extern __shared__ __attribute__((aligned(16))) unsigned char lds_raw[];
#define UNI(x) x = __builtin_amdgcn_readfirstlane(x)
__device__ __forceinline__ Frame make_frame() { Frame F; F.lds = (LAS unsigned char*)lds_raw;
    int t = threadIdx.x; asm volatile("" : "+v"(t)); F.tid = t; F.lane = t & 63; F.wave = __builtin_amdgcn_readfirstlane(t >> 6);
    int b = blockIdx.x, g = gridDim.x; asm volatile("" : "+s"(b), "+s"(g)); F.bid = b; F.G = g; return F; }
PHASE_FN ph_convert(int l) { UNI(l); const Frame F = make_frame(); unsigned char* const ws = KWS();
    phase_convert(F, l);
    if (l == 0) phase_x_to_bf16(F, KIN(0), (bf16_t*)(ws + WS_XN)); }
PHASE_FN ph_ffn_up(int sb) { UNI(sb); const Frame F = make_frame(); unsigned char* const ws = KWS();
    pg8::GeoStd g{(const char*)(ws + WS_XN), (const char*)(ws + (sb ? WS_WGU2 : WS_WGU1)), D_MODEL, D_MODEL, D_MODEL};
    pg8::StaticOrder S; S.init(M_TOK, 2 * D_FF, F.G, F.bid); EpiSwiGLU E{(bf16_t*)(ws + WS_H)};
    pg8::gemm_phase<pg8::GeoStd, EpiSwiGLU, pg8::StaticOrder, true>(F.lds, F.wave, g, S, E); }
PHASE_FN ph_ffn_down(int sb, int first) { UNI(sb); UNI(first); const Frame F = make_frame(); unsigned char* const ws = KWS();
    pg8::GeoStd g{(const char*)(ws + WS_H), (const char*)(ws + (sb ? WS_WD2 : WS_WD1)), D_FF, D_FF, D_FF};
    float* out = KOUT();
    pg8::StaticOrder S; S.init(M_TOK, D_MODEL, F.G, F.bid); EpiResid E{first ? KIN(0) : out, out, 0.5f};
    pg8::gemm_phase<pg8::GeoStd, EpiResid, pg8::StaticOrder, true>(F.lds, F.wave, g, S, E); }
PHASE_FN ph_ln(int l, int which) { UNI(l); UNI(which); const Frame F = make_frame(); unsigned char* const ws = KWS();
    const float* g = (which == 0 ? KIN(4) : which == 1 ? KIN(29) : KIN(34)) + l * D_MODEL; const float* b = (which == 0 ? KIN(5) : which == 1 ? KIN(30) : KIN(35)) + l * D_MODEL;
    phase_ln(F, KOUT(), g, b, (bf16_t*)(ws + WS_XN)); }
PHASE_FN ph_inproj() { const Frame F = make_frame(); unsigned char* const ws = KWS();
    pg8::GeoStd g{(const char*)(ws + WS_XN), (const char*)(ws + WS_WIN), D_MODEL, D_MODEL, D_MODEL};
    pg8::StaticOrder S; S.init(M_TOK, N_IN_PAD, F.G, F.bid);
    EpiInproj E{(bf16_t*)(ws + WS_U5), (bf16_t*)(ws + WS_QKV), (bf16_t*)(ws + WS_Z), (bf16_t*)(ws + WS_LX), (bf16_t*)(ws + WS_LG), (float*)(ws + WS_AB)};
    pg8::gemm_phase<pg8::GeoStd, EpiInproj, pg8::StaticOrder, true>(F.lds, F.wave, g, S, E); }
PHASE_FN ph_gdn_prep(int l) { UNI(l); const Frame F = make_frame();
    for (int uu = F.bid; uu < NUNIT / 8; uu += F.G)
        for (int u8 = 0; u8 < 8; ++u8) gdn_prep_unit(F, l, uu * 8 + u8); }
PHASE_FN ph_lru_conv(int l) { UNI(l); const Frame F = make_frame(); unsigned char* const ws = KWS();
    phase_lru_conv(F, (const bf16_t*)(ws + WS_LX), KIN(21) + l * 4 * LRU_W, KIN(22) + l * LRU_W, (bf16_t*)(ws + WS_XC)); }
PHASE_FN ph_s5_state() { const Frame F = make_frame(); unsigned char* const ws = KWS();
    pg8::GeoStd g{(const char*)(ws + WS_U5), (const char*)(ws + WS_PTAB), 1024, 1024, 1024};
    DiagOrder S{32, F.G, F.bid}; EpiS5S E{(float*)(ws + WS_S5S)};
    pg8::gemm_phase<pg8::GeoStd, EpiS5S, DiagOrder, false>(F.lds, F.wave, g, S, E); }
PHASE_FN ph_s5_intra() { const Frame F = make_frame(); unsigned char* const ws = KWS();
    GeoS5Intra g{(const char*)(ws + WS_U5), (const char*)(ws + WS_KTAB)};
    pg8::GroupOrder S{128, 4, F.G, F.bid - 32}; EpiS5Intra E{(float*)(ws + WS_YIN)};
    pg8::gemm_phase<GeoS5Intra, EpiS5Intra, pg8::GroupOrder, false>(F.lds, F.wave, g, S, E); }
PHASE_FN ph_gdn_scan() { const Frame F = make_frame();
    const int xcd = F.bid & 7, q = F.bid >> 3; gdn_scan_wg(F.lds, F.wave, F.lane, xcd * 2 + (q >> 3), q & 7); }
PHASE_FN ph_s5_carry_lru_gates(int l) { UNI(l); const Frame F = make_frame(); unsigned char* const ws = KWS();
    phase_s5_carry((F.bid - 128) * (NWAVES * 64) + F.tid, KIN(7) + l * 2048, KIN(8) + l * 2048, KIN(14) + l * 32, (const float*)(ws + WS_S5S), (bf16_t*)(ws + WS_HEXT));
    pg8::GeoStd g{(const char*)(ws + WS_XC), (const char*)(ws + WS_WLRU), LRU_W, LRU_W, LRU_W};
    pg8::StaticOrder S; S.init(M_TOK, 1024, F.G - 128, F.bid - 128);
    EpiLRU E{(const bf16_t*)(ws + WS_XC), KIN(24) + l * LRU_W, KIN(26) + l * LRU_W, KIN(27) + l * LRU_W, (float*)(ws + WS_LA), (float*)(ws + WS_LB)};
    pg8::gemm_phase<pg8::GeoStd, EpiLRU, pg8::StaticOrder, false>(F.lds, F.wave, g, S, E); }
PHASE_FN ph_gdn_post(int l) { UNI(l); const Frame F = make_frame(); unsigned char* const ws = KWS();
    phase_gdn_post(F, (const float*)(ws + WS_GO), (const bf16_t*)(ws + WS_Z), KIN(20) + l * GDN_D, (bf16_t*)(ws + WS_CAT)); }
PHASE_FN ph_s5_inter(int l) { UNI(l); const Frame F = make_frame(); unsigned char* const ws = KWS();
    GeoS5Inter g{(const char*)(ws + WS_HEXT), (const char*)(ws + WS_QTAB)};
    pg8::GroupOrder S{128, 4, F.G, F.bid}; EpiS5Inter E{(const float*)(ws + WS_YIN), (const bf16_t*)(ws + WS_U5), KIN(13) + l * S5_W, (bf16_t*)(ws + WS_YACT)};
    pg8::gemm_phase<GeoS5Inter, EpiS5Inter, pg8::GroupOrder, false>(F.lds, F.wave, g, S, E); }
PHASE_FN ph_lru_p1() { const Frame F = make_frame(); unsigned char* const ws = KWS();
    phase_lru_p1(F, (const float*)(ws + WS_LA), (const float*)(ws + WS_LB), (float*)(ws + WS_CA), (float*)(ws + WS_CB)); }
PHASE_FN ph_s5_glu(int l) { UNI(l); const Frame F = make_frame(); unsigned char* const ws = KWS();
    pg8::GeoStd g{(const char*)(ws + WS_YACT), (const char*)(ws + WS_WGLU), S5_W, S5_W, S5_W};
    pg8::StaticOrder S; S.init(M_TOK, S5_W, F.G, F.bid); EpiGLU E{(const bf16_t*)(ws + WS_YACT), KIN(16) + l * S5_W, (bf16_t*)(ws + WS_CAT)};
    pg8::gemm_phase<pg8::GeoStd, EpiGLU, pg8::StaticOrder, false>(F.lds, F.wave, g, S, E); }
PHASE_FN ph_lru_p2() { Frame F = make_frame(); unsigned char* const ws = KWS();
    if (F.bid >= F.G - 2) { F.bid -= (F.G - 2); phase_lru_p2(F, (const float*)(ws + WS_CA), (const float*)(ws + WS_CB), (float*)(ws + WS_CIN)); } }
PHASE_FN ph_lru_p3() { const Frame F = make_frame(); unsigned char* const ws = KWS();
    phase_lru_p3(F, (const float*)(ws + WS_LA), (const float*)(ws + WS_LB), (const float*)(ws + WS_CIN), (const bf16_t*)(ws + WS_LG), (bf16_t*)(ws + WS_CAT)); }
PHASE_FN ph_outproj() { const Frame F = make_frame(); unsigned char* const ws = KWS();
    pg8::GeoStd g{(const char*)(ws + WS_CAT), (const char*)(ws + WS_WOUT), D_MODEL, D_MODEL, D_MODEL};
    float* out = KOUT();
    pg8::StaticOrder S; S.init(M_TOK, D_MODEL, F.G, F.bid); EpiResid E{out, out, 1.0f};
    pg8::gemm_phase<pg8::GeoStd, EpiResid, pg8::StaticOrder, true>(F.lds, F.wave, g, S, E); }
PHASE_FN ph_grid_bar() { XcdBarrier b; b.bar = (unsigned*)(KWS() + WS_CTL) + CW_BAR; b.x = xb_xcc_id(); b.st = (volatile LAS unsigned*)((LAS unsigned char*)lds_raw + MISC_OFF) + 8; xcd_barrier(b); }

#ifndef PROBE_CONVERT
#define PROBE_CONVERT 1
#endif
#ifndef PROBE_FFNUP
#define PROBE_FFNUP 1
#endif
#ifndef PROBE_MIXER
#define PROBE_MIXER 1
#endif
__global__ void __launch_bounds__(NWAVES * 64, 2) fwd_kernel(Params Pdummy) {
    LAS unsigned char* lds = (LAS unsigned char*)lds_raw;
    for (int u = threadIdx.x; u < (LDS_BYTES - LDSCTL_OFF) / 4; u += NWAVES * 64) ((LAS unsigned*)(lds + LDSCTL_OFF))[u] = 0u;
    __syncthreads();
    LAS unsigned* st = (LAS unsigned*)(lds + MISC_OFF) + 8;
    unsigned* barw = (unsigned*)(KWS() + WS_CTL) + CW_BAR;
    (void)xcd_barrier_post(barw, (volatile LAS unsigned*)st);
    const int bid = blockIdx.x;
#define GRID_BAR() ph_grid_bar()
    for (int l = 0; l < DEPTH; ++l) {
        for (int rep = 0; rep < PROBE_CONVERT; ++rep) { if (rep) GRID_BAR(); ph_convert(l); }
        GRID_BAR();
        for (int sb = 0; sb < 2; ++sb) {
            for (int rep = 0; rep < PROBE_FFNUP; ++rep) { if (rep) GRID_BAR(); ph_ffn_up(sb); }
            GRID_BAR();
            ph_ffn_down(sb, (l == 0 && sb == 0) ? 1 : 0);
            GRID_BAR();
            ph_ln(l, sb ? 2 : 0);
            GRID_BAR();
            if (sb == 0) {
                ph_inproj();
                GRID_BAR();
                for (int rep = 0; rep < PROBE_MIXER; ++rep) {
                if (rep) GRID_BAR();
                ph_gdn_prep(l);
                ph_lru_conv(l);
                ph_s5_state();
                ph_s5_intra();
                GRID_BAR();
                if (bid < 128) ph_gdn_scan(); else ph_s5_carry_lru_gates(l);
                GRID_BAR();
                ph_gdn_post(l);
                ph_s5_inter(l);
                ph_lru_p1();
                GRID_BAR();
                ph_s5_glu(l);
                ph_lru_p2();
                GRID_BAR();
                ph_lru_p3();
                }
                GRID_BAR();
                ph_outproj();
                GRID_BAR();
                ph_ln(l, 1);
                GRID_BAR();
            }
        }
    }
#undef GRID_BAR
}

extern "C" void kernel_launch(void* const* d_in, const int* in_sizes, int n_in, void* d_out, int out_size, void* d_ws, size_t ws_size, hipStream_t stream) {
    static int grid = 0;
    if (grid == 0) {
        if (n_in != 36 || in_sizes[0] != M_TOK * D_MODEL || out_size != M_TOK * D_MODEL || ws_size < WS_END) { fprintf(stderr, "kernel_launch: unexpected shapes (n_in %d, ws %zu < %zu?)\n", n_in, ws_size, (size_t)WS_END); grid = -1; return; }
        int dev = 0, cus = 0, per_cu = 0;
        if (hipGetDevice(&dev) != hipSuccess || hipDeviceGetAttribute(&cus, hipDeviceAttributeMultiprocessorCount, dev) != hipSuccess) { grid = -1; return; }
        if (hipFuncSetAttribute((const void*)fwd_kernel, hipFuncAttributeMaxDynamicSharedMemorySize, LDS_BYTES) != hipSuccess) { fprintf(stderr, "kernel_launch: hipFuncSetAttribute failed\n"); grid = -1; return; }
        if (hipOccupancyMaxActiveBlocksPerMultiprocessor(&per_cu, (const void*)fwd_kernel, NWAVES * 64, LDS_BYTES) != hipSuccess || per_cu < 1) { fprintf(stderr, "kernel_launch: occupancy query reports %d\n", per_cu); }
        (void)hipGetLastError();
        if (cus < 256) { fprintf(stderr, "kernel_launch: needs 256 CUs, device has %d\n", cus); grid = -1; return; }
        grid = 256;
    }
    if (grid < 0) return;
    (void)hipMemsetAsync((char*)d_ws + WS_CTL, 0, CTL_BYTES, stream);
    Params p{};
    for (int i = 0; i < 36; ++i) p.in[i] = (const float*)d_in[i];
    p.out = (float*)d_out; p.ws = (unsigned char*)d_ws;
    hipLaunchKernelGGL(fwd_kernel, dim3(grid), dim3(NWAVES * 64), LDS_BYTES, stream, p);
}
```

```cpp
#include <hip/hip_runtime.h>
#include <cstdio>
#include <cstdint>

#define LAS __attribute__((address_space(3)))
#define GAS __attribute__((address_space(1)))
typedef unsigned short bf16_t;
typedef short bf16x8 __attribute__((ext_vector_type(8)));
typedef float f32x4 __attribute__((ext_vector_type(4)));
typedef float f32x2 __attribute__((ext_vector_type(2)));
typedef unsigned u32x4 __attribute__((ext_vector_type(4)));
typedef unsigned u32x2 __attribute__((ext_vector_type(2)));

constexpr int D_MODEL = 2048, BATCH = 2, SEQ = 8192, DEPTH = 4, M_TOK = BATCH * SEQ;
constexpr int D_FF = 5632, S5_W = 512, S5_G = 32, S5_P = 16, S5_N = 64;
constexpr int GDN_W = 1024, GDN_H = 8, GDN_D = 128, CH = 64, NCH = SEQ / CH  , NCHT = BATCH * NCH  ;
constexpr int LRU_W = 512;
constexpr int D_IN = 5648;
constexpr int N_IN_PAD = 5888;
constexpr float LN_EPS = 1e-5f, RMS_EPS = 1e-6f;
constexpr float DN_ALPHA = 1.6817928305074290f;

__device__ __forceinline__ unsigned cvt_pk_bf16(float lo, float hi) { unsigned r; asm volatile("v_cvt_pk_bf16_f32 %0, %1, %2" : "=v"(r) : "v"(lo), "v"(hi)); return r; }
__device__ __forceinline__ unsigned f2bf(float f) { unsigned u = __builtin_bit_cast(unsigned, f); return (u + 0x7fffu + ((u >> 16) & 1u)) >> 16; }
__device__ __forceinline__ float bf2f(unsigned h) { return __builtin_bit_cast(float, h << 16); }
__device__ __forceinline__ float bflo(unsigned w) { return __builtin_bit_cast(float, w << 16); }
__device__ __forceinline__ float bfhi(unsigned w) { return __builtin_bit_cast(float, w & 0xffff0000u); }
__device__ __forceinline__ float rcpf_(float x) { return __builtin_amdgcn_rcpf(x); }
__device__ __forceinline__ float rsqf_(float x) { return __builtin_amdgcn_rsqf(x); }
__device__ __forceinline__ float sqrtf_(float x) { return __builtin_amdgcn_sqrtf(x); }
__device__ __forceinline__ float sigmoidf_(float x) { return rcpf_(1.0f + __expf(-x)); }
__device__ __forceinline__ float siluf_(float x) { return x * rcpf_(1.0f + __expf(-x)); }
__device__ __forceinline__ float gelu_tanh(float x) { const float u = 0.7978845608028654f * (x + 0.044715f * x * x * x); return x * rcpf_(1.0f + __expf(-2.0f * u)); }
__device__ __forceinline__ float log1p_small(float e) { return e < 0.01f ? e * (1.0f - e * (0.5f - e * (1.0f / 3.0f))) : __logf(1.0f + e); }
__device__ __forceinline__ float softplusf_(float x) { return fmaxf(x, 0.f) + log1p_small(__expf(-fabsf(x))); }
__device__ __forceinline__ float expm1_neg(float z) {
    return fabsf(z) < 0.1f ? z * (1.0f + z * (0.5f + z * ((1.0f / 6.0f) + z * ((1.0f / 24.0f) + z * (1.0f / 120.0f))))) : __expf(z) - 1.0f; }
__device__ __forceinline__ float wave_sum(float v) {
#pragma unroll
    for (int o = 1; o < 64; o <<= 1) v += __shfl_xor(v, o);
    return v;
}

namespace pg8 {
constexpr int BM = 256, BK = 64, HALF = 128, HTB = HALF * BK * 2, STAGE_BYTES = 8 * HTB, NXCD = 8, WGM = 8;
__host__ __device__ __forceinline__ int lds_byte(int r, int c) { const int st = (r >> 4) * 2 + (c >> 5), rr = r & 15, cc = c & 31, ob = rr * 64 + cc * 2; return st * 1024 + (ob ^ (((ob >> 9) & 1) << 5)); }
__host__ __device__ __forceinline__ void stage_rc(int b, int& R, int& C) { const int st = b / 1024, sb = b % 1024, swz = sb ^ (((sb >> 9) & 1) << 5); R = (st >> 1) * 16 + swz / 64; C = (st & 1) * 32 + (swz % 64) / 2; }
__host__ __device__ __forceinline__ int perm32(int rho) { const int n = rho >> 4, i = rho & 15; return 8 * (i >> 2) + 4 * n + (i & 3); }

struct Unit { int pm, pn; };

struct GeoStd {
    const char* A; const char* B; int lda, ldb, K;
    __device__ __forceinline__ int nt() const { return K / BK; }
    __device__ __forceinline__ int a_voff(int R, int C) const { return (R * lda + C) * 2; }
    __device__ __forceinline__ int b_voff(int R, int C) const { return (R * ldb + C) * 2; }
    __device__ __forceinline__ long a_hstep() const { return (long)HALF * lda * 2; }
    __device__ __forceinline__ long b_hstep() const { return (long)HALF * ldb * 2; }
    __device__ __forceinline__ const char* a_base(const Unit& u) const { return A + (size_t)u.pm * BM * lda * 2; }
    __device__ __forceinline__ const char* b_base(const Unit& u) const { return B + (size_t)u.pn * BM * ldb * 2; }
};

struct StaticOrder {
    int nM, nN, nwg, G, c;
    __device__ void init(int M, int N, int G_, int c_) { nM = M / BM; nN = N / BM; nwg = nM * nN; G = G_; c = c_; }
    __device__ bool next(int i, Unit& u) const {
        if (c < 0) return false;
        const long L = (long)i * G + c; if (L >= nwg) return false;
        int wgid = (int)L; { const int q = nwg / NXCD, r = nwg % NXCD, xcd = wgid % NXCD, off = wgid / NXCD; wgid = (xcd < r ? xcd * (q + 1) : r * (q + 1) + (xcd - r) * q) + off; }
        const int nig = WGM * nN, gid = wgid / nig, fm = gid * WGM, gsz = (nM - fm) < WGM ? (nM - fm) : WGM;
        u.pm = fm + ((wgid % nig) % gsz); u.pn = (wgid % nig) / gsz; return true;
    }
};
struct GroupOrder {
    int nunits, per, G, c;
    __device__ bool next(int i, Unit& u) const { if (c < 0) return false; const long L = (long)i * G + c; if (L >= nunits) return false; u.pm = (int)L / per; u.pn = (int)L % per; return true; }
};

template <class Geo, class Epi, class Sched, bool ALIGN_EPI>
__device__ __forceinline__ void gemm_phase(LAS unsigned char* lds, int wave_id, const Geo& g, const Sched& S, const Epi& E) {
    int tid = threadIdx.x; asm volatile("" : "+v"(tid));
    const int wid = __builtin_amdgcn_readfirstlane(tid >> 6), lane = tid & 63, wr = wid >> 2, wc = wid & 3, fr = lane & 15, fq = lane >> 4;
    const int nt = g.nt();
    int voffA[2], voffB[2];
#pragma unroll
    for (int i = 0; i < 2; ++i) { int R, C; stage_rc(tid * 16 + i * 8192, R, C); const int Rb = Epi::PERM ? ((R & ~31) + perm32(R & 31)) : R;
        voffA[i] = g.a_voff(R, C); voffB[i] = g.b_voff(Rb, C); }
    const long kstep = (long)(BK * 2);
    const long hstepA = g.a_hstep(), hstepB = g.b_hstep();
    const unsigned ldsw = (unsigned)wid * 1024u;
    const int aoff = lds_byte(wr * 64 + fr, fq * 8), boff = lds_byte(wc * 32 + fr, fq * 8);
#define PG8_SA(b, h) (((b) * 2 + (h)) * HTB)
#define PG8_SB(b, h) ((4 + (b) * 2 + (h)) * HTB)
#define PG8_STAGE(bufoff, gbase, voff) do { _Pragma("unroll") for (int _i = 0; _i < 2; ++_i) \
        __builtin_amdgcn_global_load_lds((const unsigned*)((const char*)(gbase) + (voff)[_i]), (LAS unsigned*)(lds + (bufoff) + ldsw + _i * 8192), 16, 0, 0); } while (0)
#define PG8_LDA(dst, b, h) do { _Pragma("unroll") for (int m = 0; m < 4; ++m) _Pragma("unroll") for (int k = 0; k < 2; ++k) dst[m][k] = *(const LAS bf16x8*)(lds + PG8_SA(b, h) + aoff + m * 2048 + k * 1024); } while (0)
#define PG8_LDB(dst, b, h) do { _Pragma("unroll") for (int n = 0; n < 2; ++n) _Pragma("unroll") for (int k = 0; k < 2; ++k) dst[n][k] = *(const LAS bf16x8*)(lds + PG8_SB(b, h) + boff + n * 2048 + k * 1024); } while (0)
#define PG8_MMA(ai, bj, At, Bt) do { __builtin_amdgcn_s_setprio(1); _Pragma("unroll") for (int m = 0; m < 4; ++m) _Pragma("unroll") for (int n = 0; n < 2; ++n) _Pragma("unroll") for (int k = 0; k < 2; ++k) \
        acc[ai][bj][m][n] = __builtin_amdgcn_mfma_f32_16x16x32_bf16(Bt[n][k], At[m][k], acc[ai][bj][m][n], 0, 0, 0); __builtin_amdgcn_s_setprio(0); } while (0)
#define PG8_WAIT_V(n) asm volatile("s_waitcnt vmcnt(" #n ")" ::: "memory")
#define PG8_WAIT_L(n) asm volatile("s_waitcnt lgkmcnt(" #n ")" ::: "memory")
#define PG8_BAR __builtin_amdgcn_s_barrier()
#define PG8_SCHED __builtin_amdgcn_sched_barrier(0)
    Unit cur, nxt; int ui = 0;
    if (!S.next(0, cur)) return;
    f32x4 acc[2][2][4][2];
#pragma unroll
    for (int a = 0; a < 2; ++a)
#pragma unroll
        for (int b = 0; b < 2; ++b)
#pragma unroll
            for (int m = 0; m < 4; ++m)
#pragma unroll
                for (int n = 0; n < 2; ++n) acc[a][b][m][n] = (f32x4){0.f, 0.f, 0.f, 0.f};
    bf16x8 At[4][2], B0[2][2], B1[2][2];
    const char* cA = g.a_base(cur); const char* cB = g.b_base(cur);
    PG8_STAGE(PG8_SB(0, 0), cB, voffB); PG8_STAGE(PG8_SB(0, 1), cB + hstepB, voffB); PG8_STAGE(PG8_SA(0, 0), cA, voffA); PG8_STAGE(PG8_SA(0, 1), cA + hstepA, voffA);
    if (wr == 1) PG8_BAR;
    PG8_WAIT_V(2); PG8_BAR;
    PG8_STAGE(PG8_SB(1, 0), cB + kstep, voffB); PG8_STAGE(PG8_SA(1, 0), cA + kstep, voffA); PG8_STAGE(PG8_SB(1, 1), cB + hstepB + kstep, voffB);
    PG8_WAIT_V(6); PG8_BAR;
    for (;;) {
        const bool has_next = S.next(ui + 1, nxt);
        const char* nA = has_next ? g.a_base(nxt) : cA; const char* nB = has_next ? g.b_base(nxt) : cB;
        for (int t = 0; t < nt; t += 2) {
            const bool last = (t == nt - 2);
            const char* a1 = cA + (long)(t + 1) * kstep;
            const char* a2 = last ? nA : cA + (long)(t + 2) * kstep; const char* b2 = last ? nB : cB + (long)(t + 2) * kstep;
            const char* a3 = a2 + kstep; const char* b3 = b2 + kstep;
            PG8_LDB(B0, 0, 0); PG8_LDB(B1, 0, 1); PG8_SCHED; PG8_LDA(At, 0, 0); PG8_STAGE(PG8_SA(1, 1), a1 + hstepA, voffA);
            PG8_WAIT_V(8); PG8_WAIT_L(0); PG8_BAR; PG8_MMA(0, 0, At, B0); PG8_MMA(0, 1, At, B1); PG8_BAR; PG8_SCHED;
            PG8_LDA(At, 0, 1); PG8_STAGE(PG8_SB(0, 0), b2, voffB); PG8_STAGE(PG8_SB(0, 1), b2 + hstepB, voffB); PG8_STAGE(PG8_SA(0, 0), a2, voffA);
            PG8_WAIT_V(8); PG8_WAIT_L(0); PG8_BAR; PG8_MMA(1, 0, At, B0); PG8_MMA(1, 1, At, B1); PG8_BAR; PG8_SCHED;
            PG8_LDB(B0, 1, 0); PG8_LDB(B1, 1, 1); PG8_SCHED; PG8_LDA(At, 1, 0); PG8_STAGE(PG8_SA(0, 1), a2 + hstepA, voffA);
            PG8_WAIT_V(8); PG8_WAIT_L(0); PG8_BAR; PG8_MMA(0, 0, At, B0); PG8_MMA(0, 1, At, B1); PG8_BAR; PG8_SCHED;
            PG8_LDA(At, 1, 1); PG8_STAGE(PG8_SB(1, 0), b3, voffB); PG8_STAGE(PG8_SB(1, 1), b3 + hstepB, voffB); PG8_STAGE(PG8_SA(1, 0), a3, voffA);
            PG8_WAIT_V(8); PG8_WAIT_L(0); PG8_BAR; PG8_MMA(1, 0, At, B0); PG8_MMA(1, 1, At, B1); PG8_BAR; PG8_SCHED;
        }
        if constexpr (ALIGN_EPI) { if (wr == 0) PG8_BAR; }
        {
            Unit ue = cur; int fr_e = fr, fq_e = fq; asm volatile("" : "+s"(ue.pm), "+s"(ue.pn), "+v"(fr_e), "+v"(fq_e));
            E(acc, ue, wr, wc, fr_e, fq_e); }
        if (!has_next) break;
#pragma unroll
        for (int a = 0; a < 2; ++a)
#pragma unroll
            for (int b = 0; b < 2; ++b)
#pragma unroll
                for (int m = 0; m < 4; ++m)
#pragma unroll
                    for (int n = 0; n < 2; ++n) acc[a][b][m][n] = (f32x4){0.f, 0.f, 0.f, 0.f};
        cur = nxt; cA = nA; cB = nB; ++ui;
        if constexpr (ALIGN_EPI) { if (wr == 1) PG8_BAR; }
    }
    PG8_WAIT_V(0);
    if constexpr (!ALIGN_EPI) { if (wr == 0) PG8_BAR; }
    PG8_BAR;
#undef PG8_SA
#undef PG8_SB
#undef PG8_STAGE
#undef PG8_LDA
#undef PG8_LDB
#undef PG8_MMA
#undef PG8_WAIT_V
#undef PG8_WAIT_L
#undef PG8_BAR
#undef PG8_SCHED
}
}

using pg8::Unit;
struct EpiSwiGLU {
    static constexpr bool PERM = true;
    bf16_t* H;
    __device__ __forceinline__ void operator()(const f32x4 (&acc)[2][2][4][2], const Unit& u, int wr, int wc, int fr, int fq) const {
        const int row0 = u.pm * 256 + wr * 64 + fr, col0 = u.pn * 128 + wc * 32 + 8 * fq;
#pragma unroll
        for (int ai = 0; ai < 2; ++ai)
#pragma unroll
            for (int m = 0; m < 4; ++m) {
                bf16_t* rowp = H + (size_t)(row0 + ai * 128 + m * 16) * D_FF + col0;
                const f32x4 g0 = acc[ai][0][m][0], g1 = acc[ai][0][m][1], u0 = acc[ai][1][m][0], u1 = acc[ai][1][m][1];
                u32x4 w;
                w.x = cvt_pk_bf16(siluf_(g0[0]) * u0[0], siluf_(g0[1]) * u0[1]); w.y = cvt_pk_bf16(siluf_(g0[2]) * u0[2], siluf_(g0[3]) * u0[3]);
                w.z = cvt_pk_bf16(siluf_(g1[0]) * u1[0], siluf_(g1[1]) * u1[1]); w.w = cvt_pk_bf16(siluf_(g1[2]) * u1[2], siluf_(g1[3]) * u1[3]);
                *(u32x4*)rowp = w;
            }
    }
};
struct EpiResid {
    static constexpr bool PERM = false;
    const float* res; float* out; float scale;
    __device__ __forceinline__ void operator()(const f32x4 (&acc)[2][2][4][2], const Unit& u, int wr, int wc, int fr, int fq) const {
        const int row0 = u.pm * 256 + wr * 64 + fr, col0 = u.pn * 256 + wc * 32 + 4 * fq;
#pragma unroll
        for (int ai = 0; ai < 2; ++ai)
#pragma unroll
            for (int m = 0; m < 4; ++m) {
                const size_t off = (size_t)(row0 + ai * 128 + m * 16) * D_MODEL + col0;
#pragma unroll
                for (int bj = 0; bj < 2; ++bj)
#pragma unroll
                    for (int n = 0; n < 2; ++n) { const f32x4 r = *(const f32x4*)(res + off + bj * 128 + n * 16); *(f32x4*)(out + off + bj * 128 + n * 16) = r * DN_ALPHA + acc[ai][bj][m][n] * scale; }
            }
    }
};
struct EpiInproj {
    static constexpr bool PERM = true;
    bf16_t *U5, *QKV, *Z, *LX, *LG; float* AB;
    __device__ __forceinline__ void operator()(const f32x4 (&acc)[2][2][4][2], const Unit& u, int wr, int wc, int fr, int fq) const {
        const int row0 = u.pm * 256 + wr * 64 + fr;
        const int pn = u.pn;
#pragma unroll
        for (int ai = 0; ai < 2; ++ai)
#pragma unroll
            for (int m = 0; m < 4; ++m) {
                const int row = row0 + ai * 128 + m * 16;
#pragma unroll
                for (int bj = 0; bj < 2; ++bj) {
                    const int c = pn * 256 + bj * 128 + wc * 32 + 8 * fq;
                    const f32x4 v0 = acc[ai][bj][m][0], v1 = acc[ai][bj][m][1];
                    if (pn == 22) {
                        if (bj == 0 && wc == 0 && fq < 2) { float* p = AB + (size_t)row * 16 + 8 * fq; *(f32x4*)p = v0; *(f32x4*)(p + 4) = v1; }
                    } else {
                        u32x4 w; w.x = cvt_pk_bf16(v0[0], v0[1]); w.y = cvt_pk_bf16(v0[2], v0[3]); w.z = cvt_pk_bf16(v1[0], v1[1]); w.w = cvt_pk_bf16(v1[2], v1[3]);
                        bf16_t* p;
                        if (pn < 2) { const int g = c >> 4, hf = c & 8; p = U5 + ((size_t)g * M_TOK + row) * 16 + hf; }
                        else if (pn < 14) p = QKV + (size_t)row * 3072 + (c - 512);
                        else if (pn < 18) p = Z + (size_t)row * 1024 + (c - 3584);
                        else if (pn < 20) p = LX + (size_t)row * 512 + (c - 4608);
                        else p = LG + (size_t)row * 512 + (c - 5120);
                        *(u32x4*)p = w;
                    }
                }
            }
    }
};
struct EpiS5S {
    static constexpr bool PERM = false;
    float* S;
    __device__ __forceinline__ void operator()(const f32x4 (&acc)[2][2][4][2], const Unit& u, int wr, int wc, int fr, int fq) const {
        const int g = u.pm, row0 = wr * 64 + fr, col0 = wc * 32 + 4 * fq;
#pragma unroll
        for (int ai = 0; ai < 2; ++ai)
#pragma unroll
            for (int m = 0; m < 4; ++m) { float* p = S + ((size_t)g * NCHT + row0 + ai * 128 + m * 16) * 128 + col0;
#pragma unroll
                for (int n = 0; n < 2; ++n) *(f32x4*)(p + n * 16) = acc[ai][0][m][n]; }
    }
};
struct EpiS5Intra {
    static constexpr bool PERM = false;
    float* Y;
    __device__ __forceinline__ void operator()(const f32x4 (&acc)[2][2][4][2], const Unit& u, int wr, int wc, int fr, int fq) const {
        const int g = u.pm, j = u.pn, row0 = wr * 64 + fr;
#pragma unroll
        for (int ai = 0; ai < 2; ++ai)
#pragma unroll
            for (int m = 0; m < 4; ++m) { const int bc = row0 + ai * 128 + m * 16;
#pragma unroll
                for (int bj = 0; bj < 2; ++bj)
#pragma unroll
                    for (int n = 0; n < 2; ++n) { const int col = j * 256 + bj * 128 + wc * 32 + 16 * n + 4 * fq, t = col >> 4, p = col & 15;
                        *(f32x4*)(Y + ((size_t)bc * CH + t) * S5_W + g * 16 + p) = acc[ai][bj][m][n]; }
            }
    }
};
struct EpiS5Inter {
    static constexpr bool PERM = false;
    const float* Y; const bf16_t* U5; const float* dvec; bf16_t* YACT;
    __device__ __forceinline__ void operator()(const f32x4 (&acc)[2][2][4][2], const Unit& u, int wr, int wc, int fr, int fq) const {
        const int g = u.pm, j = u.pn, row0 = wr * 64 + fr;
#pragma unroll
        for (int ai = 0; ai < 2; ++ai)
#pragma unroll
            for (int m = 0; m < 4; ++m) { const int bc = row0 + ai * 128 + m * 16;
#pragma unroll
                for (int bj = 0; bj < 2; ++bj)
#pragma unroll
                    for (int n = 0; n < 2; ++n) { const int col = j * 256 + bj * 128 + wc * 32 + 16 * n + 4 * fq, t = col >> 4, p = col & 15;
                        const size_t tok = (size_t)bc * CH + t; const int ch = g * 16 + p;
                        const f32x4 y0 = *(const f32x4*)(Y + tok * S5_W + ch);
                        const u32x2 uu = *(const u32x2*)(U5 + ((size_t)g * M_TOK + tok) * 16 + p);
                        const f32x4 d0 = *(const f32x4*)(dvec + ch);
                        const f32x4 a0 = acc[ai][bj][m][n];
                        const float o0 = gelu_tanh(a0[0] + y0[0] + d0[0] * bflo(uu.x)), o1 = gelu_tanh(a0[1] + y0[1] + d0[1] * bfhi(uu.x));
                        const float o2 = gelu_tanh(a0[2] + y0[2] + d0[2] * bflo(uu.y)), o3 = gelu_tanh(a0[3] + y0[3] + d0[3] * bfhi(uu.y));
                        u32x2 w; w.x = cvt_pk_bf16(o0, o1); w.y = cvt_pk_bf16(o2, o3);
                        *(u32x2*)(YACT + tok * S5_W + ch) = w; }
                asm volatile("" ::: "memory");
            }
    }
};
struct EpiGLU {
    static constexpr bool PERM = true;
    const bf16_t* YACT; const float* bglu; bf16_t* CAT;
    __device__ __forceinline__ void operator()(const f32x4 (&acc)[2][2][4][2], const Unit& u, int wr, int wc, int fr, int fq) const {
        const int row0 = u.pm * 256 + wr * 64 + fr;
#pragma unroll
        for (int ai = 0; ai < 2; ++ai)
#pragma unroll
            for (int m = 0; m < 4; ++m) { const size_t row = (size_t)(row0 + ai * 128 + m * 16);
#pragma unroll
                for (int bj = 0; bj < 2; ++bj) { const int col = u.pn * 256 + bj * 128 + wc * 32 + 8 * fq;
                    const u32x4 yy = *(const u32x4*)(YACT + row * S5_W + col);
                    const f32x4 b0 = *(const f32x4*)(bglu + col), b1 = *(const f32x4*)(bglu + col + 4);
                    const f32x4 a0 = acc[ai][bj][m][0] + b0, a1 = acc[ai][bj][m][1] + b1;
                    u32x4 w;
                    w.x = cvt_pk_bf16(bflo(yy.x) * sigmoidf_(a0[0]), bfhi(yy.x) * sigmoidf_(a0[1])); w.y = cvt_pk_bf16(bflo(yy.y) * sigmoidf_(a0[2]), bfhi(yy.y) * sigmoidf_(a0[3]));
                    w.z = cvt_pk_bf16(bflo(yy.z) * sigmoidf_(a1[0]), bfhi(yy.z) * sigmoidf_(a1[1])); w.w = cvt_pk_bf16(bflo(yy.w) * sigmoidf_(a1[2]), bfhi(yy.w) * sigmoidf_(a1[3]));
                    *(u32x4*)(CAT + row * D_MODEL + col) = w; }
            }
    }
};
struct EpiLRU {
    static constexpr bool PERM = true;
    const bf16_t* XC; const float *ba, *bx, *lam; float *LA, *LB;
    __device__ __forceinline__ void operator()(const f32x4 (&acc)[2][2][4][2], const Unit& u, int wr, int wc, int fr, int fq) const {
        const int row0 = u.pm * 256 + wr * 64 + fr, ch = u.pn * 128 + wc * 32 + 8 * fq;
        float sp[8], bav[8], bxv[8];
#pragma unroll
        for (int e = 0; e < 8; ++e) { sp[e] = -8.0f * softplusf_(-lam[ch + e]); bav[e] = ba[ch + e]; bxv[e] = bx[ch + e]; }
#pragma unroll
        for (int ai = 0; ai < 2; ++ai)
#pragma unroll
            for (int m = 0; m < 4; ++m) { const size_t row = (size_t)(row0 + ai * 128 + m * 16);
                const u32x4 xx = *(const u32x4*)(XC + row * LRU_W + ch);
                float xc[8] = {bflo(xx.x), bfhi(xx.x), bflo(xx.y), bfhi(xx.y), bflo(xx.z), bfhi(xx.z), bflo(xx.w), bfhi(xx.w)};
                float av[8], bv[8];
#pragma unroll
                for (int e = 0; e < 8; ++e) { const float ra = acc[ai][0][m][e >> 2][e & 3] + bav[e], rx = acc[ai][1][m][e >> 2][e & 3] + bxv[e];
                    const float r = sigmoidf_(ra), ig = sigmoidf_(rx), la = sp[e] * r; av[e] = __expf(la); bv[e] = sqrtf_(fmaxf(-expm1_neg(2.0f * la), 0.f)) * (ig * xc[e]); }
                *(f32x4*)(LA + row * LRU_W + ch) = (f32x4){av[0], av[1], av[2], av[3]}; *(f32x4*)(LA + row * LRU_W + ch + 4) = (f32x4){av[4], av[5], av[6], av[7]};
                *(f32x4*)(LB + row * LRU_W + ch) = (f32x4){bv[0], bv[1], bv[2], bv[3]}; *(f32x4*)(LB + row * LRU_W + ch + 4) = (f32x4){bv[4], bv[5], bv[6], bv[7]};
            }
    }
};

#define XB_TMO      128
#define XB_XCNT(j)  (256  + 64 * (j))
#define XB_XSUB(j)  (1280 + 64 * (j))
#define XB_XGEN(j)  (2304 + 64 * (j))
#define XB_TOP      3328
#define XB_TOPGEN   3392
#define XCD_BAR_WORDS 3456
#define XB_SPIN_CAP (1u << 22)
__device__ __forceinline__ unsigned xb_ld(unsigned* p)              { return __hip_atomic_load(p, __ATOMIC_RELAXED, __HIP_MEMORY_SCOPE_AGENT); }
__device__ __forceinline__ unsigned xb_add(unsigned* p, unsigned v) { return __hip_atomic_fetch_add(p, v, __ATOMIC_RELAXED, __HIP_MEMORY_SCOPE_AGENT); }
__device__ __forceinline__ unsigned xb_xcc_id() { return (unsigned)__builtin_amdgcn_s_getreg((3 << 11) | 20) & 0xFu; }
#define XB_SPIN(cond, bar) do { unsigned _sp = 0; while (cond) { __builtin_amdgcn_s_sleep(1); \
    if ((++_sp & 255u) == 0u) { if (xb_ld(&(bar)[XB_TMO])) break; if (_sp > XB_SPIN_CAP) { atomicAdd(&(bar)[XB_TMO], 1u); break; } } } } while (0)
struct XcdBarrier { unsigned* bar; unsigned x; volatile LAS unsigned* st; };
__device__ __forceinline__ XcdBarrier xcd_barrier_post(unsigned* bar, volatile LAS unsigned* st) {
    XcdBarrier b; b.bar = bar; b.x = xb_xcc_id(); b.st = st;
    if (threadIdx.x == 0) (void)xb_add(&bar[XB_XCNT(b.x)], 1u);
    return b;
}
__device__ __forceinline__ void xcd_barrier_complete(unsigned* bar, unsigned x, unsigned& nloc, unsigned& nx) {
    const unsigned G = gridDim.x * gridDim.y * gridDim.z;
    unsigned sum, cnt, mine, sp = 0u;
    for (;;) {
        sum = 0u; cnt = 0u; mine = 0u;
#pragma unroll
        for (unsigned j = 0; j < 16; ++j) { const unsigned c = xb_ld(&bar[XB_XCNT(j)]); sum += c; cnt += (c > 0u) ? 1u : 0u; mine = (j == x) ? c : mine; }
        if (sum == G) break;
        __builtin_amdgcn_s_sleep(1);
        if ((++sp & 255u) == 0u) { if (xb_ld(&bar[XB_TMO])) break; if (sp > XB_SPIN_CAP) { atomicAdd(&bar[XB_TMO], 1u); break; } }
    }
    nloc = mine > 0u ? mine : 1u; nx = cnt > 0u ? cnt : 1u;
}
__device__ __forceinline__ void xcd_barrier(const XcdBarrier& b) {
    asm volatile("s_waitcnt vmcnt(0)" ::: "memory");
    __syncthreads();
    if (threadIdx.x == 0) {
        unsigned* bar = b.bar; unsigned bx = b.x;
        __builtin_amdgcn_s_waitcnt(0);
        unsigned nloc = b.st[0], nx = b.st[1];
        if (nloc == 0u) { xcd_barrier_complete(bar, bx, nloc, nx); b.st[0] = nloc; b.st[1] = nx; }
        const unsigned old = xb_add(&bar[XB_XSUB(bx)], 1u);
        const unsigned gen = old / nloc;
        if (old + 1u == (gen + 1u) * nloc) {
            __builtin_amdgcn_fence(__ATOMIC_RELEASE, "agent");
            asm volatile("s_waitcnt vmcnt(0)" ::: "memory");
            const unsigned og = xb_add(&bar[XB_TOP], 1u);
            const unsigned tg = og / nx;
            if (og + 1u == (tg + 1u) * nx) xb_add(&bar[XB_TOPGEN], 1u);
            else XB_SPIN(xb_ld(&bar[XB_TOPGEN]) == tg, bar);
            __builtin_amdgcn_fence(__ATOMIC_ACQUIRE, "agent");
            xb_add(&bar[XB_XGEN(bx)], 1u);
            asm volatile("s_waitcnt vmcnt(0)" ::: "memory");
        } else {
            XB_SPIN(xb_ld(&bar[XB_XGEN(bx)]) == gen, bar);
            __builtin_amdgcn_fence(__ATOMIC_ACQUIRE, "agent");
            asm volatile("s_waitcnt vmcnt(0)" ::: "memory");
        }
    }
    __syncthreads();
}

__device__ __forceinline__ void sub_barrier(unsigned* cnt, unsigned target) {
    asm volatile("s_waitcnt vmcnt(0)" ::: "memory");
    __syncthreads();
    if (threadIdx.x == 0) {
        __builtin_amdgcn_fence(__ATOMIC_RELEASE, "agent");
        asm volatile("s_waitcnt vmcnt(0)" ::: "memory");
        (void)xb_add(cnt, 1u);
        unsigned sp = 0u; while (xb_ld(cnt) < target) { __builtin_amdgcn_s_sleep(1); if (++sp > XB_SPIN_CAP) break; }
        __builtin_amdgcn_fence(__ATOMIC_ACQUIRE, "agent");
        asm volatile("s_waitcnt vmcnt(0)" ::: "memory");
    }
    __syncthreads();
}

constexpr size_t al256(size_t x) { return (x + 255) & ~(size_t)255; }
constexpr size_t WS_CTL = 0, CTL_BYTES = 1u << 20;
constexpr size_t SZ_WGU = (size_t)2 * D_FF * D_MODEL * 2, SZ_WD = (size_t)D_MODEL * D_FF * 2, SZ_WIN = (size_t)N_IN_PAD * D_MODEL * 2, SZ_WOUT = (size_t)D_MODEL * D_MODEL * 2;
constexpr size_t WS_WGU1 = WS_CTL + CTL_BYTES, WS_WGU2 = WS_WGU1 + SZ_WGU, WS_WD1 = WS_WGU2 + SZ_WGU, WS_WD2 = WS_WD1 + SZ_WD, WS_WIN = WS_WD2 + SZ_WD, WS_WOUT = WS_WIN + SZ_WIN;
constexpr size_t WS_WGLU = WS_WOUT + SZ_WOUT, WS_WLRU = WS_WGLU + (size_t)512 * 512 * 2;
constexpr size_t WS_KTAB = WS_WLRU + (size_t)1024 * 512 * 2;
constexpr size_t WS_PTAB = WS_KTAB + (size_t)32 * 16 * 128 * 16 * 2;
constexpr size_t WS_QTAB = WS_PTAB + (size_t)32 * 256 * 1024 * 2;
constexpr size_t WS_XN = WS_QTAB + (size_t)32 * 1024 * 256 * 2;
constexpr size_t WS_H = WS_XN + (size_t)M_TOK * D_MODEL * 2;
constexpr size_t WS_U5 = WS_H + (size_t)M_TOK * D_FF * 2;
constexpr size_t WS_QKV = WS_U5 + (size_t)M_TOK * 512 * 2;
constexpr size_t WS_Z = WS_QKV + (size_t)M_TOK * 3072 * 2;
constexpr size_t WS_AB = WS_Z + (size_t)M_TOK * 1024 * 2;
constexpr size_t WS_LX = WS_AB + (size_t)M_TOK * 16 * 4;
constexpr size_t WS_LG = WS_LX + (size_t)M_TOK * 512 * 2;
constexpr size_t WS_XC = WS_LG + (size_t)M_TOK * 512 * 2;
constexpr int NUNIT = BATCH * GDN_H * NCH;
constexpr size_t WS_GU = WS_XC + (size_t)M_TOK * 512 * 2;
constexpr size_t WS_GW = WS_GU + (size_t)NUNIT * 64 * 128 * 4;
constexpr size_t WS_GQD = WS_GW + (size_t)NUNIT * 16384;
constexpr size_t WS_GKD = WS_GQD + (size_t)NUNIT * 16384;
constexpr size_t WS_GQK = WS_GKD + (size_t)NUNIT * 16384;
constexpr size_t WS_GL = WS_GQK + (size_t)NUNIT * 8192;
constexpr size_t WS_GO = WS_GL + al256((size_t)NUNIT * 4);
constexpr size_t WS_S5S = WS_GO + (size_t)M_TOK * 1024 * 4;
constexpr size_t WS_HEXT = WS_S5S + (size_t)32 * 256 * 128 * 4;
constexpr size_t WS_YIN = WS_HEXT + (size_t)32 * 256 * 256 * 2;
constexpr size_t WS_YACT = WS_YIN + (size_t)M_TOK * 512 * 4;
constexpr size_t WS_LA = WS_YACT + (size_t)M_TOK * 512 * 2;
constexpr size_t WS_LB = WS_LA + (size_t)M_TOK * 512 * 4;
constexpr size_t WS_CA = WS_LB + (size_t)M_TOK * 512 * 4;
constexpr size_t WS_CB = WS_CA + (size_t)NCHT * 512 * 4;
constexpr size_t WS_CIN = WS_CB + (size_t)NCHT * 512 * 4;
constexpr size_t WS_CAT = WS_CIN + (size_t)NCHT * 512 * 4;
constexpr size_t WS_END = WS_CAT + (size_t)M_TOK * D_MODEL * 2;
constexpr int CW_BAR = 4096, CW_SUB = 8192;

constexpr int RING_BYTES = 131072, LDSCTL_OFF = RING_BYTES, MISC_OFF = LDSCTL_OFF + 320, LDS_BYTES = 147456;
constexpr int NWAVES = 8;

struct Params { const float* in[36]; float* out; unsigned char* ws; };
typedef const __attribute__((address_space(4))) unsigned char* kptr_t;
__device__ __forceinline__ kptr_t karg_base() { kptr_t k = (kptr_t)__builtin_amdgcn_kernarg_segment_ptr(); asm volatile("" : "+s"(k)); return k; }
__device__ __forceinline__ const float* KIN(int i) { return *(const float* const __attribute__((address_space(4)))*)(karg_base() + 8 * i); }
__device__ __forceinline__ float* KOUT() { return *(float* const __attribute__((address_space(4)))*)(karg_base() + 8 * 36); }
__device__ __forceinline__ unsigned char* KWS() { return *(unsigned char* const __attribute__((address_space(4)))*)(karg_base() + 8 * 37); }
struct Frame {
    LAS unsigned char* lds; int tid, lane, wave, G, bid;
    __device__ __forceinline__ int gw() const { return bid * NWAVES + wave; }
    __device__ __forceinline__ int ngw() const { return G * NWAVES; }
    __device__ __forceinline__ int gt() const { return bid * (NWAVES * 64) + tid; }
    __device__ __forceinline__ int ngt() const { return G * NWAVES * 64; }
};
#define LDS_WAIT() asm volatile("s_waitcnt lgkmcnt(0)" ::: "memory")
__device__ __forceinline__ Frame fresh(const Frame& F0) { Frame F = F0; int w = F0.wave; asm volatile("" : "+s"(w)); int ln = (int)__builtin_amdgcn_mbcnt_hi(~0u, __builtin_amdgcn_mbcnt_lo(~0u, 0u)); asm volatile("" : "+v"(ln));
    F.wave = w; F.lane = ln; F.tid = w * 64 + ln;
    int b = blockIdx.x, g = gridDim.x; asm volatile("" : "+s"(b), "+s"(g)); F.bid = b; F.G = g; return F; }

struct MapId { __device__ __forceinline__ int operator()(int n) const { return n; } };
struct MapGU { int half; __device__ __forceinline__ int operator()(int n) const { return 256 * (n >> 7) + 128 * half + (n & 127); } };
struct MapIn { __device__ __forceinline__ int operator()(int n) const { return n < 4608 ? n : (n < 4624 ? 5632 + (n - 4608) : n - 16); } };
template <int K, int N, class Map>
__device__ __forceinline__ void transpose_item(const float* W, bf16_t* WT, int item, int lane, const Map map) {
    constexpr int nblk = (N + 63) >> 6;
    const int kb = item / nblk, nb = item - kb * nblk, k0 = 64 * kb, n = 64 * nb + lane;
    if (n < N) {
        const float* p = W + (size_t)k0 * N + n;
        float v[64];
#pragma unroll
        for (int i = 0; i < 64; ++i) v[i] = p[(size_t)i * N];
        bf16_t* q = WT + (size_t)map(n) * K + k0;
#pragma unroll
        for (int j = 0; j < 8; ++j) { u32x4 o; o.x = cvt_pk_bf16(v[8 * j], v[8 * j + 1]); o.y = cvt_pk_bf16(v[8 * j + 2], v[8 * j + 3]); o.z = cvt_pk_bf16(v[8 * j + 4], v[8 * j + 5]); o.w = cvt_pk_bf16(v[8 * j + 6], v[8 * j + 7]);
            *(u32x4*)(q + 8 * j) = o; }
    }
}
__device__ __forceinline__ void cplx_pow(float lre, float lim, float dt, int d, float& zr, float& zi) {
    const float mag = __expf((float)d * lre * dt);
    const double rev = (double)d * ((double)dt * (double)lim) * 0.15915494309189535;
    const float r = (float)(rev - rint(rev));
    zr = mag * __builtin_amdgcn_cosf(r); zi = mag * __builtin_amdgcn_sinf(r);
}
__device__ __forceinline__ void s5_coef(float lre, float lim, float dt, float& cr, float& ci) {
    const float a = lre * dt; const double rev = ((double)dt * (double)lim) * 0.15915494309189535; const float r = (float)(rev - rint(rev));
    const float cb = __builtin_amdgcn_cosf(r), sb = __builtin_amdgcn_sinf(r), sh = __builtin_amdgcn_sinf(0.5f * r);
    const float er = expm1_neg(a) * cb - 2.0f * sh * sh, ei = __expf(a) * sb;
    const float den = rcpf_(lre * lre + lim * lim);
    cr = (er * lre + ei * lim) * den; ci = (ei * lre - er * lim) * den;
}
__device__ __forceinline__ void phase_convert(const Frame& F, int l) {
    unsigned char* ws = KWS();
    const int gw = F.gw(), NGW = F.ngw();
    constexpr int I_GU = (D_MODEL / 64) * (D_FF / 64), I_DN = (D_FF / 64) * (D_MODEL / 64), I_IN = (D_MODEL / 64) * ((D_IN + 63) / 64), I_OUT = (D_MODEL / 64) * (D_MODEL / 64), I_GLU = (512 / 64) * (512 / 64);
    constexpr int NITEMS = 4 * I_GU + 2 * I_DN + I_IN + I_OUT + I_GLU;
    const size_t oGU = (size_t)l * D_MODEL * D_FF, oIN = (size_t)l * D_MODEL * D_IN, oOUT = (size_t)l * D_MODEL * D_MODEL, oGLU = (size_t)l * 512 * 512;
    for (int it = gw; it < NITEMS; it += NGW) {
        int r = it;
        if (r < I_GU) { transpose_item<D_MODEL, D_FF>(KIN(1) + oGU, (bf16_t*)(ws + WS_WGU1), r, F.lane, MapGU{0}); continue; } r -= I_GU;
        if (r < I_GU) { transpose_item<D_MODEL, D_FF>(KIN(2) + oGU, (bf16_t*)(ws + WS_WGU1), r, F.lane, MapGU{1}); continue; } r -= I_GU;
        if (r < I_DN) { transpose_item<D_FF, D_MODEL>(KIN(3) + oGU, (bf16_t*)(ws + WS_WD1), r, F.lane, MapId{}); continue; } r -= I_DN;
        if (r < I_GU) { transpose_item<D_MODEL, D_FF>(KIN(31) + oGU, (bf16_t*)(ws + WS_WGU2), r, F.lane, MapGU{0}); continue; } r -= I_GU;
        if (r < I_GU) { transpose_item<D_MODEL, D_FF>(KIN(32) + oGU, (bf16_t*)(ws + WS_WGU2), r, F.lane, MapGU{1}); continue; } r -= I_GU;
        if (r < I_DN) { transpose_item<D_FF, D_MODEL>(KIN(33) + oGU, (bf16_t*)(ws + WS_WD2), r, F.lane, MapId{}); continue; } r -= I_DN;
        if (r < I_IN) { transpose_item<D_MODEL, D_IN>(KIN(6) + oIN, (bf16_t*)(ws + WS_WIN), r, F.lane, MapIn{}); continue; } r -= I_IN;
        if (r < I_OUT) { transpose_item<D_MODEL, D_MODEL>(KIN(28) + oOUT, (bf16_t*)(ws + WS_WOUT), r, F.lane, MapId{}); continue; } r -= I_OUT;
        transpose_item<512, 512>(KIN(15) + oGLU, (bf16_t*)(ws + WS_WGLU), r, F.lane, MapId{});
    }
    const int gt = F.gt(), NGT = F.ngt();
    { const float* wa = KIN(23) + (size_t)l * 8 * 64 * 64; const float* wx = KIN(25) + (size_t)l * 8 * 64 * 64; bf16_t* WL = (bf16_t*)(ws + WS_WLRU);
      for (int idx = gt; idx < 1024 * 512; idx += NGT) { const int row = idx >> 9, k = idx & 511, pn = row >> 8, bj = (row >> 7) & 1, j = row & 127, c = 128 * pn + j, h = c >> 6;
          float v = 0.f; if ((k >> 6) == h) v = (bj ? wx : wa)[(h * 64 + (k & 63)) * 64 + (c & 63)];
          WL[idx] = (bf16_t)f2bf(v); } }
    const float* lre_ = KIN(7) + l * 2048; const float* lim_ = KIN(8) + l * 2048; const float* bre = KIN(9) + (size_t)l * 32768; const float* bim = KIN(10) + (size_t)l * 32768;
    const float* cre = KIN(11) + (size_t)l * 32768; const float* cim = KIN(12) + (size_t)l * 32768; const float* lstep = KIN(14) + l * 32;
    { bf16_t* KT = (bf16_t*)(ws + WS_KTAB);
      for (int idx = gt; idx < 32 * 16 * 8 * 16; idx += NGT) { const int q = idx & 15, d8 = (idx >> 4) & 7, p = (idx >> 7) & 15, g = idx >> 11;
          float acc[8];
#pragma unroll
          for (int dd = 0; dd < 8; ++dd) acc[dd] = 0.f;
          const float dt = __expf(lstep[g]);
          for (int n = 0; n < 64; ++n) { const float lre = fminf(lre_[g * 64 + n], -1e-4f), lim = lim_[g * 64 + n];
              float zr, zi, ar, ai, cr, ci; cplx_pow(lre, lim, dt, 8 * d8, zr, zi); cplx_pow(lre, lim, dt, 1, ar, ai); s5_coef(lre, lim, dt, cr, ci);
              const float br = bre[(g * 64 + n) * 16 + q], bi = bim[(g * 64 + n) * 16 + q];
              const float bbr = cr * br - ci * bi, bbi = cr * bi + ci * br;
              float wr_ = zr * bbr - zi * bbi, wi_ = zr * bbi + zi * bbr;
              const float c_r = cre[(g * 16 + p) * 64 + n], c_i = cim[(g * 16 + p) * 64 + n];
#pragma unroll
              for (int dd = 0; dd < 8; ++dd) { acc[dd] += c_r * wr_ - c_i * wi_; const float t = wr_ * ar - wi_ * ai; wi_ = wr_ * ai + wi_ * ar; wr_ = t; } }
#pragma unroll
          for (int dd = 0; dd < 8; ++dd) KT[(((size_t)g * 16 + p) * 128 + (63 - 8 * d8 - dd)) * 16 + q] = (bf16_t)f2bf(acc[dd]); }
      if (l == 0) for (int idx = gt; idx < 32 * 16 * 64 * 2; idx += NGT) { const int gp = idx >> 7, r = idx & 127; *(u32x4*)(KT + ((size_t)gp * 128 + 64) * 16 + r * 8) = (u32x4){0u, 0u, 0u, 0u}; } }
    { bf16_t* PT = (bf16_t*)(ws + WS_PTAB);
      for (int idx = gt; idx < 32 * 64 * 8 * 16; idx += NGT) { const int q = idx & 15, s8 = (idx >> 4) & 7, n = (idx >> 7) & 63, g = idx >> 13;
          const float dt = __expf(lstep[g]); const float lre = fminf(lre_[g * 64 + n], -1e-4f), lim = lim_[g * 64 + n];
          float zr, zi, ar, ai, cr, ci; cplx_pow(lre, lim, dt, 56 - 8 * s8, zr, zi); cplx_pow(lre, lim, dt, 1, ar, ai); s5_coef(lre, lim, dt, cr, ci);
          const float br = bre[(g * 64 + n) * 16 + q], bi = bim[(g * 64 + n) * 16 + q];
          const float bbr = cr * br - ci * bi, bbi = cr * bi + ci * br;
          float wr_ = zr * bbr - zi * bbi, wi_ = zr * bbi + zi * bbr;
#pragma unroll
          for (int ss = 7; ss >= 0; --ss) { const int s = 8 * s8 + ss;
              PT[((size_t)g * 256 + 2 * n) * 1024 + s * 16 + q] = (bf16_t)f2bf(wr_); PT[((size_t)g * 256 + 2 * n + 1) * 1024 + s * 16 + q] = (bf16_t)f2bf(wi_);
              const float t = wr_ * ar - wi_ * ai; wi_ = wr_ * ai + wi_ * ar; wr_ = t; } } }
    { bf16_t* QT = (bf16_t*)(ws + WS_QTAB);
      for (int idx = gt; idx < 32 * 16 * 8 * 64; idx += NGT) { const int n = idx & 63, t8 = (idx >> 6) & 7, p = (idx >> 9) & 15, g = idx >> 13;
          const float dt = __expf(lstep[g]); const float lre = fminf(lre_[g * 64 + n], -1e-4f), lim = lim_[g * 64 + n];
          float zr, zi, ar, ai; cplx_pow(lre, lim, dt, 8 * t8 + 1, zr, zi); cplx_pow(lre, lim, dt, 1, ar, ai);
          const float c_r = cre[(g * 16 + p) * 64 + n], c_i = cim[(g * 16 + p) * 64 + n];
          float wr_ = c_r * zr - c_i * zi, wi_ = c_r * zi + c_i * zr;
#pragma unroll
          for (int tt = 0; tt < 8; ++tt) { const int t = 8 * t8 + tt;
              *(unsigned*)(QT + ((size_t)g * 1024 + t * 16 + p) * 256 + 2 * n) = cvt_pk_bf16(wr_, -wi_);
              const float tmp = wr_ * ar - wi_ * ai; wi_ = wr_ * ai + wi_ * ar; wr_ = tmp; } }
      if (l == 0) for (int idx = gt; idx < 32 * 1024 * 16; idx += NGT) { const int row = idx >> 4, r = idx & 15; *(u32x4*)(QT + (size_t)row * 256 + 128 + r * 8) = (u32x4){0u, 0u, 0u, 0u}; } }
}
__device__ __forceinline__ void phase_x_to_bf16(const Frame& F, const float* x, bf16_t* XN) {
    const size_t n8 = (size_t)M_TOK * D_MODEL / 8;
    for (size_t i = F.gt(); i < n8; i += F.ngt()) { const f32x4 a = *(const f32x4*)(x + i * 8), b = *(const f32x4*)(x + i * 8 + 4);
        u32x4 w; w.x = cvt_pk_bf16(a[0], a[1]); w.y = cvt_pk_bf16(a[2], a[3]); w.z = cvt_pk_bf16(b[0], b[1]); w.w = cvt_pk_bf16(b[2], b[3]); *(u32x4*)(XN + i * 8) = w; }
}
__device__ __forceinline__ void phase_ln(const Frame& F, float* X, const float* gam, const float* bet, bf16_t* XN) {
    f32x4 gv[8], bv[8];
#pragma unroll
    for (int j = 0; j < 8; ++j) { gv[j] = *(const f32x4*)(gam + 4 * F.lane + 256 * j); bv[j] = *(const f32x4*)(bet + 4 * F.lane + 256 * j); }
    for (int m = F.gw(); m < M_TOK; m += F.ngw()) {
        float* xr = X + (size_t)m * D_MODEL + 4 * F.lane; f32x4 v[8]; float s = 0.f;
#pragma unroll
        for (int j = 0; j < 8; ++j) { v[j] = *(const f32x4*)(xr + 256 * j); s += (v[j][0] + v[j][1]) + (v[j][2] + v[j][3]); }
        const float mean = wave_sum(s) * (1.f / D_MODEL); float s2 = 0.f;
#pragma unroll
        for (int j = 0; j < 8; ++j) { v[j] = v[j] - mean; s2 += (v[j][0] * v[j][0] + v[j][1] * v[j][1]) + (v[j][2] * v[j][2] + v[j][3] * v[j][3]); }
        const float rstd = rsqf_(wave_sum(s2) * (1.f / D_MODEL) + LN_EPS);
        bf16_t* xo = XN + (size_t)m * D_MODEL + 4 * F.lane;
#pragma unroll
        for (int j = 0; j < 8; ++j) { const f32x4 o = v[j] * rstd * gv[j] + bv[j]; *(f32x4*)(xr + 256 * j) = o;
            u32x2 w; w.x = cvt_pk_bf16(o[0], o[1]); w.y = cvt_pk_bf16(o[2], o[3]); *(u32x2*)(xo + 256 * j) = w; }
    }
}

__device__ __forceinline__ void phase_lru_conv(const Frame& F, const bf16_t* LX, const float* cw, const float* cb, bf16_t* XC) {
    const int nitems = M_TOK * 64;
    for (int it = F.gt(); it < nitems; it += F.ngt()) {
        const int row = it >> 6, c8 = (it & 63) * 8, t = row & (SEQ - 1);
        float acc[8];
#pragma unroll
        for (int e = 0; e < 8; ++e) acc[e] = cb[c8 + e];
#pragma unroll
        for (int k = 0; k < 4; ++k) { const int dt_ = 3 - k; if (t - dt_ >= 0) {
                const u32x4 xx = *(const u32x4*)(LX + (size_t)(row - dt_) * LRU_W + c8);
                const f32x4 w0 = *(const f32x4*)(cw + k * LRU_W + c8), w1 = *(const f32x4*)(cw + k * LRU_W + c8 + 4);
                acc[0] += w0[0] * bflo(xx.x); acc[1] += w0[1] * bfhi(xx.x); acc[2] += w0[2] * bflo(xx.y); acc[3] += w0[3] * bfhi(xx.y);
                acc[4] += w1[0] * bflo(xx.z); acc[5] += w1[1] * bfhi(xx.z); acc[6] += w1[2] * bflo(xx.w); acc[7] += w1[3] * bfhi(xx.w); } }
        u32x4 w; w.x = cvt_pk_bf16(acc[0], acc[1]); w.y = cvt_pk_bf16(acc[2], acc[3]); w.z = cvt_pk_bf16(acc[4], acc[5]); w.w = cvt_pk_bf16(acc[6], acc[7]);
        *(u32x4*)(XC + (size_t)row * LRU_W + c8) = w;
    }
}
__device__ __forceinline__ void lru_p1_tile(int tid, int pm, int pn, const float* LA, const float* LB, float* CA, float* CB) {
    const int bc = pm * 4 + (tid >> 7), ch = pn * 128 + (tid & 127); const size_t base = (size_t)bc * CH * LRU_W + ch;
    float A = 1.f, B = 0.f;
#pragma unroll 16
    for (int t = 0; t < CH; ++t) { const float a = LA[base + (size_t)t * LRU_W], b = LB[base + (size_t)t * LRU_W]; B = a * B + b; A *= a; }
    CA[bc * LRU_W + ch] = A; CB[bc * LRU_W + ch] = B;
}
__device__ __forceinline__ void phase_lru_p3(int gt, int ngt, const float* LA, const float* LB, const float* CA, const float* CB, const bf16_t* LG, bf16_t* CAT) {
    for (int it = gt; it < NCHT * LRU_W; it += ngt) {
        const int bc = it >> 9, ch = it & 511, b = bc >> 7, c = bc & (NCH - 1); const size_t row0 = (size_t)bc * CH;
        float h = 0.f;
        for (int cc = 0; cc < c; ++cc) { const int o = (b * NCH + cc) * LRU_W + ch; h = CA[o] * h + CB[o]; }
#pragma unroll 8
        for (int t = 0; t < CH; ++t) { const size_t row = row0 + t; h = LA[row * LRU_W + ch] * h + LB[row * LRU_W + ch];
            const float gt_ = bf2f(LG[row * LRU_W + ch]); CAT[row * D_MODEL + 1536 + ch] = (bf16_t)f2bf(h * gelu_tanh(gt_)); }
    }
}

__device__ __forceinline__ void s5_carry_group(int g, int tix, const float* lre_, const float* lim_, const float* lstep, const float* S5S, bf16_t* HEXT) {
    if (tix >= BATCH * 64) return;
    const int b = tix >> 6, n = tix & 63;
    const float dt = __expf(lstep[g]); const float lre = fminf(lre_[g * 64 + n], -1e-4f), lim = lim_[g * 64 + n];
    float ar, ai; cplx_pow(lre, lim, dt, 64, ar, ai);
    float hr = 0.f, hi = 0.f;
    for (int c0 = 0; c0 < NCH; c0 += 16) {
        f32x2 sv[16];
#pragma unroll
        for (int k = 0; k < 16; ++k) sv[k] = *(const f32x2*)(S5S + ((size_t)g * NCHT + b * NCH + c0 + k) * 128 + 2 * n);
#pragma unroll
        for (int k = 0; k < 16; ++k) { const size_t rowi = (size_t)g * NCHT + b * NCH + c0 + k;
            *(unsigned*)(HEXT + rowi * 256 + 2 * n) = cvt_pk_bf16(hr, hi); *(unsigned*)(HEXT + rowi * 256 + 128 + 2 * n) = 0u;
            const float nr = ar * hr - ai * hi + sv[k][0], ni = ar * hi + ai * hr + sv[k][1]; hr = nr; hi = ni; } }
}

__device__ __forceinline__ int fragoff(int m, int k, int KS) { const int idx = k & 31, g = (idx & 15) >> 2, j = (idx & 3) + 4 * (idx >> 4); return ((((m >> 4) * KS + (k >> 5)) * 64) + 16 * g + (m & 15)) * 8 + j; }
__device__ __forceinline__ bf16x8 ldsfrag(LAS unsigned char* lds, int base, int stride, int row0, int k0, int lane) { return *(const LAS bf16x8*)(lds + base + (row0 + (lane & 15)) * stride + (k0 + 8 * (lane >> 4)) * 2); }
constexpr int GP_QS = 0, GP_KS = 18432, GP_VT = 36864, GP_KBT = 57344, GP_ST = 77824, GP_TB = 110592, GP_MISC = 120832, GP_TMP = GP_MISC + 1024;
__device__ __forceinline__ void gdn_prep_unit(const Frame& F, int l, int unit) {
    unsigned char* ws = KWS(); LAS unsigned char* lds = F.lds;
    const int tid = F.tid, lane = F.lane, wave = F.wave;
    const int c = unit & (NCH - 1), bh = unit >> 7, h = bh & 7, b = bh >> 3, t0 = c * CH; const size_t tok0 = (size_t)b * SEQ + t0;
    const bf16_t* QKV = (const bf16_t*)(ws + WS_QKV); const float* AB = (const float*)(ws + WS_AB);
    LAS float* gcs = (LAS float*)(lds + GP_MISC); LAS float* betas = gcs + 64; LAS float* egs = gcs + 128; LAS float* egls = gcs + 192;
    LAS float* Mf = (LAS float*)(lds + GP_ST); LAS float* Xf = (LAS float*)(lds + GP_KS); LAS float* Tmp = (LAS float*)(lds + GP_TMP);
    if (wave == 0) {
        const float al = AB[(tok0 + lane) * 16 + h], bl = AB[(tok0 + lane) * 16 + 8 + h];
        float g = -__expf(KIN(18)[l * 8 + h]) * softplusf_(al + KIN(19)[l * 8 + h]);
#pragma unroll
        for (int o = 1; o < 64; o <<= 1) { const float t = __shfl_up(g, o); if (lane >= o) g += t; }
        const float glast = __shfl(g, 63);
        gcs[lane] = g; betas[lane] = sigmoidf_(bl); egs[lane] = __expf(g); egls[lane] = __expf(glast - g);
        if (lane == 0) ((float*)(ws + WS_GL))[unit] = __expf(glast);
    }
    __syncthreads();
    {
        const float* convw = KIN(17) + (size_t)l * 4 * 3072;
        float cw[3][4][2];
#pragma unroll
        for (int sg = 0; sg < 3; ++sg)
#pragma unroll
            for (int k = 0; k < 4; ++k) { const f32x2 w = *(const f32x2*)(convw + k * 3072 + sg * 1024 + h * 128 + 2 * lane); cw[sg][k][0] = w[0]; cw[sg][k][1] = w[1]; }
        float xw[3][3][2];
        const int i0 = wave * 8;
#pragma unroll
        for (int j = 0; j < 3; ++j) { const int tt = t0 + i0 - 3 + j;
#pragma unroll
            for (int sg = 0; sg < 3; ++sg) { unsigned v = 0u; if (tt >= 0) v = *(const unsigned*)(QKV + ((size_t)b * SEQ + tt) * 3072 + sg * 1024 + h * 128 + 2 * lane); xw[sg][j][0] = bflo(v); xw[sg][j][1] = bfhi(v); } }
#pragma unroll
        for (int ii = 0; ii < 8; ++ii) { const int i = i0 + ii; float y[3][2];
#pragma unroll
            for (int sg = 0; sg < 3; ++sg) { const unsigned v = *(const unsigned*)(QKV + (tok0 + i) * 3072 + sg * 1024 + h * 128 + 2 * lane); const float x0 = bflo(v), x1 = bfhi(v);
                y[sg][0] = siluf_(cw[sg][0][0] * xw[sg][0][0] + cw[sg][1][0] * xw[sg][1][0] + cw[sg][2][0] * xw[sg][2][0] + cw[sg][3][0] * x0);
                y[sg][1] = siluf_(cw[sg][0][1] * xw[sg][0][1] + cw[sg][1][1] * xw[sg][1][1] + cw[sg][2][1] * xw[sg][2][1] + cw[sg][3][1] * x1);
                xw[sg][0][0] = xw[sg][1][0]; xw[sg][0][1] = xw[sg][1][1]; xw[sg][1][0] = xw[sg][2][0]; xw[sg][1][1] = xw[sg][2][1]; xw[sg][2][0] = x0; xw[sg][2][1] = x1; }
            const float ssq = wave_sum(y[0][0] * y[0][0] + y[0][1] * y[0][1]), ssk = wave_sum(y[1][0] * y[1][0] + y[1][1] * y[1][1]);
            const float rq = rsqf_(ssq + RMS_EPS) * 0.08838834764831845f, rk = rsqf_(ssk + RMS_EPS);
            const float q0 = y[0][0] * rq, q1 = y[0][1] * rq, k0 = y[1][0] * rk, k1 = y[1][1] * rk;
            const float be = betas[i], eg = egs[i], egl = egls[i];
            *(LAS unsigned*)(lds + GP_QS + i * 288 + lane * 4) = cvt_pk_bf16(q0, q1);
            *(LAS unsigned*)(lds + GP_KS + i * 288 + lane * 4) = cvt_pk_bf16(k0, k1);
            *(LAS bf16_t*)(lds + GP_VT + (2 * lane) * 160 + i * 2) = (bf16_t)f2bf(y[2][0] * be); *(LAS bf16_t*)(lds + GP_VT + (2 * lane + 1) * 160 + i * 2) = (bf16_t)f2bf(y[2][1] * be);
            *(LAS bf16_t*)(lds + GP_KBT + (2 * lane) * 160 + i * 2) = (bf16_t)f2bf(k0 * be * eg); *(LAS bf16_t*)(lds + GP_KBT + (2 * lane + 1) * 160 + i * 2) = (bf16_t)f2bf(k1 * be * eg);
            *(LAS unsigned*)(lds + GP_ST + fragoff(i, 2 * lane, 4) * 2) = cvt_pk_bf16(q0 * eg, q1 * eg);
            *(LAS bf16_t*)(lds + GP_ST + 16384 + fragoff(2 * lane, i, 2) * 2) = (bf16_t)f2bf(k0 * egl);
            *(LAS bf16_t*)(lds + GP_ST + 16384 + fragoff(2 * lane + 1, i, 2) * 2) = (bf16_t)f2bf(k1 * egl);
        }
    }
    __syncthreads();
    {
        u32x4* dq = (u32x4*)(ws + WS_GQD + (size_t)unit * 16384); u32x4* dk = (u32x4*)(ws + WS_GKD + (size_t)unit * 16384);
        const LAS u32x4* sq = (const LAS u32x4*)(lds + GP_ST); const LAS u32x4* sk = (const LAS u32x4*)(lds + GP_ST + 16384);
        dq[tid] = sq[tid]; dq[tid + 512] = sq[tid + 512]; dk[tid] = sk[tid]; dk[tid + 512] = sk[tid + 512];
    }
    __syncthreads();
    {
        const int ti = wave >> 1, tj0 = (wave & 1) * 2;
        f32x4 kk[2], qk[2];
#pragma unroll
        for (int jj = 0; jj < 2; ++jj) { kk[jj] = (f32x4){0.f, 0.f, 0.f, 0.f}; qk[jj] = (f32x4){0.f, 0.f, 0.f, 0.f}; }
#pragma unroll
        for (int s = 0; s < 4; ++s) { const bf16x8 aK = ldsfrag(lds, GP_KS, 288, 16 * ti, 32 * s, lane), aQ = ldsfrag(lds, GP_QS, 288, 16 * ti, 32 * s, lane);
#pragma unroll
            for (int jj = 0; jj < 2; ++jj) { const bf16x8 bK = ldsfrag(lds, GP_KS, 288, 16 * (tj0 + jj), 32 * s, lane);
                kk[jj] = __builtin_amdgcn_mfma_f32_16x16x32_bf16(aK, bK, kk[jj], 0, 0, 0); qk[jj] = __builtin_amdgcn_mfma_f32_16x16x32_bf16(aQ, bK, qk[jj], 0, 0, 0); } }
        LDS_WAIT(); __syncthreads();
#pragma unroll
        for (int jj = 0; jj < 2; ++jj)
#pragma unroll
            for (int r = 0; r < 4; ++r) { const int ii = 16 * ti + 4 * (lane >> 4) + r, jx = 16 * (tj0 + jj) + (lane & 15);
                const float dec = (ii >= jx) ? __expf(gcs[ii] - gcs[jx]) : 0.f;
                Mf[ii * 64 + jx] = (ii > jx) ? betas[ii] * kk[jj][r] * dec : 0.f;
                *(LAS bf16_t*)(lds + GP_ST + 16384 + fragoff(ii, jx, 2) * 2) = (bf16_t)f2bf(qk[jj][r] * dec); }
    }
    __syncthreads();
    {
        for (int e = tid; e < 6 * 256; e += 512) { const int blk = e >> 8, i = (e >> 4) & 15, j = e & 15; const int br = blk < 3 ? 0 : (blk < 5 ? 1 : 2), bc = blk < 3 ? blk + 1 : (blk < 5 ? blk - 1 : 3);
            Xf[(16 * br + i) * 64 + 16 * bc + j] = 0.f; }
        if (wave == 0) { const int bb = lane >> 4, cc = lane & 15; float x[16];
#pragma unroll
            for (int i = 0; i < 16; ++i) { float s = (i == cc) ? 1.f : 0.f;
#pragma unroll
                for (int j = 0; j < i; ++j) s -= Mf[(16 * bb + i) * 64 + 16 * bb + j] * x[j];
                x[i] = s; }
#pragma unroll
            for (int i = 0; i < 16; ++i) Xf[(16 * bb + i) * 64 + 16 * bb + cc] = x[i]; }
    }
    __syncthreads();
    { const int pr = tid >> 8, i = (tid >> 4) & 15, j = tid & 15, lo = 32 * pr, hi = lo + 16; float s = 0.f;
#pragma unroll
      for (int k = 0; k < 16; ++k) s += Mf[(hi + i) * 64 + lo + k] * Xf[(lo + k) * 64 + lo + j];
      Tmp[pr * 256 + i * 16 + j] = s; }
    __syncthreads();
    { const int pr = tid >> 8, i = (tid >> 4) & 15, j = tid & 15, lo = 32 * pr, hi = lo + 16; float s = 0.f;
#pragma unroll
      for (int k = 0; k < 16; ++k) s += Xf[(hi + i) * 64 + hi + k] * Tmp[pr * 256 + k * 16 + j];
      Xf[(hi + i) * 64 + lo + j] = -s; }
    __syncthreads();
#pragma unroll
    for (int rep = 0; rep < 2; ++rep) { const int e = tid + 512 * rep, i = e >> 5, j = e & 31; float s = 0.f;
#pragma unroll 8
        for (int k = 0; k < 32; ++k) s += Mf[(32 + i) * 64 + k] * Xf[k * 64 + j];
        Tmp[i * 32 + j] = s; }
    __syncthreads();
#pragma unroll
    for (int rep = 0; rep < 2; ++rep) { const int e = tid + 512 * rep, i = e >> 5, j = e & 31; float s = 0.f;
#pragma unroll 8
        for (int k = 0; k < 32; ++k) s += Xf[(32 + i) * 64 + 32 + k] * Tmp[k * 32 + j];
        Xf[(32 + i) * 64 + j] = -s; }
    __syncthreads();
    { const int row = tid >> 3, c0 = (tid & 7) * 8; const LAS float* s = Xf + row * 64 + c0;
      u32x4 w; w.x = cvt_pk_bf16(s[0], s[1]); w.y = cvt_pk_bf16(s[2], s[3]); w.z = cvt_pk_bf16(s[4], s[5]); w.w = cvt_pk_bf16(s[6], s[7]);
      *(LAS u32x4*)(lds + GP_TB + row * 160 + c0 * 2) = w; }
    __syncthreads();
    {
        float* GU = (float*)(ws + WS_GU);
#pragma unroll
        for (int i = 0; i < 4; ++i) { f32x4 au = (f32x4){0.f, 0.f, 0.f, 0.f}, aw = (f32x4){0.f, 0.f, 0.f, 0.f};
#pragma unroll
            for (int s = 0; s < 2; ++s) { const bf16x8 a = ldsfrag(lds, GP_TB, 160, 16 * i, 32 * s, lane);
                au = __builtin_amdgcn_mfma_f32_16x16x32_bf16(a, ldsfrag(lds, GP_VT, 160, 16 * wave, 32 * s, lane), au, 0, 0, 0);
                aw = __builtin_amdgcn_mfma_f32_16x16x32_bf16(a, ldsfrag(lds, GP_KBT, 160, 16 * wave, 32 * s, lane), aw, 0, 0, 0); }
            *(f32x4*)(GU + ((((size_t)unit * 8 + wave) * 4 + i) * 64 + lane) * 4) = au;
#pragma unroll
            for (int r = 0; r < 4; ++r) *(LAS bf16_t*)(lds + GP_QS + fragoff(16 * i + 4 * (lane >> 4) + r, 16 * wave + (lane & 15), 4) * 2) = (bf16_t)f2bf(aw[r]); }
    }
    __syncthreads();
    {
        u32x4* dw = (u32x4*)(ws + WS_GW + (size_t)unit * 16384); u32x4* dq = (u32x4*)(ws + WS_GQK + (size_t)unit * 8192);
        const LAS u32x4* sw = (const LAS u32x4*)(lds + GP_QS); const LAS u32x4* sq = (const LAS u32x4*)(lds + GP_ST + 16384);
        dw[tid] = sw[tid]; dw[tid + 512] = sw[tid + 512]; dq[tid] = sq[tid];
    }
    __syncthreads();
}
__device__ __forceinline__ bf16x8 pack2(const f32x4& a, const f32x4& b) { u32x4 w; w.x = cvt_pk_bf16(a[0], a[1]); w.y = cvt_pk_bf16(a[2], a[3]); w.z = cvt_pk_bf16(b[0], b[1]); w.w = cvt_pk_bf16(b[2], b[3]); return __builtin_bit_cast(bf16x8, w); }
constexpr int SC_BUF = 61440, SC_W = 0, SC_QD = 16384, SC_KD = 32768, SC_QK = 49152, SC_U = 57344, SC_OST = 2 * SC_BUF;
__device__ __forceinline__ void gdn_scan_wg(LAS unsigned char* lds, int wave, int lane, int bh, int sl) {
    unsigned char* ws = KWS(); const int b = bh >> 3, h = bh & 7;
    const int role = wave - 1;
    const unsigned char* src0 = ws; size_t ustr0 = 16384; int off0 = 0, n0 = 8;
    if (role == 0 || role == 1) { src0 = ws + WS_GW + (role & 1) * 8192; off0 = SC_W + (role & 1) * 8192; }
    else if (role == 2 || role == 3) { src0 = ws + WS_GQD + (role & 1) * 8192; off0 = SC_QD + (role & 1) * 8192; }
    else if (role == 4 || role == 5) { src0 = ws + WS_GKD + (role & 1) * 8192; off0 = SC_KD + (role & 1) * 8192; }
    else if (role == 6) { src0 = ws + WS_GQK; ustr0 = 8192; off0 = SC_QK; }
    const unsigned char* srcU = ws + WS_GU + (size_t)sl * 4096;
#define SC_LOAD(c_) do { const int unit_ = bh * NCH + (c_); const int bo_ = ((c_) & 1) * SC_BUF; \
        const unsigned char* p_ = src0 + (size_t)unit_ * ustr0 + lane * 16; \
        _Pragma("unroll") for (int k_ = 0; k_ < 8; ++k_) __builtin_amdgcn_global_load_lds((const unsigned*)(p_ + k_ * 1024), (LAS unsigned*)(lds + bo_ + off0 + k_ * 1024), 16, 0, 0); \
        if (role == 6) { const unsigned char* q_ = srcU + (size_t)unit_ * 32768 + lane * 16; \
            _Pragma("unroll") for (int k_ = 0; k_ < 4; ++k_) __builtin_amdgcn_global_load_lds((const unsigned*)(q_ + k_ * 1024), (LAS unsigned*)(lds + bo_ + SC_U + k_ * 1024), 16, 0, 0); } } while (0)
    f32x4 S[8];
#pragma unroll
    for (int j = 0; j < 8; ++j) S[j] = (f32x4){0.f, 0.f, 0.f, 0.f};
    if (wave != 0) { SC_LOAD(0); asm volatile("s_waitcnt vmcnt(0)" ::: "memory"); }
    asm volatile("" ::: "memory"); __builtin_amdgcn_s_barrier(); asm volatile("" ::: "memory");
    float* GO = (float*)(ws + WS_GO);
    for (int c = 0; c < NCH; ++c) {
        if (wave != 0) {
            if (c + 1 < NCH) { SC_LOAD(c + 1); asm volatile("s_waitcnt vmcnt(0)" ::: "memory"); }
        } else {
            const int unit = bh * NCH + c;
            LAS unsigned char* bb = lds + (c & 1) * SC_BUF + lane * 16;
            const float gl = ((const float*)(ws + WS_GL))[unit];
            bf16x8 Sb[4];
#pragma unroll
            for (int s = 0; s < 4; ++s) Sb[s] = pack2(S[2 * s], S[2 * s + 1]);
            f32x4 vn[4], o[4];
#pragma unroll
            for (int i = 0; i < 4; ++i) { f32x4 p = (f32x4){0.f, 0.f, 0.f, 0.f}; o[i] = (f32x4){0.f, 0.f, 0.f, 0.f};
#pragma unroll
                for (int s = 0; s < 4; ++s) { p = __builtin_amdgcn_mfma_f32_16x16x32_bf16(*(const LAS bf16x8*)(bb + SC_W + (i * 4 + s) * 1024), Sb[s], p, 0, 0, 0);
                    o[i] = __builtin_amdgcn_mfma_f32_16x16x32_bf16(*(const LAS bf16x8*)(bb + SC_QD + (i * 4 + s) * 1024), Sb[s], o[i], 0, 0, 0); }
                vn[i] = *(const LAS f32x4*)(bb + SC_U + i * 1024) - p; }
            bf16x8 vb[2];
            vb[0] = pack2(vn[0], vn[1]); vb[1] = pack2(vn[2], vn[3]);
#pragma unroll
            for (int i = 0; i < 4; ++i)
#pragma unroll
                for (int s = 0; s < 2; ++s) o[i] = __builtin_amdgcn_mfma_f32_16x16x32_bf16(*(const LAS bf16x8*)(bb + SC_QK + (i * 2 + s) * 1024), vb[s], o[i], 0, 0, 0);
#pragma unroll
            for (int j = 0; j < 8; ++j) { S[j] = S[j] * gl;
#pragma unroll
                for (int s = 0; s < 2; ++s) S[j] = __builtin_amdgcn_mfma_f32_16x16x32_bf16(*(const LAS bf16x8*)(bb + SC_KD + (j * 2 + s) * 1024), vb[s], S[j], 0, 0, 0); }
            LAS float* ost = (LAS float*)(lds + SC_OST);
#pragma unroll
            for (int i = 0; i < 4; ++i)
#pragma unroll
                for (int r = 0; r < 4; ++r) ost[(16 * i + 4 * (lane >> 4) + r) * 16 + (lane & 15)] = o[i][r];
            LDS_WAIT();
#pragma unroll
            for (int k = 0; k < 4; ++k) { const int row = 16 * k + (lane >> 2); const f32x4 v = *(const LAS f32x4*)(ost + row * 16 + (lane & 3) * 4);
                *(f32x4*)(GO + ((size_t)b * SEQ + c * CH + row) * GDN_W + h * GDN_D + 16 * sl + (lane & 3) * 4) = v; }
            LDS_WAIT();
        }
        asm volatile("" ::: "memory"); __builtin_amdgcn_s_barrier(); asm volatile("" ::: "memory");
    }
#undef SC_LOAD
}
__device__ __forceinline__ void phase_gdn_post(const Frame& F, const float* GO, const bf16_t* Z, const float* ng, bf16_t* CAT) {
    const int d0 = (F.lane & 7) * 16;
    float gv[16];
#pragma unroll
    for (int e = 0; e < 16; ++e) gv[e] = ng[d0 + e];
    for (int m = F.gw(); m < M_TOK; m += F.ngw()) {
        const float* op = GO + (size_t)m * GDN_W + F.lane * 16; float v[16]; float ss = 0.f;
#pragma unroll
        for (int q = 0; q < 4; ++q) { const f32x4 t = *(const f32x4*)(op + 4 * q); v[4 * q] = t[0]; v[4 * q + 1] = t[1]; v[4 * q + 2] = t[2]; v[4 * q + 3] = t[3]; ss += (t[0] * t[0] + t[1] * t[1]) + (t[2] * t[2] + t[3] * t[3]); }
        ss += __shfl_xor(ss, 1); ss += __shfl_xor(ss, 2); ss += __shfl_xor(ss, 4);
        const float rn = rsqf_(ss * (1.0f / GDN_D) + RMS_EPS);
        const u32x4 z0 = *(const u32x4*)(Z + (size_t)m * GDN_W + F.lane * 16), z1 = *(const u32x4*)(Z + (size_t)m * GDN_W + F.lane * 16 + 8);
        const float zz[16] = {bflo(z0.x), bfhi(z0.x), bflo(z0.y), bfhi(z0.y), bflo(z0.z), bfhi(z0.z), bflo(z0.w), bfhi(z0.w), bflo(z1.x), bfhi(z1.x), bflo(z1.y), bfhi(z1.y), bflo(z1.z), bfhi(z1.z), bflo(z1.w), bfhi(z1.w)};
        float o[16];
#pragma unroll
        for (int e = 0; e < 16; ++e) o[e] = v[e] * rn * gv[e] * siluf_(zz[e]);
        u32x4 w0, w1; w0.x = cvt_pk_bf16(o[0], o[1]); w0.y = cvt_pk_bf16(o[2], o[3]); w0.z = cvt_pk_bf16(o[4], o[5]); w0.w = cvt_pk_bf16(o[6], o[7]);
        w1.x = cvt_pk_bf16(o[8], o[9]); w1.y = cvt_pk_bf16(o[10], o[11]); w1.z = cvt_pk_bf16(o[12], o[13]); w1.w = cvt_pk_bf16(o[14], o[15]);
        bf16_t* cp = CAT + (size_t)m * D_MODEL + 512 + F.lane * 16; *(u32x4*)cp = w0; *(u32x4*)(cp + 8) = w1;
    }
}

struct DiagOrder { int nunits, G, c; __device__ bool next(int i, Unit& u) const { if (c < 0) return false; const long L = (long)i * G + c; if (L >= nunits) return false; u.pm = (int)L; u.pn = (int)L; return true; } };
struct GeoS5Intra {
    const char* U5; const char* KT;
    __device__ __forceinline__ int nt() const { return 16; }
    __device__ __forceinline__ int a_voff(int R, int C) const { return (R * 1024 + C) * 2; }
    __device__ __forceinline__ int b_voff(int R, int C) const { return (((R & 15) * 128 - (R >> 4)) * 16 + C) * 2; }
    __device__ __forceinline__ long a_hstep() const { return (long)128 * 1024 * 2; }
    __device__ __forceinline__ long b_hstep() const { return -256; }
    __device__ __forceinline__ const char* a_base(const Unit& u) const { return U5 + (size_t)u.pm * 256 * 1024 * 2; }
    __device__ __forceinline__ const char* b_base(const Unit& u) const { return KT + (size_t)u.pm * (16 * 128 * 16 * 2) + (63 - 16 * u.pn) * 32; }
};
struct GeoS5Inter {
    const char* HX; const char* QT;
    __device__ __forceinline__ int nt() const { return 4; }
    __device__ __forceinline__ int a_voff(int R, int C) const { return (R * 256 + C) * 2; }
    __device__ __forceinline__ int b_voff(int R, int C) const { return (R * 256 + C) * 2; }
    __device__ __forceinline__ long a_hstep() const { return (long)128 * 256 * 2; }
    __device__ __forceinline__ long b_hstep() const { return (long)128 * 256 * 2; }
    __device__ __forceinline__ const char* a_base(const Unit& u) const { return HX + (size_t)u.pm * 256 * 256 * 2; }
    __device__ __forceinline__ const char* b_base(const Unit& u) const { return QT + ((size_t)u.pm * 4 + u.pn) * 256 * 256 * 2; }
};

#define PHASE_FN static __device__ __forceinline__ void
extern __shared__ __attribute__((aligned(16))) unsigned char lds_raw[];
#define UNI(x) x = __builtin_amdgcn_readfirstlane(x)
__device__ __forceinline__ Frame make_frame() { Frame F; F.lds = (LAS unsigned char*)lds_raw;
    int t = threadIdx.x; asm volatile("" : "+v"(t)); F.tid = t; F.lane = t & 63; F.wave = __builtin_amdgcn_readfirstlane(t >> 6);
    int b = blockIdx.x, g = gridDim.x; asm volatile("" : "+s"(b), "+s"(g)); F.bid = b; F.G = g; return F; }
PHASE_FN ph_convert(int l) { UNI(l); const Frame F = make_frame(); unsigned char* const ws = KWS();
    phase_convert(F, l);
    if (l == 0) phase_x_to_bf16(F, KIN(0), (bf16_t*)(ws + WS_XN)); }
PHASE_FN ph_ffn_up(int sb) { UNI(sb); const Frame F = make_frame(); unsigned char* const ws = KWS();
    pg8::GeoStd g{(const char*)(ws + WS_XN), (const char*)(ws + (sb ? WS_WGU2 : WS_WGU1)), D_MODEL, D_MODEL, D_MODEL};
    pg8::StaticOrder S; S.init(M_TOK, 2 * D_FF, F.G, F.bid); EpiSwiGLU E{(bf16_t*)(ws + WS_H)};
    pg8::gemm_phase<pg8::GeoStd, EpiSwiGLU, pg8::StaticOrder, true>(F.lds, F.wave, g, S, E); }
PHASE_FN ph_ffn_down(int sb, int first) { UNI(sb); UNI(first); const Frame F = make_frame(); unsigned char* const ws = KWS();
    pg8::GeoStd g{(const char*)(ws + WS_H), (const char*)(ws + (sb ? WS_WD2 : WS_WD1)), D_FF, D_FF, D_FF};
    float* out = KOUT();
    pg8::StaticOrder S; S.init(M_TOK, D_MODEL, F.G, F.bid); EpiResid E{first ? KIN(0) : out, out, 0.5f};
    pg8::gemm_phase<pg8::GeoStd, EpiResid, pg8::StaticOrder, true>(F.lds, F.wave, g, S, E); }
PHASE_FN ph_ln(int l, int which) { UNI(l); UNI(which); const Frame F = make_frame(); unsigned char* const ws = KWS();
    const float* g = (which == 0 ? KIN(4) : which == 1 ? KIN(29) : KIN(34)) + l * D_MODEL; const float* b = (which == 0 ? KIN(5) : which == 1 ? KIN(30) : KIN(35)) + l * D_MODEL;
    phase_ln(F, KOUT(), g, b, (bf16_t*)(ws + WS_XN)); }
PHASE_FN ph_inproj() { const Frame F = make_frame(); unsigned char* const ws = KWS();
    pg8::GeoStd g{(const char*)(ws + WS_XN), (const char*)(ws + WS_WIN), D_MODEL, D_MODEL, D_MODEL};
    pg8::StaticOrder S; S.init(M_TOK, N_IN_PAD, F.G, F.bid);
    EpiInproj E{(bf16_t*)(ws + WS_U5), (bf16_t*)(ws + WS_QKV), (bf16_t*)(ws + WS_Z), (bf16_t*)(ws + WS_LX), (bf16_t*)(ws + WS_LG), (float*)(ws + WS_AB)};
    pg8::gemm_phase<pg8::GeoStd, EpiInproj, pg8::StaticOrder, true>(F.lds, F.wave, g, S, E); }
PHASE_FN ph_gdn_prep(int l) { UNI(l); const Frame F = make_frame();
    for (int uu = F.bid; uu < NUNIT / 8; uu += F.G)
        for (int u8 = 0; u8 < 8; ++u8) gdn_prep_unit(F, l, uu * 8 + u8); }
PHASE_FN ph_lru_conv(int l) { UNI(l); const Frame F = make_frame(); unsigned char* const ws = KWS();
    phase_lru_conv(F, (const bf16_t*)(ws + WS_LX), KIN(21) + l * 4 * LRU_W, KIN(22) + l * LRU_W, (bf16_t*)(ws + WS_XC)); }
PHASE_FN ph_s5_state() { const Frame F = make_frame(); unsigned char* const ws = KWS();
    pg8::GeoStd g{(const char*)(ws + WS_U5), (const char*)(ws + WS_PTAB), 1024, 1024, 1024};
    DiagOrder S{32, F.G, F.bid}; EpiS5S E{(float*)(ws + WS_S5S)};
    pg8::gemm_phase<pg8::GeoStd, EpiS5S, DiagOrder, false>(F.lds, F.wave, g, S, E); }
PHASE_FN ph_s5_intra() { const Frame F = make_frame(); unsigned char* const ws = KWS();
    GeoS5Intra g{(const char*)(ws + WS_U5), (const char*)(ws + WS_KTAB)};
    pg8::GroupOrder S{128, 4, F.G, F.bid - 32}; EpiS5Intra E{(float*)(ws + WS_YIN)};
    pg8::gemm_phase<GeoS5Intra, EpiS5Intra, pg8::GroupOrder, false>(F.lds, F.wave, g, S, E); }
PHASE_FN ph_gdn_scan() { const Frame F = make_frame();
    const int xcd = F.bid & 7, q = F.bid >> 3; gdn_scan_wg(F.lds, F.wave, F.lane, xcd * 2 + (q >> 3), q & 7); }
struct OwnGroupOrder { int g; __device__ bool next(int i, Unit& u) const { if (i >= 4) return false; u.pm = g; u.pn = i; return true; } };
PHASE_FN ph_chain_a(int l) { UNI(l); const Frame F = make_frame(); unsigned char* const ws = KWS();
    const int w = F.bid - 128;
    if (w < 32) {
        s5_carry_group(w, F.tid, KIN(7) + l * 2048, KIN(8) + l * 2048, KIN(14) + l * 32, (const float*)(ws + WS_S5S), (bf16_t*)(ws + WS_HEXT));
        asm volatile("s_waitcnt vmcnt(0)" ::: "memory"); __syncthreads();
        GeoS5Inter g{(const char*)(ws + WS_HEXT), (const char*)(ws + WS_QTAB)};
        OwnGroupOrder S{w}; EpiS5Inter E{(const float*)(ws + WS_YIN), (const bf16_t*)(ws + WS_U5), KIN(13) + l * S5_W, (bf16_t*)(ws + WS_YACT)};
        pg8::gemm_phase<GeoS5Inter, EpiS5Inter, OwnGroupOrder, false>(F.lds, F.wave, g, S, E);
    } else {
        pg8::GeoStd g{(const char*)(ws + WS_XC), (const char*)(ws + WS_WLRU), LRU_W, LRU_W, LRU_W};
        pg8::StaticOrder S; S.init(M_TOK, 1024, 96, w - 32);
        EpiLRU E{(const bf16_t*)(ws + WS_XC), KIN(24) + l * LRU_W, KIN(26) + l * LRU_W, KIN(27) + l * LRU_W, (float*)(ws + WS_LA), (float*)(ws + WS_LB)};
        pg8::gemm_phase<pg8::GeoStd, EpiLRU, pg8::StaticOrder, false>(F.lds, F.wave, g, S, E);
        asm volatile("s_waitcnt vmcnt(0)" ::: "memory"); __syncthreads();
        Unit u; for (int i = 0; S.next(i, u); ++i) lru_p1_tile(F.tid, u.pm, u.pn, (const float*)(ws + WS_LA), (const float*)(ws + WS_LB), (float*)(ws + WS_CA), (float*)(ws + WS_CB));
    }
    sub_barrier((unsigned*)(ws + WS_CTL) + CW_SUB + 64 * l, 128u);
}
PHASE_FN ph_chain_b(int l) { UNI(l); const Frame F = make_frame(); unsigned char* const ws = KWS();
    const int w = F.bid - 128;
    {   pg8::GeoStd g{(const char*)(ws + WS_YACT), (const char*)(ws + WS_WGLU), S5_W, S5_W, S5_W};
        pg8::StaticOrder S; S.init(M_TOK, S5_W, 128, w); EpiGLU E{(const bf16_t*)(ws + WS_YACT), KIN(16) + l * S5_W, (bf16_t*)(ws + WS_CAT)};
        pg8::gemm_phase<pg8::GeoStd, EpiGLU, pg8::StaticOrder, false>(F.lds, F.wave, g, S, E); }
    phase_lru_p3(w * (NWAVES * 64) + F.tid, 128 * NWAVES * 64, (const float*)(ws + WS_LA), (const float*)(ws + WS_LB), (const float*)(ws + WS_CA), (const float*)(ws + WS_CB), (const bf16_t*)(ws + WS_LG), (bf16_t*)(ws + WS_CAT));
}
PHASE_FN ph_gdn_post(int l) { UNI(l); const Frame F = make_frame(); unsigned char* const ws = KWS();
    phase_gdn_post(F, (const float*)(ws + WS_GO), (const bf16_t*)(ws + WS_Z), KIN(20) + l * GDN_D, (bf16_t*)(ws + WS_CAT)); }
PHASE_FN ph_outproj() { const Frame F = make_frame(); unsigned char* const ws = KWS();
    pg8::GeoStd g{(const char*)(ws + WS_CAT), (const char*)(ws + WS_WOUT), D_MODEL, D_MODEL, D_MODEL};
    float* out = KOUT();
    pg8::StaticOrder S; S.init(M_TOK, D_MODEL, F.G, F.bid); EpiResid E{out, out, 1.0f};
    pg8::gemm_phase<pg8::GeoStd, EpiResid, pg8::StaticOrder, true>(F.lds, F.wave, g, S, E); }
PHASE_FN ph_grid_bar() { XcdBarrier b; b.bar = (unsigned*)(KWS() + WS_CTL) + CW_BAR; b.x = xb_xcc_id(); b.st = (volatile LAS unsigned*)((LAS unsigned char*)lds_raw + MISC_OFF) + 8; xcd_barrier(b); }

#ifndef PROBE_CONVERT
#define PROBE_CONVERT 1
#endif
#ifndef PROBE_FFNUP
#define PROBE_FFNUP 1
#endif
#ifndef PROBE_MIXER
#define PROBE_MIXER 1
#endif
#define GRID_BAR() ph_grid_bar()
#define REPEAT(N, stmt) do { stmt; if constexpr ((N) > 1) { GRID_BAR(); stmt; } } while (0)
template <int L, int SB> __device__ __forceinline__ void half_layer(int bid) {
    REPEAT(PROBE_FFNUP, ph_ffn_up(SB));
    GRID_BAR();
    ph_ffn_down(SB, (L == 0 && SB == 0) ? 1 : 0);
    GRID_BAR();
    ph_ln(L, SB ? 2 : 0);
    GRID_BAR();
    if constexpr (SB == 0) {
        ph_inproj();
        GRID_BAR();
#define MIXER_BODY do { \
          \
        ph_gdn_prep(L); ph_lru_conv(L); ph_s5_state(); ph_s5_intra(); \
        GRID_BAR(); \
          \
        if (bid < 128) ph_gdn_scan(); else { ph_chain_a(L); ph_chain_b(L); } \
        GRID_BAR(); \
          \
        ph_gdn_post(L); } while (0)
        REPEAT(PROBE_MIXER, MIXER_BODY);
#undef MIXER_BODY
        GRID_BAR();
        ph_outproj();
        GRID_BAR();
        ph_ln(L, 1);
        GRID_BAR();
    }
}
template <int L> __device__ __forceinline__ void layer(int bid) {
    REPEAT(PROBE_CONVERT, ph_convert(L));
    GRID_BAR();
    half_layer<L, 0>(bid);
    half_layer<L, 1>(bid);
}
__global__ void __launch_bounds__(NWAVES * 64, 2) fwd_kernel(Params Pdummy) {
    LAS unsigned char* lds = (LAS unsigned char*)lds_raw;
    for (int u = threadIdx.x; u < (LDS_BYTES - LDSCTL_OFF) / 4; u += NWAVES * 64) ((LAS unsigned*)(lds + LDSCTL_OFF))[u] = 0u;
    __syncthreads();
    LAS unsigned* st = (LAS unsigned*)(lds + MISC_OFF) + 8;
    unsigned* barw = (unsigned*)(KWS() + WS_CTL) + CW_BAR;
    (void)xcd_barrier_post(barw, (volatile LAS unsigned*)st);
    int bid = blockIdx.x; asm volatile("" : "+s"(bid));
    layer<0>(bid); layer<1>(bid); layer<2>(bid); layer<3>(bid);
}
#undef GRID_BAR

extern "C" void kernel_launch(void* const* d_in, const int* in_sizes, int n_in, void* d_out, int out_size, void* d_ws, size_t ws_size, hipStream_t stream) {
    static int grid = 0;
    if (grid == 0) {
        if (n_in != 36 || in_sizes[0] != M_TOK * D_MODEL || out_size != M_TOK * D_MODEL || ws_size < WS_END) { fprintf(stderr, "kernel_launch: unexpected shapes (n_in %d, ws %zu < %zu?)\n", n_in, ws_size, (size_t)WS_END); grid = -1; return; }
        int dev = 0, cus = 0, per_cu = 0;
        if (hipGetDevice(&dev) != hipSuccess || hipDeviceGetAttribute(&cus, hipDeviceAttributeMultiprocessorCount, dev) != hipSuccess) { grid = -1; return; }
        if (hipFuncSetAttribute((const void*)fwd_kernel, hipFuncAttributeMaxDynamicSharedMemorySize, LDS_BYTES) != hipSuccess) { fprintf(stderr, "kernel_launch: hipFuncSetAttribute failed\n"); grid = -1; return; }
        if (hipOccupancyMaxActiveBlocksPerMultiprocessor(&per_cu, (const void*)fwd_kernel, NWAVES * 64, LDS_BYTES) != hipSuccess || per_cu < 1) { fprintf(stderr, "kernel_launch: occupancy query reports %d\n", per_cu); }
        (void)hipGetLastError();
        if (cus < 256) { fprintf(stderr, "kernel_launch: needs 256 CUs, device has %d\n", cus); grid = -1; return; }
        grid = 256;
    }
    if (grid < 0) return;
    (void)hipMemsetAsync((char*)d_ws + WS_CTL, 0, CTL_BYTES, stream);
    Params p{};
    for (int i = 0; i < 36; ++i) p.in[i] = (const float*)d_in[i];
    p.out = (float*)d_out; p.ws = (unsigned char*)d_ws;
    hipLaunchKernelGGL(fwd_kernel, dim3(grid), dim3(NWAVES * 64), LDS_BYTES, stream, p);
}
```

```cpp
#include <hip/hip_runtime.h>
#include <cstdio>
#include <cstdint>

#define LAS __attribute__((address_space(3)))
#define GAS __attribute__((address_space(1)))
typedef unsigned short bf16_t;
typedef short bf16x8 __attribute__((ext_vector_type(8)));
typedef float f32x4 __attribute__((ext_vector_type(4)));
typedef float f32x2 __attribute__((ext_vector_type(2)));
typedef unsigned u32x4 __attribute__((ext_vector_type(4)));
typedef unsigned u32x2 __attribute__((ext_vector_type(2)));

constexpr int D_MODEL = 2048, BATCH = 2, SEQ = 8192, DEPTH = 4, M_TOK = BATCH * SEQ;
constexpr int D_FF = 5632, S5_W = 512, S5_G = 32, S5_P = 16, S5_N = 64;
constexpr int GDN_W = 1024, GDN_H = 8, GDN_D = 128, CH = 64, NCH = SEQ / CH  , NCHT = BATCH * NCH  ;
constexpr int LRU_W = 512;
constexpr int D_IN = 5648;
constexpr int N_IN_PAD = 5888;
constexpr float LN_EPS = 1e-5f, RMS_EPS = 1e-6f;
constexpr float DN_ALPHA = 1.6817928305074290f;

__device__ __forceinline__ unsigned cvt_pk_bf16(float lo, float hi) { unsigned r; asm volatile("v_cvt_pk_bf16_f32 %0, %1, %2" : "=v"(r) : "v"(lo), "v"(hi)); return r; }
__device__ __forceinline__ unsigned f2bf(float f) { unsigned u = __builtin_bit_cast(unsigned, f); return (u + 0x7fffu + ((u >> 16) & 1u)) >> 16; }
__device__ __forceinline__ float bf2f(unsigned h) { return __builtin_bit_cast(float, h << 16); }
__device__ __forceinline__ float bflo(unsigned w) { return __builtin_bit_cast(float, w << 16); }
__device__ __forceinline__ float bfhi(unsigned w) { return __builtin_bit_cast(float, w & 0xffff0000u); }
__device__ __forceinline__ float rcpf_(float x) { return __builtin_amdgcn_rcpf(x); }
__device__ __forceinline__ float rsqf_(float x) { return __builtin_amdgcn_rsqf(x); }
__device__ __forceinline__ float sqrtf_(float x) { return __builtin_amdgcn_sqrtf(x); }
__device__ __forceinline__ float sigmoidf_(float x) { return rcpf_(1.0f + __expf(-x)); }
__device__ __forceinline__ float siluf_(float x) { return x * rcpf_(1.0f + __expf(-x)); }
__device__ __forceinline__ float gelu_tanh(float x) { const float u = 0.7978845608028654f * (x + 0.044715f * x * x * x); return x * rcpf_(1.0f + __expf(-2.0f * u)); }
__device__ __forceinline__ float log1p_small(float e) { return e < 0.01f ? e * (1.0f - e * (0.5f - e * (1.0f / 3.0f))) : __logf(1.0f + e); }
__device__ __forceinline__ float softplusf_(float x) { return fmaxf(x, 0.f) + log1p_small(__expf(-fabsf(x))); }
__device__ __forceinline__ float expm1_neg(float z) {
    return fabsf(z) < 0.1f ? z * (1.0f + z * (0.5f + z * ((1.0f / 6.0f) + z * ((1.0f / 24.0f) + z * (1.0f / 120.0f))))) : __expf(z) - 1.0f; }
__device__ __forceinline__ float wave_sum(float v) {
#pragma unroll
    for (int o = 1; o < 64; o <<= 1) v += __shfl_xor(v, o);
    return v;
}

namespace pg8 {
constexpr int BM = 256, BK = 64, HALF = 128, HTB = HALF * BK * 2, STAGE_BYTES = 8 * HTB, NXCD = 8, WGM = 8;
__host__ __device__ __forceinline__ int lds_byte(int r, int c) { const int st = (r >> 4) * 2 + (c >> 5), rr = r & 15, cc = c & 31, ob = rr * 64 + cc * 2; return st * 1024 + (ob ^ (((ob >> 9) & 1) << 5)); }
__host__ __device__ __forceinline__ void stage_rc(int b, int& R, int& C) { const int st = b / 1024, sb = b % 1024, swz = sb ^ (((sb >> 9) & 1) << 5); R = (st >> 1) * 16 + swz / 64; C = (st & 1) * 32 + (swz % 64) / 2; }
__host__ __device__ __forceinline__ int perm32(int rho) { const int n = rho >> 4, i = rho & 15; return 8 * (i >> 2) + 4 * n + (i & 3); }

struct Unit { int pm, pn; };

struct GeoStd {
    const char* A; const char* B; int lda, ldb, K;
    __device__ __forceinline__ int nt() const { return K / BK; }
    __device__ __forceinline__ int a_voff(int R, int C) const { return (R * lda + C) * 2; }
    __device__ __forceinline__ int b_voff(int R, int C) const { return (R * ldb + C) * 2; }
    __device__ __forceinline__ long a_hstep() const { return (long)HALF * lda * 2; }
    __device__ __forceinline__ long b_hstep() const { return (long)HALF * ldb * 2; }
    __device__ __forceinline__ const char* a_base(const Unit& u) const { return A + (size_t)u.pm * BM * lda * 2; }
    __device__ __forceinline__ const char* b_base(const Unit& u) const { return B + (size_t)u.pn * BM * ldb * 2; }
};

struct StaticOrder {
    int nM, nN, nwg, G, c;
    __device__ void init(int M, int N, int G_, int c_) { nM = M / BM; nN = N / BM; nwg = nM * nN; G = G_; c = c_; }
    __device__ bool next(int i, Unit& u) const {
        if (c < 0) return false;
        const long L = (long)i * G + c; if (L >= nwg) return false;
        int wgid = (int)L; { const int q = nwg / NXCD, r = nwg % NXCD, xcd = wgid % NXCD, off = wgid / NXCD; wgid = (xcd < r ? xcd * (q + 1) : r * (q + 1) + (xcd - r) * q) + off; }
        const int nig = WGM * nN, gid = wgid / nig, fm = gid * WGM, gsz = (nM - fm) < WGM ? (nM - fm) : WGM;
        u.pm = fm + ((wgid % nig) % gsz); u.pn = (wgid % nig) / gsz; return true;
    }
};
struct GroupOrder {
    int nunits, per, G, c;
    __device__ bool next(int i, Unit& u) const { if (c < 0) return false; const long L = (long)i * G + c; if (L >= nunits) return false; u.pm = (int)L / per; u.pn = (int)L % per; return true; }
};

template <class Geo, class Epi, class Sched, bool ALIGN_EPI>
__device__ __forceinline__ void gemm_phase(LAS unsigned char* lds, int wave_id, const Geo& g, const Sched& S, const Epi& E) {
    int tid = threadIdx.x; asm volatile("" : "+v"(tid));
    const int wid = __builtin_amdgcn_readfirstlane(tid >> 6), lane = tid & 63, wr = wid >> 2, wc = wid & 3, fr = lane & 15, fq = lane >> 4;
    const int nt = g.nt();
    int voffA[2], voffB[2];
#pragma unroll
    for (int i = 0; i < 2; ++i) { int R, C; stage_rc(tid * 16 + i * 8192, R, C); const int Rb = Epi::PERM ? ((R & ~31) + perm32(R & 31)) : R;
        voffA[i] = g.a_voff(R, C); voffB[i] = g.b_voff(Rb, C); }
    const long kstep = (long)(BK * 2);
    const long hstepA = g.a_hstep(), hstepB = g.b_hstep();
    const unsigned ldsw = (unsigned)wid * 1024u;
    const int aoff = lds_byte(wr * 64 + fr, fq * 8), boff = lds_byte(wc * 32 + fr, fq * 8);
#define PG8_SA(b, h) (((b) * 2 + (h)) * HTB)
#define PG8_SB(b, h) ((4 + (b) * 2 + (h)) * HTB)
#define PG8_STAGE(bufoff, gbase, voff) do { _Pragma("unroll") for (int _i = 0; _i < 2; ++_i) \
        __builtin_amdgcn_global_load_lds((const unsigned*)((const char*)(gbase) + (voff)[_i]), (LAS unsigned*)(lds + (bufoff) + ldsw + _i * 8192), 16, 0, 0); } while (0)
#define PG8_LDA(dst, b, h) do { _Pragma("unroll") for (int m = 0; m < 4; ++m) _Pragma("unroll") for (int k = 0; k < 2; ++k) dst[m][k] = *(const LAS bf16x8*)(lds + PG8_SA(b, h) + aoff + m * 2048 + k * 1024); } while (0)
#define PG8_LDB(dst, b, h) do { _Pragma("unroll") for (int n = 0; n < 2; ++n) _Pragma("unroll") for (int k = 0; k < 2; ++k) dst[n][k] = *(const LAS bf16x8*)(lds + PG8_SB(b, h) + boff + n * 2048 + k * 1024); } while (0)
#define PG8_MMA(ai, bj, At, Bt) do { __builtin_amdgcn_s_setprio(1); _Pragma("unroll") for (int m = 0; m < 4; ++m) _Pragma("unroll") for (int n = 0; n < 2; ++n) _Pragma("unroll") for (int k = 0; k < 2; ++k) \
        acc[ai][bj][m][n] = __builtin_amdgcn_mfma_f32_16x16x32_bf16(Bt[n][k], At[m][k], acc[ai][bj][m][n], 0, 0, 0); __builtin_amdgcn_s_setprio(0); } while (0)
#define PG8_WAIT_V(n) asm volatile("s_waitcnt vmcnt(" #n ")" ::: "memory")
#define PG8_WAIT_L(n) asm volatile("s_waitcnt lgkmcnt(" #n ")" ::: "memory")
#define PG8_BAR __builtin_amdgcn_s_barrier()
#define PG8_SCHED __builtin_amdgcn_sched_barrier(0)
    Unit cur, nxt; int ui = 0;
    if (!S.next(0, cur)) return;
    f32x4 acc[2][2][4][2];
#pragma unroll
    for (int a = 0; a < 2; ++a)
#pragma unroll
        for (int b = 0; b < 2; ++b)
#pragma unroll
            for (int m = 0; m < 4; ++m)
#pragma unroll
                for (int n = 0; n < 2; ++n) acc[a][b][m][n] = (f32x4){0.f, 0.f, 0.f, 0.f};
    bf16x8 At[4][2], B0[2][2], B1[2][2];
    const char* cA = g.a_base(cur); const char* cB = g.b_base(cur);
    PG8_STAGE(PG8_SB(0, 0), cB, voffB); PG8_STAGE(PG8_SB(0, 1), cB + hstepB, voffB); PG8_STAGE(PG8_SA(0, 0), cA, voffA); PG8_STAGE(PG8_SA(0, 1), cA + hstepA, voffA);
    if (wr == 1) PG8_BAR;
    PG8_WAIT_V(2); PG8_BAR;
    PG8_STAGE(PG8_SB(1, 0), cB + kstep, voffB); PG8_STAGE(PG8_SA(1, 0), cA + kstep, voffA); PG8_STAGE(PG8_SB(1, 1), cB + hstepB + kstep, voffB);
    PG8_WAIT_V(6); PG8_BAR;
    for (;;) {
        const bool has_next = S.next(ui + 1, nxt);
        const char* nA = has_next ? g.a_base(nxt) : cA; const char* nB = has_next ? g.b_base(nxt) : cB;
        for (int t = 0; t < nt; t += 2) {
            const bool last = (t == nt - 2);
            const char* a1 = cA + (long)(t + 1) * kstep;
            const char* a2 = last ? nA : cA + (long)(t + 2) * kstep; const char* b2 = last ? nB : cB + (long)(t + 2) * kstep;
            const char* a3 = a2 + kstep; const char* b3 = b2 + kstep;
            PG8_LDB(B0, 0, 0); PG8_LDB(B1, 0, 1); PG8_SCHED; PG8_LDA(At, 0, 0); PG8_STAGE(PG8_SA(1, 1), a1 + hstepA, voffA);
            PG8_WAIT_V(8); PG8_WAIT_L(0); PG8_BAR; PG8_MMA(0, 0, At, B0); PG8_MMA(0, 1, At, B1); PG8_BAR; PG8_SCHED;
            PG8_LDA(At, 0, 1); PG8_STAGE(PG8_SB(0, 0), b2, voffB); PG8_STAGE(PG8_SB(0, 1), b2 + hstepB, voffB); PG8_STAGE(PG8_SA(0, 0), a2, voffA);
            PG8_WAIT_V(8); PG8_WAIT_L(0); PG8_BAR; PG8_MMA(1, 0, At, B0); PG8_MMA(1, 1, At, B1); PG8_BAR; PG8_SCHED;
            PG8_LDB(B0, 1, 0); PG8_LDB(B1, 1, 1); PG8_SCHED; PG8_LDA(At, 1, 0); PG8_STAGE(PG8_SA(0, 1), a2 + hstepA, voffA);
            PG8_WAIT_V(8); PG8_WAIT_L(0); PG8_BAR; PG8_MMA(0, 0, At, B0); PG8_MMA(0, 1, At, B1); PG8_BAR; PG8_SCHED;
            PG8_LDA(At, 1, 1); PG8_STAGE(PG8_SB(1, 0), b3, voffB); PG8_STAGE(PG8_SB(1, 1), b3 + hstepB, voffB); PG8_STAGE(PG8_SA(1, 0), a3, voffA);
            PG8_WAIT_V(8); PG8_WAIT_L(0); PG8_BAR; PG8_MMA(1, 0, At, B0); PG8_MMA(1, 1, At, B1); PG8_BAR; PG8_SCHED;
        }
        if constexpr (ALIGN_EPI) { if (wr == 0) PG8_BAR; }
        {
            Unit ue = cur; int fr_e = fr, fq_e = fq; asm volatile("" : "+s"(ue.pm), "+s"(ue.pn), "+v"(fr_e), "+v"(fq_e));
            E(acc, ue, wr, wc, fr_e, fq_e); }
        if (!has_next) break;
#pragma unroll
        for (int a = 0; a < 2; ++a)
#pragma unroll
            for (int b = 0; b < 2; ++b)
#pragma unroll
                for (int m = 0; m < 4; ++m)
#pragma unroll
                    for (int n = 0; n < 2; ++n) acc[a][b][m][n] = (f32x4){0.f, 0.f, 0.f, 0.f};
        cur = nxt; cA = nA; cB = nB; ++ui;
        if constexpr (ALIGN_EPI) { if (wr == 1) PG8_BAR; }
    }
    PG8_WAIT_V(0);
    if constexpr (!ALIGN_EPI) { if (wr == 0) PG8_BAR; }
    PG8_BAR;
#undef PG8_SA
#undef PG8_SB
#undef PG8_STAGE
#undef PG8_LDA
#undef PG8_LDB
#undef PG8_MMA
#undef PG8_WAIT_V
#undef PG8_WAIT_L
#undef PG8_BAR
#undef PG8_SCHED
}
}

using pg8::Unit;
struct EpiSwiGLU {
    static constexpr bool PERM = true;
    bf16_t* H;
    __device__ __forceinline__ void operator()(const f32x4 (&acc)[2][2][4][2], const Unit& u, int wr, int wc, int fr, int fq) const {
        const int row0 = u.pm * 256 + wr * 64 + fr, col0 = u.pn * 128 + wc * 32 + 8 * fq;
#pragma unroll
        for (int ai = 0; ai < 2; ++ai)
#pragma unroll
            for (int m = 0; m < 4; ++m) {
                bf16_t* rowp = H + (size_t)(row0 + ai * 128 + m * 16) * D_FF + col0;
                const f32x4 g0 = acc[ai][0][m][0], g1 = acc[ai][0][m][1], u0 = acc[ai][1][m][0], u1 = acc[ai][1][m][1];
                u32x4 w;
                w.x = cvt_pk_bf16(siluf_(g0[0]) * u0[0], siluf_(g0[1]) * u0[1]); w.y = cvt_pk_bf16(siluf_(g0[2]) * u0[2], siluf_(g0[3]) * u0[3]);
                w.z = cvt_pk_bf16(siluf_(g1[0]) * u1[0], siluf_(g1[1]) * u1[1]); w.w = cvt_pk_bf16(siluf_(g1[2]) * u1[2], siluf_(g1[3]) * u1[3]);
                *(u32x4*)rowp = w;
            }
    }
};
struct EpiResid {
    static constexpr bool PERM = false;
    const float* res; float* out; float scale;
    __device__ __forceinline__ void operator()(const f32x4 (&acc)[2][2][4][2], const Unit& u, int wr, int wc, int fr, int fq) const {
        const int row0 = u.pm * 256 + wr * 64 + fr, col0 = u.pn * 256 + wc * 32 + 4 * fq;
#pragma unroll
        for (int ai = 0; ai < 2; ++ai)
#pragma unroll
            for (int m = 0; m < 4; ++m) {
                const size_t off = (size_t)(row0 + ai * 128 + m * 16) * D_MODEL + col0;
#pragma unroll
                for (int bj = 0; bj < 2; ++bj)
#pragma unroll
                    for (int n = 0; n < 2; ++n) { const f32x4 r = *(const f32x4*)(res + off + bj * 128 + n * 16); *(f32x4*)(out + off + bj * 128 + n * 16) = r * DN_ALPHA + acc[ai][bj][m][n] * scale; }
            }
    }
};
struct EpiInproj {
    static constexpr bool PERM = true;
    bf16_t *U5, *QKV, *Z, *LX, *LG; float* AB;
    __device__ __forceinline__ void operator()(const f32x4 (&acc)[2][2][4][2], const Unit& u, int wr, int wc, int fr, int fq) const {
        const int row0 = u.pm * 256 + wr * 64 + fr;
        const int pn = u.pn;
#pragma unroll
        for (int ai = 0; ai < 2; ++ai)
#pragma unroll
            for (int m = 0; m < 4; ++m) {
                const int row = row0 + ai * 128 + m * 16;
#pragma unroll
                for (int bj = 0; bj < 2; ++bj) {
                    const int c = pn * 256 + bj * 128 + wc * 32 + 8 * fq;
                    const f32x4 v0 = acc[ai][bj][m][0], v1 = acc[ai][bj][m][1];
                    if (pn == 22) {
                        if (bj == 0 && wc == 0 && fq < 2) { float* p = AB + (size_t)row * 16 + 8 * fq; *(f32x4*)p = v0; *(f32x4*)(p + 4) = v1; }
                    } else {
                        u32x4 w; w.x = cvt_pk_bf16(v0[0], v0[1]); w.y = cvt_pk_bf16(v0[2], v0[3]); w.z = cvt_pk_bf16(v1[0], v1[1]); w.w = cvt_pk_bf16(v1[2], v1[3]);
                        bf16_t* p;
                        if (pn < 2) { const int g = c >> 4, hf = c & 8; p = U5 + ((size_t)g * M_TOK + row) * 16 + hf; }
                        else if (pn < 14) p = QKV + (size_t)row * 3072 + (c - 512);
                        else if (pn < 18) p = Z + (size_t)row * 1024 + (c - 3584);
                        else if (pn < 20) p = LX + (size_t)row * 512 + (c - 4608);
                        else p = LG + (size_t)row * 512 + (c - 5120);
                        *(u32x4*)p = w;
                    }
                }
            }
    }
};
struct EpiS5S {
    static constexpr bool PERM = false;
    float* S;
    __device__ __forceinline__ void operator()(const f32x4 (&acc)[2][2][4][2], const Unit& u, int wr, int wc, int fr, int fq) const {
        const int g = u.pm, row0 = wr * 64 + fr, col0 = wc * 32 + 4 * fq;
#pragma unroll
        for (int ai = 0; ai < 2; ++ai)
#pragma unroll
            for (int m = 0; m < 4; ++m) { float* p = S + ((size_t)g * NCHT + row0 + ai * 128 + m * 16) * 128 + col0;
#pragma unroll
                for (int n = 0; n < 2; ++n) *(f32x4*)(p + n * 16) = acc[ai][0][m][n]; }
    }
};
struct EpiS5Intra {
    static constexpr bool PERM = false;
    float* Y;
    __device__ __forceinline__ void operator()(const f32x4 (&acc)[2][2][4][2], const Unit& u, int wr, int wc, int fr, int fq) const {
        const int g = u.pm, j = u.pn, row0 = wr * 64 + fr;
#pragma unroll
        for (int ai = 0; ai < 2; ++ai)
#pragma unroll
            for (int m = 0; m < 4; ++m) { const int bc = row0 + ai * 128 + m * 16;
#pragma unroll
                for (int bj = 0; bj < 2; ++bj)
#pragma unroll
                    for (int n = 0; n < 2; ++n) { const int col = j * 256 + bj * 128 + wc * 32 + 16 * n + 4 * fq, t = col >> 4, p = col & 15;
                        *(f32x4*)(Y + ((size_t)bc * CH + t) * S5_W + g * 16 + p) = acc[ai][bj][m][n]; }
            }
    }
};
struct EpiS5Inter {
    static constexpr bool PERM = false;
    const float* Y; const bf16_t* U5; const float* dvec; bf16_t* YACT;
    __device__ __forceinline__ void operator()(const f32x4 (&acc)[2][2][4][2], const Unit& u, int wr, int wc, int fr, int fq) const {
        const int g = u.pm, j = u.pn, row0 = wr * 64 + fr;
#pragma unroll
        for (int ai = 0; ai < 2; ++ai)
#pragma unroll
            for (int m = 0; m < 4; ++m) { const int bc = row0 + ai * 128 + m * 16;
#pragma unroll
                for (int bj = 0; bj < 2; ++bj)
#pragma unroll
                    for (int n = 0; n < 2; ++n) { const int col = j * 256 + bj * 128 + wc * 32 + 16 * n + 4 * fq, t = col >> 4, p = col & 15;
                        const size_t tok = (size_t)bc * CH + t; const int ch = g * 16 + p;
                        const f32x4 y0 = *(const f32x4*)(Y + tok * S5_W + ch);
                        const u32x2 uu = *(const u32x2*)(U5 + ((size_t)g * M_TOK + tok) * 16 + p);
                        const f32x4 d0 = *(const f32x4*)(dvec + ch);
                        const f32x4 a0 = acc[ai][bj][m][n];
                        const float o0 = gelu_tanh(a0[0] + y0[0] + d0[0] * bflo(uu.x)), o1 = gelu_tanh(a0[1] + y0[1] + d0[1] * bfhi(uu.x));
                        const float o2 = gelu_tanh(a0[2] + y0[2] + d0[2] * bflo(uu.y)), o3 = gelu_tanh(a0[3] + y0[3] + d0[3] * bfhi(uu.y));
                        u32x2 w; w.x = cvt_pk_bf16(o0, o1); w.y = cvt_pk_bf16(o2, o3);
                        *(u32x2*)(YACT + tok * S5_W + ch) = w; }
                asm volatile("" ::: "memory");
            }
    }
};
struct EpiGLU {
    static constexpr bool PERM = true;
    const bf16_t* YACT; const float* bglu; bf16_t* CAT;
    __device__ __forceinline__ void operator()(const f32x4 (&acc)[2][2][4][2], const Unit& u, int wr, int wc, int fr, int fq) const {
        const int row0 = u.pm * 256 + wr * 64 + fr;
#pragma unroll
        for (int ai = 0; ai < 2; ++ai)
#pragma unroll
            for (int m = 0; m < 4; ++m) { const size_t row = (size_t)(row0 + ai * 128 + m * 16);
#pragma unroll
                for (int bj = 0; bj < 2; ++bj) { const int col = u.pn * 256 + bj * 128 + wc * 32 + 8 * fq;
                    const u32x4 yy = *(const u32x4*)(YACT + row * S5_W + col);
                    const f32x4 b0 = *(const f32x4*)(bglu + col), b1 = *(const f32x4*)(bglu + col + 4);
                    const f32x4 a0 = acc[ai][bj][m][0] + b0, a1 = acc[ai][bj][m][1] + b1;
                    u32x4 w;
                    w.x = cvt_pk_bf16(bflo(yy.x) * sigmoidf_(a0[0]), bfhi(yy.x) * sigmoidf_(a0[1])); w.y = cvt_pk_bf16(bflo(yy.y) * sigmoidf_(a0[2]), bfhi(yy.y) * sigmoidf_(a0[3]));
                    w.z = cvt_pk_bf16(bflo(yy.z) * sigmoidf_(a1[0]), bfhi(yy.z) * sigmoidf_(a1[1])); w.w = cvt_pk_bf16(bflo(yy.w) * sigmoidf_(a1[2]), bfhi(yy.w) * sigmoidf_(a1[3]));
                    *(u32x4*)(CAT + row * D_MODEL + col) = w; }
            }
    }
};
struct EpiLRU {
    static constexpr bool PERM = true;
    const bf16_t* XC; const float *ba, *bx, *lam; float *LA, *LB;
    __device__ __forceinline__ void operator()(const f32x4 (&acc)[2][2][4][2], const Unit& u, int wr, int wc, int fr, int fq) const {
        const int row0 = u.pm * 256 + wr * 64 + fr, ch = u.pn * 128 + wc * 32 + 8 * fq;
        float sp[8], bav[8], bxv[8];
#pragma unroll
        for (int e = 0; e < 8; ++e) { sp[e] = -8.0f * softplusf_(-lam[ch + e]); bav[e] = ba[ch + e]; bxv[e] = bx[ch + e]; }
#pragma unroll
        for (int ai = 0; ai < 2; ++ai)
#pragma unroll
            for (int m = 0; m < 4; ++m) { const size_t row = (size_t)(row0 + ai * 128 + m * 16);
                const u32x4 xx = *(const u32x4*)(XC + row * LRU_W + ch);
                float xc[8] = {bflo(xx.x), bfhi(xx.x), bflo(xx.y), bfhi(xx.y), bflo(xx.z), bfhi(xx.z), bflo(xx.w), bfhi(xx.w)};
                float av[8], bv[8];
#pragma unroll
                for (int e = 0; e < 8; ++e) { const float ra = acc[ai][0][m][e >> 2][e & 3] + bav[e], rx = acc[ai][1][m][e >> 2][e & 3] + bxv[e];
                    const float r = sigmoidf_(ra), ig = sigmoidf_(rx), la = sp[e] * r; av[e] = __expf(la); bv[e] = sqrtf_(fmaxf(-expm1_neg(2.0f * la), 0.f)) * (ig * xc[e]); }
                *(f32x4*)(LA + row * LRU_W + ch) = (f32x4){av[0], av[1], av[2], av[3]}; *(f32x4*)(LA + row * LRU_W + ch + 4) = (f32x4){av[4], av[5], av[6], av[7]};
                *(f32x4*)(LB + row * LRU_W + ch) = (f32x4){bv[0], bv[1], bv[2], bv[3]}; *(f32x4*)(LB + row * LRU_W + ch + 4) = (f32x4){bv[4], bv[5], bv[6], bv[7]};
            }
    }
};

#define XB_TMO      128
#define XB_XCNT(j)  (256  + 64 * (j))
#define XB_XSUB(j)  (1280 + 64 * (j))
#define XB_XGEN(j)  (2304 + 64 * (j))
#define XB_TOP      3328
#define XB_TOPGEN   3392
#define XCD_BAR_WORDS 3456
#define XB_SPIN_CAP (1u << 22)
__device__ __forceinline__ unsigned xb_ld(unsigned* p)              { return __hip_atomic_load(p, __ATOMIC_RELAXED, __HIP_MEMORY_SCOPE_AGENT); }
__device__ __forceinline__ unsigned xb_add(unsigned* p, unsigned v) { return __hip_atomic_fetch_add(p, v, __ATOMIC_RELAXED, __HIP_MEMORY_SCOPE_AGENT); }
__device__ __forceinline__ unsigned xb_xcc_id() { return (unsigned)__builtin_amdgcn_s_getreg((3 << 11) | 20) & 0xFu; }
#define XB_SPIN(cond, bar) do { unsigned _sp = 0; while (cond) { __builtin_amdgcn_s_sleep(1); \
    if ((++_sp & 255u) == 0u) { if (xb_ld(&(bar)[XB_TMO])) break; if (_sp > XB_SPIN_CAP) { atomicAdd(&(bar)[XB_TMO], 1u); break; } } } } while (0)
struct XcdBarrier { unsigned* bar; unsigned x; volatile LAS unsigned* st; };
__device__ __forceinline__ XcdBarrier xcd_barrier_post(unsigned* bar, volatile LAS unsigned* st) {
    XcdBarrier b; b.bar = bar; b.x = xb_xcc_id(); b.st = st;
    if (threadIdx.x == 0) (void)xb_add(&bar[XB_XCNT(b.x)], 1u);
    return b;
}
__device__ __forceinline__ void xcd_barrier_complete(unsigned* bar, unsigned x, unsigned& nloc, unsigned& nx) {
    const unsigned G = gridDim.x * gridDim.y * gridDim.z;
    unsigned sum, cnt, mine, sp = 0u;
    for (;;) {
        sum = 0u; cnt = 0u; mine = 0u;
#pragma unroll
        for (unsigned j = 0; j < 16; ++j) { const unsigned c = xb_ld(&bar[XB_XCNT(j)]); sum += c; cnt += (c > 0u) ? 1u : 0u; mine = (j == x) ? c : mine; }
        if (sum == G) break;
        __builtin_amdgcn_s_sleep(1);
        if ((++sp & 255u) == 0u) { if (xb_ld(&bar[XB_TMO])) break; if (sp > XB_SPIN_CAP) { atomicAdd(&bar[XB_TMO], 1u); break; } }
    }
    nloc = mine > 0u ? mine : 1u; nx = cnt > 0u ? cnt : 1u;
}
__device__ __forceinline__ void xcd_barrier(const XcdBarrier& b) {
    asm volatile("s_waitcnt vmcnt(0)" ::: "memory");
    __syncthreads();
    if (threadIdx.x == 0) {
        unsigned* bar = b.bar; unsigned bx = b.x;
        __builtin_amdgcn_s_waitcnt(0);
        unsigned nloc = b.st[0], nx = b.st[1];
        if (nloc == 0u) { xcd_barrier_complete(bar, bx, nloc, nx); b.st[0] = nloc; b.st[1] = nx; }
        const unsigned old = xb_add(&bar[XB_XSUB(bx)], 1u);
        const unsigned gen = old / nloc;
        if (old + 1u == (gen + 1u) * nloc) {
            __builtin_amdgcn_fence(__ATOMIC_RELEASE, "agent");
            asm volatile("s_waitcnt vmcnt(0)" ::: "memory");
            const unsigned og = xb_add(&bar[XB_TOP], 1u);
            const unsigned tg = og / nx;
            if (og + 1u == (tg + 1u) * nx) xb_add(&bar[XB_TOPGEN], 1u);
            else XB_SPIN(xb_ld(&bar[XB_TOPGEN]) == tg, bar);
            __builtin_amdgcn_fence(__ATOMIC_ACQUIRE, "agent");
            xb_add(&bar[XB_XGEN(bx)], 1u);
            asm volatile("s_waitcnt vmcnt(0)" ::: "memory");
        } else {
            XB_SPIN(xb_ld(&bar[XB_XGEN(bx)]) == gen, bar);
            __builtin_amdgcn_fence(__ATOMIC_ACQUIRE, "agent");
            asm volatile("s_waitcnt vmcnt(0)" ::: "memory");
        }
    }
    __syncthreads();
}

__device__ __forceinline__ void sub_barrier(unsigned* cnt, unsigned target) {
    asm volatile("s_waitcnt vmcnt(0)" ::: "memory");
    __syncthreads();
    if (threadIdx.x == 0) {
        __builtin_amdgcn_fence(__ATOMIC_RELEASE, "agent");
        asm volatile("s_waitcnt vmcnt(0)" ::: "memory");
        (void)xb_add(cnt, 1u);
        unsigned sp = 0u; while (xb_ld(cnt) < target) { __builtin_amdgcn_s_sleep(1); if (++sp > XB_SPIN_CAP) break; }
        __builtin_amdgcn_fence(__ATOMIC_ACQUIRE, "agent");
        asm volatile("s_waitcnt vmcnt(0)" ::: "memory");
    }
    __syncthreads();
}

constexpr size_t al256(size_t x) { return (x + 255) & ~(size_t)255; }
constexpr size_t WS_CTL = 0, CTL_BYTES = 1u << 20;
constexpr size_t SZ_WGU = (size_t)2 * D_FF * D_MODEL * 2, SZ_WD = (size_t)D_MODEL * D_FF * 2, SZ_WIN = (size_t)N_IN_PAD * D_MODEL * 2, SZ_WOUT = (size_t)D_MODEL * D_MODEL * 2;
constexpr size_t WS_WGU1 = WS_CTL + CTL_BYTES, WS_WGU2 = WS_WGU1 + SZ_WGU, WS_WD1 = WS_WGU2 + SZ_WGU, WS_WD2 = WS_WD1 + SZ_WD, WS_WIN = WS_WD2 + SZ_WD, WS_WOUT = WS_WIN + SZ_WIN;
constexpr size_t WS_WGLU = WS_WOUT + SZ_WOUT, WS_WLRU = WS_WGLU + (size_t)512 * 512 * 2;
constexpr size_t WS_KTAB = WS_WLRU + (size_t)1024 * 512 * 2;
constexpr size_t WS_PTAB = WS_KTAB + (size_t)32 * 16 * 128 * 16 * 2;
constexpr size_t WS_QTAB = WS_PTAB + (size_t)32 * 256 * 1024 * 2;
constexpr size_t WS_XN = WS_QTAB + (size_t)32 * 1024 * 256 * 2;
constexpr size_t WS_H = WS_XN + (size_t)M_TOK * D_MODEL * 2;
constexpr size_t WS_U5 = WS_H + (size_t)M_TOK * D_FF * 2;
constexpr size_t WS_QKV = WS_U5 + (size_t)M_TOK * 512 * 2;
constexpr size_t WS_Z = WS_QKV + (size_t)M_TOK * 3072 * 2;
constexpr size_t WS_AB = WS_Z + (size_t)M_TOK * 1024 * 2;
constexpr size_t WS_LX = WS_AB + (size_t)M_TOK * 16 * 4;
constexpr size_t WS_LG = WS_LX + (size_t)M_TOK * 512 * 2;
constexpr size_t WS_XC = WS_LG + (size_t)M_TOK * 512 * 2;
constexpr int NUNIT = BATCH * GDN_H * NCH;
constexpr size_t WS_GU = WS_XC + (size_t)M_TOK * 512 * 2;
constexpr size_t WS_GW = WS_GU + (size_t)NUNIT * 64 * 128 * 4;
constexpr size_t WS_GQD = WS_GW + (size_t)NUNIT * 16384;
constexpr size_t WS_GKD = WS_GQD + (size_t)NUNIT * 16384;
constexpr size_t WS_GQK = WS_GKD + (size_t)NUNIT * 16384;
constexpr size_t WS_GL = WS_GQK + (size_t)NUNIT * 8192;
constexpr size_t WS_GO = WS_GL + al256((size_t)NUNIT * 4);
constexpr size_t WS_S5S = WS_GO + (size_t)M_TOK * 1024 * 4;
constexpr size_t WS_HEXT = WS_S5S + (size_t)32 * 256 * 128 * 4;
constexpr size_t WS_YIN = WS_HEXT + (size_t)4 * 32 * 256 * 256 * 2;
constexpr size_t WS_YACT = WS_YIN + (size_t)M_TOK * 512 * 4;
constexpr size_t WS_LA = WS_YACT + (size_t)M_TOK * 512 * 2;
constexpr size_t WS_LB = WS_LA + (size_t)M_TOK * 512 * 4;
constexpr size_t WS_CA = WS_LB + (size_t)M_TOK * 512 * 4;
constexpr size_t WS_CB = WS_CA + (size_t)NCHT * 512 * 4;
constexpr size_t WS_CIN = WS_CB + (size_t)NCHT * 512 * 4;
constexpr size_t WS_CAT = WS_CIN + (size_t)NCHT * 512 * 4;
constexpr size_t WS_END = WS_CAT + (size_t)M_TOK * D_MODEL * 2;
constexpr int CW_BAR = 4096, CW_SUB = 8192;

constexpr int RING_BYTES = 131072, LDSCTL_OFF = 155648, MISC_OFF = LDSCTL_OFF + 320, LDS_BYTES = 157696;
constexpr int NWAVES = 8;

struct Params { const float* in[36]; float* out; unsigned char* ws; };
typedef const __attribute__((address_space(4))) unsigned char* kptr_t;
__device__ __forceinline__ kptr_t karg_base() { kptr_t k = (kptr_t)__builtin_amdgcn_kernarg_segment_ptr(); asm volatile("" : "+s"(k)); return k; }
__device__ __forceinline__ const float* KIN(int i) { return *(const float* const __attribute__((address_space(4)))*)(karg_base() + 8 * i); }
__device__ __forceinline__ float* KOUT() { return *(float* const __attribute__((address_space(4)))*)(karg_base() + 8 * 36); }
__device__ __forceinline__ unsigned char* KWS() { return *(unsigned char* const __attribute__((address_space(4)))*)(karg_base() + 8 * 37); }
struct Frame {
    LAS unsigned char* lds; int tid, lane, wave, G, bid;
    __device__ __forceinline__ int gw() const { return bid * NWAVES + wave; }
    __device__ __forceinline__ int ngw() const { return G * NWAVES; }
    __device__ __forceinline__ int gt() const { return bid * (NWAVES * 64) + tid; }
    __device__ __forceinline__ int ngt() const { return G * NWAVES * 64; }
};
#define LDS_WAIT() asm volatile("s_waitcnt lgkmcnt(0)" ::: "memory")
__device__ __forceinline__ Frame fresh(const Frame& F0) { Frame F = F0; int w = F0.wave; asm volatile("" : "+s"(w)); int ln = (int)__builtin_amdgcn_mbcnt_hi(~0u, __builtin_amdgcn_mbcnt_lo(~0u, 0u)); asm volatile("" : "+v"(ln));
    F.wave = w; F.lane = ln; F.tid = w * 64 + ln;
    int b = blockIdx.x, g = gridDim.x; asm volatile("" : "+s"(b), "+s"(g)); F.bid = b; F.G = g; return F; }

#ifndef PROBE_TS_A
#define PROBE_TS_A -1
#endif
#ifndef PROBE_TS_B
#define PROBE_TS_B -1
#endif
#ifndef PROBE_TS_MULT
#define PROBE_TS_MULT 8
#endif
constexpr int CW_TS = 12288;
template <int L> __device__ __forceinline__ void STAMP(int slot, int blk) {
    if constexpr (PROBE_TS_A >= 0) { if (threadIdx.x == 0 && (int)blockIdx.x == blk && (slot == PROBE_TS_A || slot == PROBE_TS_B)) {
        unsigned long long* ts = (unsigned long long*)((unsigned*)(KWS() + WS_CTL) + CW_TS); __hip_atomic_store(ts + L * 32 + slot, __builtin_amdgcn_s_memrealtime(), __ATOMIC_RELAXED, __HIP_MEMORY_SCOPE_AGENT); } }
}
__device__ __forceinline__ void STAMPR(int l, int slot, int blk) {
    if constexpr (PROBE_TS_A >= 0) { if (threadIdx.x == 0 && (int)blockIdx.x == blk && (slot == PROBE_TS_A || slot == PROBE_TS_B)) {
        unsigned long long* ts = (unsigned long long*)((unsigned*)(KWS() + WS_CTL) + CW_TS); __hip_atomic_store(ts + l * 32 + slot, __builtin_amdgcn_s_memrealtime(), __ATOMIC_RELAXED, __HIP_MEMORY_SCOPE_AGENT); } }
}
__device__ __forceinline__ void probe_tail() {
    if constexpr (PROBE_TS_A >= 0) { if (threadIdx.x == 0 && blockIdx.x == 0) {
        unsigned long long* ts = (unsigned long long*)((unsigned*)(KWS() + WS_CTL) + CW_TS); unsigned long long tot = 0;
        for (int l = 0; l < DEPTH; ++l) { const unsigned long long a = __hip_atomic_load(ts + l * 32 + PROBE_TS_A, __ATOMIC_RELAXED, __HIP_MEMORY_SCOPE_AGENT), b = __hip_atomic_load(ts + l * 32 + PROBE_TS_B, __ATOMIC_RELAXED, __HIP_MEMORY_SCOPE_AGENT); if (b > a) tot += b - a; }
        tot *= PROBE_TS_MULT; if (tot > 40000000ull) tot = 40000000ull;
        const unsigned long long t0 = __builtin_amdgcn_s_memrealtime();
        while (__builtin_amdgcn_s_memrealtime() - t0 < tot) __builtin_amdgcn_s_sleep(32); } }
}

struct MapId { __device__ __forceinline__ int operator()(int n) const { return n; } };
struct MapGU { int half; __device__ __forceinline__ int operator()(int n) const { return 256 * (n >> 7) + 128 * half + (n & 127); } };
struct MapIn { __device__ __forceinline__ int operator()(int n) const { return n < 4608 ? n : (n < 4624 ? 5632 + (n - 4608) : n - 16); } };
template <int K, int N, class Map>
__device__ __forceinline__ void transpose_item(const float* W, bf16_t* WT, int item, int lane, const Map map) {
    constexpr int nblk = (N + 63) >> 6;
    const int kb = item / nblk, nb = item - kb * nblk, k0 = 64 * kb, n = 64 * nb + lane;
    if (n < N) {
        const float* p = W + (size_t)k0 * N + n;
        float v[64];
#pragma unroll
        for (int i = 0; i < 64; ++i) v[i] = p[(size_t)i * N];
        bf16_t* q = WT + (size_t)map(n) * K + k0;
#pragma unroll
        for (int j = 0; j < 8; ++j) { u32x4 o; o.x = cvt_pk_bf16(v[8 * j], v[8 * j + 1]); o.y = cvt_pk_bf16(v[8 * j + 2], v[8 * j + 3]); o.z = cvt_pk_bf16(v[8 * j + 4], v[8 * j + 5]); o.w = cvt_pk_bf16(v[8 * j + 6], v[8 * j + 7]);
            *(u32x4*)(q + 8 * j) = o; }
    }
}
__device__ __forceinline__ void cplx_pow(float lre, float lim, float dt, int d, float& zr, float& zi) {
    const float mag = __expf((float)d * lre * dt);
    const double rev = (double)d * ((double)dt * (double)lim) * 0.15915494309189535;
    const float r = (float)(rev - rint(rev));
    zr = mag * __builtin_amdgcn_cosf(r); zi = mag * __builtin_amdgcn_sinf(r);
}
__device__ __forceinline__ void s5_coef(float lre, float lim, float dt, float& cr, float& ci) {
    const float a = lre * dt; const double rev = ((double)dt * (double)lim) * 0.15915494309189535; const float r = (float)(rev - rint(rev));
    const float cb = __builtin_amdgcn_cosf(r), sb = __builtin_amdgcn_sinf(r), sh = __builtin_amdgcn_sinf(0.5f * r);
    const float er = expm1_neg(a) * cb - 2.0f * sh * sh, ei = __expf(a) * sb;
    const float den = rcpf_(lre * lre + lim * lim);
    cr = (er * lre + ei * lim) * den; ci = (ei * lre - er * lim) * den;
}
__device__ __forceinline__ void phase_convert(const Frame& F, int l) {
    unsigned char* ws = KWS();
    const int gw = F.gw(), NGW = F.ngw();
    constexpr int I_GU = (D_MODEL / 64) * (D_FF / 64), I_DN = (D_FF / 64) * (D_MODEL / 64), I_IN = (D_MODEL / 64) * ((D_IN + 63) / 64), I_OUT = (D_MODEL / 64) * (D_MODEL / 64), I_GLU = (512 / 64) * (512 / 64);
    constexpr int NITEMS = 4 * I_GU + 2 * I_DN + I_IN + I_OUT + I_GLU;
    const size_t oGU = (size_t)l * D_MODEL * D_FF, oIN = (size_t)l * D_MODEL * D_IN, oOUT = (size_t)l * D_MODEL * D_MODEL, oGLU = (size_t)l * 512 * 512;
    for (int it = gw; it < NITEMS; it += NGW) {
        int r = it;
        if (r < I_GU) { transpose_item<D_MODEL, D_FF>(KIN(1) + oGU, (bf16_t*)(ws + WS_WGU1), r, F.lane, MapGU{0}); continue; } r -= I_GU;
        if (r < I_GU) { transpose_item<D_MODEL, D_FF>(KIN(2) + oGU, (bf16_t*)(ws + WS_WGU1), r, F.lane, MapGU{1}); continue; } r -= I_GU;
        if (r < I_DN) { transpose_item<D_FF, D_MODEL>(KIN(3) + oGU, (bf16_t*)(ws + WS_WD1), r, F.lane, MapId{}); continue; } r -= I_DN;
        if (r < I_GU) { transpose_item<D_MODEL, D_FF>(KIN(31) + oGU, (bf16_t*)(ws + WS_WGU2), r, F.lane, MapGU{0}); continue; } r -= I_GU;
        if (r < I_GU) { transpose_item<D_MODEL, D_FF>(KIN(32) + oGU, (bf16_t*)(ws + WS_WGU2), r, F.lane, MapGU{1}); continue; } r -= I_GU;
        if (r < I_DN) { transpose_item<D_FF, D_MODEL>(KIN(33) + oGU, (bf16_t*)(ws + WS_WD2), r, F.lane, MapId{}); continue; } r -= I_DN;
        if (r < I_IN) { transpose_item<D_MODEL, D_IN>(KIN(6) + oIN, (bf16_t*)(ws + WS_WIN), r, F.lane, MapIn{}); continue; } r -= I_IN;
        if (r < I_OUT) { transpose_item<D_MODEL, D_MODEL>(KIN(28) + oOUT, (bf16_t*)(ws + WS_WOUT), r, F.lane, MapId{}); continue; } r -= I_OUT;
        transpose_item<512, 512>(KIN(15) + oGLU, (bf16_t*)(ws + WS_WGLU), r, F.lane, MapId{});
    }
    STAMPR(l, 25, 40);
    const int gt = F.gt(), NGT = F.ngt();
    { const float* wa = KIN(23) + (size_t)l * 8 * 64 * 64; const float* wx = KIN(25) + (size_t)l * 8 * 64 * 64; bf16_t* WL = (bf16_t*)(ws + WS_WLRU);
      for (int idx = gt; idx < 1024 * 512; idx += NGT) { const int row = idx >> 9, k = idx & 511, pn = row >> 8, bj = (row >> 7) & 1, j = row & 127, c = 128 * pn + j, h = c >> 6;
          float v = 0.f; if ((k >> 6) == h) v = (bj ? wx : wa)[(h * 64 + (k & 63)) * 64 + (c & 63)];
          WL[idx] = (bf16_t)f2bf(v); } }
    STAMPR(l, 26, 40);
    if (F.G == 256) {
        __syncthreads();
        const float* lre_ = KIN(7) + l * 2048; const float* lim_ = KIN(8) + l * 2048; const float* bre = KIN(9) + (size_t)l * 32768; const float* bim = KIN(10) + (size_t)l * 32768;
        const float* cre = KIN(11) + (size_t)l * 32768; const float* cim = KIN(12) + (size_t)l * 32768; const float* lstep = KIN(14) + l * 32;
        const int g = F.bid & 31, sl8 = F.bid >> 5, tid = F.tid;
        LAS float* PW = (LAS float*)F.lds;
        LAS float* LB = PW + 64 * 18;
        LAS float* CF = LB + 128;
        const float dt = __expf(lstep[g]);
        for (int e = tid; e < 64 * 9; e += 512) { const int n = e / 9, k = e - 9 * n; const float lre = fminf(lre_[g * 64 + n], -1e-4f), lim = lim_[g * 64 + n];
            float zr, zi; cplx_pow(lre, lim, dt, 8 * k, zr, zi); PW[e * 2] = zr; PW[e * 2 + 1] = zi; }
        if (tid < 64) { const float lre = fminf(lre_[g * 64 + tid], -1e-4f), lim = lim_[g * 64 + tid]; float ar, ai, cr, ci; cplx_pow(lre, lim, dt, 1, ar, ai); s5_coef(lre, lim, dt, cr, ci);
            LB[2 * tid] = ar; LB[2 * tid + 1] = ai; CF[2 * tid] = cr; CF[2 * tid + 1] = ci; }
        LAS float* BR = CF + 128; LAS float* BI = BR + 1024; LAS float* CR = BI + 1024; LAS float* CI = CR + 1024;
        for (int e = tid; e < 1024; e += 512) { BR[e] = bre[g * 1024 + e]; BI[e] = bim[g * 1024 + e]; CR[e] = cre[g * 1024 + e]; CI[e] = cim[g * 1024 + e]; }
        __syncthreads();
        bf16_t* KT = (bf16_t*)(ws + WS_KTAB); bf16_t* PT = (bf16_t*)(ws + WS_PTAB); bf16_t* QT = (bf16_t*)(ws + WS_QTAB);
        if (tid < 256) {
            const int it = sl8 * 256 + tid, q = it & 15, d8 = (it >> 4) & 7, p = it >> 7;
            float acc[8];
#pragma unroll
            for (int dd = 0; dd < 8; ++dd) acc[dd] = 0.f;
            for (int n = 0; n < 64; ++n) { const float zr = PW[(n * 9 + d8) * 2], zi = PW[(n * 9 + d8) * 2 + 1], ar = LB[2 * n], ai = LB[2 * n + 1], cr = CF[2 * n], ci = CF[2 * n + 1];
                const float br = BR[n * 16 + q], bi = BI[n * 16 + q];
                const float bbr = cr * br - ci * bi, bbi = cr * bi + ci * br;
                float wr_ = zr * bbr - zi * bbi, wi_ = zr * bbi + zi * bbr;
                const float c_r = CR[p * 64 + n], c_i = CI[p * 64 + n];
#pragma unroll
                for (int dd = 0; dd < 8; ++dd) { acc[dd] += c_r * wr_ - c_i * wi_; const float t = wr_ * ar - wi_ * ai; wi_ = wr_ * ai + wi_ * ar; wr_ = t; } }
#pragma unroll
            for (int dd = 0; dd < 8; ++dd) KT[(((size_t)g * 16 + p) * 128 + (63 - 8 * d8 - dd)) * 16 + q] = (bf16_t)f2bf(acc[dd]);
        }
#pragma unroll
        for (int rep = 0; rep < 2; ++rep) {
            const int it = sl8 * 1024 + rep * 512 + tid, q = it & 15, s8 = (it >> 4) & 7, n = it >> 7;
            const float zr = PW[(n * 9 + (7 - s8)) * 2], zi = PW[(n * 9 + (7 - s8)) * 2 + 1], ar = LB[2 * n], ai = LB[2 * n + 1], cr = CF[2 * n], ci = CF[2 * n + 1];
            const float br = BR[n * 16 + q], bi = BI[n * 16 + q];
            const float bbr = cr * br - ci * bi, bbi = cr * bi + ci * br;
            float wr_ = zr * bbr - zi * bbi, wi_ = zr * bbi + zi * bbr;
#pragma unroll
            for (int ss = 7; ss >= 0; --ss) { const int s_ = 8 * s8 + ss;
                PT[((size_t)g * 256 + 2 * n) * 1024 + s_ * 16 + q] = (bf16_t)f2bf(wr_); PT[((size_t)g * 256 + 2 * n + 1) * 1024 + s_ * 16 + q] = (bf16_t)f2bf(wi_);
                const float t = wr_ * ar - wi_ * ai; wi_ = wr_ * ai + wi_ * ar; wr_ = t; }
        }
#pragma unroll
        for (int rep = 0; rep < 2; ++rep) {
            const int it = sl8 * 1024 + rep * 512 + tid, n = it & 63, t8 = (it >> 6) & 7, p = it >> 9;
            const float ar = LB[2 * n], ai = LB[2 * n + 1]; const float z0r = PW[(n * 9 + t8) * 2], z0i = PW[(n * 9 + t8) * 2 + 1];
            const float zr = z0r * ar - z0i * ai, zi = z0r * ai + z0i * ar;
            const float c_r = CR[p * 64 + n], c_i = CI[p * 64 + n];
            float wr_ = c_r * zr - c_i * zi, wi_ = c_r * zi + c_i * zr;
#pragma unroll
            for (int tt = 0; tt < 8; ++tt) { const int t = 8 * t8 + tt;
                *(unsigned*)(QT + ((size_t)g * 1024 + t * 16 + p) * 256 + 2 * n) = cvt_pk_bf16(wr_, -wi_);
                const float tmp = wr_ * ar - wi_ * ai; wi_ = wr_ * ai + wi_ * ar; wr_ = tmp; }
        }
        if (l == 0) {
            for (int idx = gt; idx < 32 * 16 * 64 * 2; idx += NGT) { const int gp = idx >> 7, r = idx & 127; *(u32x4*)(KT + ((size_t)gp * 128 + 64) * 16 + r * 8) = (u32x4){0u, 0u, 0u, 0u}; }
            for (int idx = gt; idx < 32 * 1024 * 16; idx += NGT) { const int row = idx >> 4, r = idx & 15; *(u32x4*)(QT + (size_t)row * 256 + 128 + r * 8) = (u32x4){0u, 0u, 0u, 0u}; } }
        __syncthreads();
    }
    STAMPR(l, 27, 40);
}
__device__ __forceinline__ void phase_x_to_bf16(const Frame& F, const float* x, bf16_t* XN) {
    const size_t n8 = (size_t)M_TOK * D_MODEL / 8;
    for (size_t i = F.gt(); i < n8; i += F.ngt()) { const f32x4 a = *(const f32x4*)(x + i * 8), b = *(const f32x4*)(x + i * 8 + 4);
        u32x4 w; w.x = cvt_pk_bf16(a[0], a[1]); w.y = cvt_pk_bf16(a[2], a[3]); w.z = cvt_pk_bf16(b[0], b[1]); w.w = cvt_pk_bf16(b[2], b[3]); *(u32x4*)(XN + i * 8) = w; }
}
__device__ __forceinline__ void phase_ln(const Frame& F, float* X, const float* gam, const float* bet, bf16_t* XN) {
    f32x4 gv[8], bv[8];
#pragma unroll
    for (int j = 0; j < 8; ++j) { gv[j] = *(const f32x4*)(gam + 4 * F.lane + 256 * j); bv[j] = *(const f32x4*)(bet + 4 * F.lane + 256 * j); }
    for (int m = F.gw(); m < M_TOK; m += F.ngw()) {
        float* xr = X + (size_t)m * D_MODEL + 4 * F.lane; f32x4 v[8]; float s = 0.f;
#pragma unroll
        for (int j = 0; j < 8; ++j) { v[j] = *(const f32x4*)(xr + 256 * j); s += (v[j][0] + v[j][1]) + (v[j][2] + v[j][3]); }
        const float mean = wave_sum(s) * (1.f / D_MODEL); float s2 = 0.f;
#pragma unroll
        for (int j = 0; j < 8; ++j) { v[j] = v[j] - mean; s2 += (v[j][0] * v[j][0] + v[j][1] * v[j][1]) + (v[j][2] * v[j][2] + v[j][3] * v[j][3]); }
        const float rstd = rsqf_(wave_sum(s2) * (1.f / D_MODEL) + LN_EPS);
        bf16_t* xo = XN + (size_t)m * D_MODEL + 4 * F.lane;
#pragma unroll
        for (int j = 0; j < 8; ++j) { const f32x4 o = v[j] * rstd * gv[j] + bv[j]; *(f32x4*)(xr + 256 * j) = o;
            u32x2 w; w.x = cvt_pk_bf16(o[0], o[1]); w.y = cvt_pk_bf16(o[2], o[3]); *(u32x2*)(xo + 256 * j) = w; }
    }
}

__device__ __forceinline__ void phase_lru_conv(const Frame& F, const bf16_t* LX, const float* cw, const float* cb, bf16_t* XC) {
    const int nitems = M_TOK * 64;
    for (int it = F.gt(); it < nitems; it += F.ngt()) {
        const int row = it >> 6, c8 = (it & 63) * 8, t = row & (SEQ - 1);
        float acc[8];
#pragma unroll
        for (int e = 0; e < 8; ++e) acc[e] = cb[c8 + e];
#pragma unroll
        for (int k = 0; k < 4; ++k) { const int dt_ = 3 - k; if (t - dt_ >= 0) {
                const u32x4 xx = *(const u32x4*)(LX + (size_t)(row - dt_) * LRU_W + c8);
                const f32x4 w0 = *(const f32x4*)(cw + k * LRU_W + c8), w1 = *(const f32x4*)(cw + k * LRU_W + c8 + 4);
                acc[0] += w0[0] * bflo(xx.x); acc[1] += w0[1] * bfhi(xx.x); acc[2] += w0[2] * bflo(xx.y); acc[3] += w0[3] * bfhi(xx.y);
                acc[4] += w1[0] * bflo(xx.z); acc[5] += w1[1] * bfhi(xx.z); acc[6] += w1[2] * bflo(xx.w); acc[7] += w1[3] * bfhi(xx.w); } }
        u32x4 w; w.x = cvt_pk_bf16(acc[0], acc[1]); w.y = cvt_pk_bf16(acc[2], acc[3]); w.z = cvt_pk_bf16(acc[4], acc[5]); w.w = cvt_pk_bf16(acc[6], acc[7]);
        *(u32x4*)(XC + (size_t)row * LRU_W + c8) = w;
    }
}
__device__ __forceinline__ void lru_p1_tile(int tid, int pm, int pn, const float* LA, const float* LB, float* CA, float* CB) {
    const int bc = pm * 4 + (tid >> 7), ch = pn * 128 + (tid & 127); const size_t base = (size_t)bc * CH * LRU_W + ch;
    float A = 1.f, B = 0.f;
#pragma unroll 16
    for (int t = 0; t < CH; ++t) { const float a = LA[base + (size_t)t * LRU_W], b = LB[base + (size_t)t * LRU_W]; B = a * B + b; A *= a; }
    CA[bc * LRU_W + ch] = A; CB[bc * LRU_W + ch] = B;
}
__device__ __forceinline__ void phase_lru_p3(int gt, int ngt, const float* LA, const float* LB, const float* CA, const float* CB, const bf16_t* LG, bf16_t* CAT) {
    for (int it = gt; it < NCHT * LRU_W; it += ngt) {
        const int bc = it >> 9, ch = it & 511, b = bc >> 7, c = bc & (NCH - 1); const size_t row0 = (size_t)bc * CH;
        float h = 0.f;
        for (int cc = 0; cc < c; ++cc) { const int o = (b * NCH + cc) * LRU_W + ch; h = CA[o] * h + CB[o]; }
#pragma unroll 8
        for (int t = 0; t < CH; ++t) { const size_t row = row0 + t; h = LA[row * LRU_W + ch] * h + LB[row * LRU_W + ch];
            const float gt_ = bf2f(LG[row * LRU_W + ch]); CAT[row * D_MODEL + 1536 + ch] = (bf16_t)f2bf(h * gelu_tanh(gt_)); }
    }
}

__device__ __forceinline__ void s5_carry_group(int g, int tix, const float* lre_, const float* lim_, const float* lstep, const float* S5S, bf16_t* HEXT) {
    if (tix >= BATCH * 64) return;
    const int b = tix >> 6, n = tix & 63;
    const float dt = __expf(lstep[g]); const float lre = fminf(lre_[g * 64 + n], -1e-4f), lim = lim_[g * 64 + n];
    float ar, ai; cplx_pow(lre, lim, dt, 64, ar, ai);
    float hr = 0.f, hi = 0.f;
    for (int c0 = 0; c0 < NCH; c0 += 16) {
        f32x2 sv[16];
#pragma unroll
        for (int k = 0; k < 16; ++k) sv[k] = *(const f32x2*)(S5S + ((size_t)g * NCHT + b * NCH + c0 + k) * 128 + 2 * n);
#pragma unroll
        for (int k = 0; k < 16; ++k) { const size_t rowi = (size_t)g * NCHT + b * NCH + c0 + k;
            *(unsigned*)(HEXT + rowi * 256 + 2 * n) = cvt_pk_bf16(hr, hi); *(unsigned*)(HEXT + rowi * 256 + 128 + 2 * n) = 0u;
            const float nr = ar * hr - ai * hi + sv[k][0], ni = ar * hi + ai * hr + sv[k][1]; hr = nr; hi = ni; } }
}

__device__ __forceinline__ int fragoff(int m, int k, int KS) { const int idx = k & 31, g = (idx & 15) >> 2, j = (idx & 3) + 4 * (idx >> 4); return ((((m >> 4) * KS + (k >> 5)) * 64) + 16 * g + (m & 15)) * 8 + j; }
__device__ __forceinline__ bf16x8 ldsfrag(LAS unsigned char* lds, int base, int stride, int row0, int k0, int lane) { return *(const LAS bf16x8*)(lds + base + (row0 + (lane & 15)) * stride + (k0 + 8 * (lane >> 4)) * 2); }
constexpr int GP_QS = 0, GP_KS = 18432, GP_VT = 36864, GP_KBT = 57344, GP_ST = 77824, GP_TB = 110592, GP_MISC = 120832, GP_TMP = GP_MISC + 1024;
__device__ __forceinline__ void gdn_prep_unit(const Frame& F, int l, int unit) {
    unsigned char* ws = KWS(); LAS unsigned char* lds = F.lds;
    const int tid = F.tid, lane = F.lane, wave = F.wave;
    const int c = unit & (NCH - 1), bh = unit >> 7, h = bh & 7, b = bh >> 3, t0 = c * CH; const size_t tok0 = (size_t)b * SEQ + t0;
    const bf16_t* QKV = (const bf16_t*)(ws + WS_QKV); const float* AB = (const float*)(ws + WS_AB);
    LAS float* gcs = (LAS float*)(lds + GP_MISC); LAS float* betas = gcs + 64; LAS float* egs = gcs + 128; LAS float* egls = gcs + 192;
    LAS float* Mf = (LAS float*)(lds + GP_ST); LAS float* Xf = (LAS float*)(lds + GP_KS); LAS float* Tmp = (LAS float*)(lds + GP_TMP);
    if (wave == 0) {
        const float al = AB[(tok0 + lane) * 16 + h], bl = AB[(tok0 + lane) * 16 + 8 + h];
        float g = -__expf(KIN(18)[l * 8 + h]) * softplusf_(al + KIN(19)[l * 8 + h]);
#pragma unroll
        for (int o = 1; o < 64; o <<= 1) { const float t = __shfl_up(g, o); if (lane >= o) g += t; }
        const float glast = __shfl(g, 63);
        gcs[lane] = g; betas[lane] = sigmoidf_(bl); egs[lane] = __expf(g); egls[lane] = __expf(glast - g);
        if (lane == 0) ((float*)(ws + WS_GL))[unit] = __expf(glast);
    }
    __syncthreads();
    {
        const float* convw = KIN(17) + (size_t)l * 4 * 3072;
        float cw[3][4][2];
#pragma unroll
        for (int sg = 0; sg < 3; ++sg)
#pragma unroll
            for (int k = 0; k < 4; ++k) { const f32x2 w = *(const f32x2*)(convw + k * 3072 + sg * 1024 + h * 128 + 2 * lane); cw[sg][k][0] = w[0]; cw[sg][k][1] = w[1]; }
        float xw[3][3][2];
        const int i0 = wave * 8;
#pragma unroll
        for (int j = 0; j < 3; ++j) { const int tt = t0 + i0 - 3 + j;
#pragma unroll
            for (int sg = 0; sg < 3; ++sg) { unsigned v = 0u; if (tt >= 0) v = *(const unsigned*)(QKV + ((size_t)b * SEQ + tt) * 3072 + sg * 1024 + h * 128 + 2 * lane); xw[sg][j][0] = bflo(v); xw[sg][j][1] = bfhi(v); } }
#pragma unroll
        for (int ii = 0; ii < 8; ++ii) { const int i = i0 + ii; float y[3][2];
#pragma unroll
            for (int sg = 0; sg < 3; ++sg) { const unsigned v = *(const unsigned*)(QKV + (tok0 + i) * 3072 + sg * 1024 + h * 128 + 2 * lane); const float x0 = bflo(v), x1 = bfhi(v);
                y[sg][0] = siluf_(cw[sg][0][0] * xw[sg][0][0] + cw[sg][1][0] * xw[sg][1][0] + cw[sg][2][0] * xw[sg][2][0] + cw[sg][3][0] * x0);
                y[sg][1] = siluf_(cw[sg][0][1] * xw[sg][0][1] + cw[sg][1][1] * xw[sg][1][1] + cw[sg][2][1] * xw[sg][2][1] + cw[sg][3][1] * x1);
                xw[sg][0][0] = xw[sg][1][0]; xw[sg][0][1] = xw[sg][1][1]; xw[sg][1][0] = xw[sg][2][0]; xw[sg][1][1] = xw[sg][2][1]; xw[sg][2][0] = x0; xw[sg][2][1] = x1; }
            const float ssq = wave_sum(y[0][0] * y[0][0] + y[0][1] * y[0][1]), ssk = wave_sum(y[1][0] * y[1][0] + y[1][1] * y[1][1]);
            const float rq = rsqf_(ssq + RMS_EPS) * 0.08838834764831845f, rk = rsqf_(ssk + RMS_EPS);
            const float q0 = y[0][0] * rq, q1 = y[0][1] * rq, k0 = y[1][0] * rk, k1 = y[1][1] * rk;
            const float be = betas[i], eg = egs[i], egl = egls[i];
            *(LAS unsigned*)(lds + GP_QS + i * 288 + lane * 4) = cvt_pk_bf16(q0, q1);
            *(LAS unsigned*)(lds + GP_KS + i * 288 + lane * 4) = cvt_pk_bf16(k0, k1);
            *(LAS bf16_t*)(lds + GP_VT + (2 * lane) * 160 + i * 2) = (bf16_t)f2bf(y[2][0] * be); *(LAS bf16_t*)(lds + GP_VT + (2 * lane + 1) * 160 + i * 2) = (bf16_t)f2bf(y[2][1] * be);
            *(LAS bf16_t*)(lds + GP_KBT + (2 * lane) * 160 + i * 2) = (bf16_t)f2bf(k0 * be * eg); *(LAS bf16_t*)(lds + GP_KBT + (2 * lane + 1) * 160 + i * 2) = (bf16_t)f2bf(k1 * be * eg);
            *(LAS unsigned*)(lds + GP_ST + fragoff(i, 2 * lane, 4) * 2) = cvt_pk_bf16(q0 * eg, q1 * eg);
            *(LAS bf16_t*)(lds + GP_ST + 16384 + fragoff(2 * lane, i, 2) * 2) = (bf16_t)f2bf(k0 * egl);
            *(LAS bf16_t*)(lds + GP_ST + 16384 + fragoff(2 * lane + 1, i, 2) * 2) = (bf16_t)f2bf(k1 * egl);
        }
    }
    __syncthreads();
    {
        u32x4* dq = (u32x4*)(ws + WS_GQD + (size_t)unit * 16384); u32x4* dk = (u32x4*)(ws + WS_GKD + (size_t)unit * 16384);
        const LAS u32x4* sq = (const LAS u32x4*)(lds + GP_ST); const LAS u32x4* sk = (const LAS u32x4*)(lds + GP_ST + 16384);
        dq[tid] = sq[tid]; dq[tid + 512] = sq[tid + 512]; dk[tid] = sk[tid]; dk[tid + 512] = sk[tid + 512];
    }
    __syncthreads();
    {
        const int ti = wave >> 1, tj0 = (wave & 1) * 2;
        f32x4 kk[2], qk[2];
#pragma unroll
        for (int jj = 0; jj < 2; ++jj) { kk[jj] = (f32x4){0.f, 0.f, 0.f, 0.f}; qk[jj] = (f32x4){0.f, 0.f, 0.f, 0.f}; }
#pragma unroll
        for (int s = 0; s < 4; ++s) { const bf16x8 aK = ldsfrag(lds, GP_KS, 288, 16 * ti, 32 * s, lane), aQ = ldsfrag(lds, GP_QS, 288, 16 * ti, 32 * s, lane);
#pragma unroll
            for (int jj = 0; jj < 2; ++jj) { const bf16x8 bK = ldsfrag(lds, GP_KS, 288, 16 * (tj0 + jj), 32 * s, lane);
                kk[jj] = __builtin_amdgcn_mfma_f32_16x16x32_bf16(aK, bK, kk[jj], 0, 0, 0); qk[jj] = __builtin_amdgcn_mfma_f32_16x16x32_bf16(aQ, bK, qk[jj], 0, 0, 0); } }
        LDS_WAIT(); __syncthreads();
#pragma unroll
        for (int jj = 0; jj < 2; ++jj)
#pragma unroll
            for (int r = 0; r < 4; ++r) { const int ii = 16 * ti + 4 * (lane >> 4) + r, jx = 16 * (tj0 + jj) + (lane & 15);
                const float dec = (ii >= jx) ? __expf(gcs[ii] - gcs[jx]) : 0.f;
                Mf[ii * 64 + jx] = (ii > jx) ? betas[ii] * kk[jj][r] * dec : 0.f;
                *(LAS bf16_t*)(lds + GP_ST + 16384 + fragoff(ii, jx, 2) * 2) = (bf16_t)f2bf(qk[jj][r] * dec); }
    }
    __syncthreads();
    {
        for (int e = tid; e < 6 * 256; e += 512) { const int blk = e >> 8, i = (e >> 4) & 15, j = e & 15; const int br = blk < 3 ? 0 : (blk < 5 ? 1 : 2), bc = blk < 3 ? blk + 1 : (blk < 5 ? blk - 1 : 3);
            Xf[(16 * br + i) * 64 + 16 * bc + j] = 0.f; }
        if (wave == 0) { const int bb = lane >> 4, cc = lane & 15; float x[16];
#pragma unroll
            for (int i = 0; i < 16; ++i) { float s = (i == cc) ? 1.f : 0.f;
#pragma unroll
                for (int j = 0; j < i; ++j) s -= Mf[(16 * bb + i) * 64 + 16 * bb + j] * x[j];
                x[i] = s; }
#pragma unroll
            for (int i = 0; i < 16; ++i) Xf[(16 * bb + i) * 64 + 16 * bb + cc] = x[i]; }
    }
    __syncthreads();
    { const int pr = tid >> 8, i = (tid >> 4) & 15, j = tid & 15, lo = 32 * pr, hi = lo + 16; float s = 0.f;
#pragma unroll
      for (int k = 0; k < 16; ++k) s += Mf[(hi + i) * 64 + lo + k] * Xf[(lo + k) * 64 + lo + j];
      Tmp[pr * 256 + i * 16 + j] = s; }
    __syncthreads();
    { const int pr = tid >> 8, i = (tid >> 4) & 15, j = tid & 15, lo = 32 * pr, hi = lo + 16; float s = 0.f;
#pragma unroll
      for (int k = 0; k < 16; ++k) s += Xf[(hi + i) * 64 + hi + k] * Tmp[pr * 256 + k * 16 + j];
      Xf[(hi + i) * 64 + lo + j] = -s; }
    __syncthreads();
#pragma unroll
    for (int rep = 0; rep < 2; ++rep) { const int e = tid + 512 * rep, i = e >> 5, j = e & 31; float s = 0.f;
#pragma unroll 8
        for (int k = 0; k < 32; ++k) s += Mf[(32 + i) * 64 + k] * Xf[k * 64 + j];
        Tmp[i * 32 + j] = s; }
    __syncthreads();
#pragma unroll
    for (int rep = 0; rep < 2; ++rep) { const int e = tid + 512 * rep, i = e >> 5, j = e & 31; float s = 0.f;
#pragma unroll 8
        for (int k = 0; k < 32; ++k) s += Xf[(32 + i) * 64 + 32 + k] * Tmp[k * 32 + j];
        Xf[(32 + i) * 64 + j] = -s; }
    __syncthreads();
    { const int row = tid >> 3, c0 = (tid & 7) * 8; const LAS float* s = Xf + row * 64 + c0;
      u32x4 w; w.x = cvt_pk_bf16(s[0], s[1]); w.y = cvt_pk_bf16(s[2], s[3]); w.z = cvt_pk_bf16(s[4], s[5]); w.w = cvt_pk_bf16(s[6], s[7]);
      *(LAS u32x4*)(lds + GP_TB + row * 160 + c0 * 2) = w; }
    __syncthreads();
    {
        float* GU = (float*)(ws + WS_GU);
#pragma unroll
        for (int i = 0; i < 4; ++i) { f32x4 au = (f32x4){0.f, 0.f, 0.f, 0.f}, aw = (f32x4){0.f, 0.f, 0.f, 0.f};
#pragma unroll
            for (int s = 0; s < 2; ++s) { const bf16x8 a = ldsfrag(lds, GP_TB, 160, 16 * i, 32 * s, lane);
                au = __builtin_amdgcn_mfma_f32_16x16x32_bf16(a, ldsfrag(lds, GP_VT, 160, 16 * wave, 32 * s, lane), au, 0, 0, 0);
                aw = __builtin_amdgcn_mfma_f32_16x16x32_bf16(a, ldsfrag(lds, GP_KBT, 160, 16 * wave, 32 * s, lane), aw, 0, 0, 0); }
            *(f32x4*)(GU + ((((size_t)unit * 8 + wave) * 4 + i) * 64 + lane) * 4) = au;
#pragma unroll
            for (int r = 0; r < 4; ++r) *(LAS bf16_t*)(lds + GP_QS + fragoff(16 * i + 4 * (lane >> 4) + r, 16 * wave + (lane & 15), 4) * 2) = (bf16_t)f2bf(aw[r]); }
    }
    __syncthreads();
    {
        u32x4* dw = (u32x4*)(ws + WS_GW + (size_t)unit * 16384); u32x4* dq = (u32x4*)(ws + WS_GQK + (size_t)unit * 8192);
        const LAS u32x4* sw = (const LAS u32x4*)(lds + GP_QS); const LAS u32x4* sq = (const LAS u32x4*)(lds + GP_ST + 16384);
        dw[tid] = sw[tid]; dw[tid + 512] = sw[tid + 512]; dq[tid] = sq[tid];
    }
    __syncthreads();
}
__device__ __forceinline__ bf16x8 pack2(const f32x4& a, const f32x4& b) { u32x4 w; w.x = cvt_pk_bf16(a[0], a[1]); w.y = cvt_pk_bf16(a[2], a[3]); w.z = cvt_pk_bf16(b[0], b[1]); w.w = cvt_pk_bf16(b[2], b[3]); return __builtin_bit_cast(bf16x8, w); }
constexpr int SC_BUF = 61440, SC_W = 0, SC_QD = 16384, SC_KD = 32768, SC_QK = 49152, SC_U = 57344, SC_OST = 2 * SC_BUF, SC_AHEAD = 3;
__device__ __forceinline__ void gdn_scan_wg(LAS unsigned char* lds, int wave, int lane, int bh, int sl) {
    unsigned char* ws = KWS(); const int b = bh >> 3, h = bh & 7;
    const int role = wave - 1;
    const unsigned char* src0 = ws; size_t ustr0 = 16384; int off0 = 0;
    if (role == 0 || role == 1) { src0 = ws + WS_GW + (role & 1) * 8192; off0 = SC_W + (role & 1) * 8192; }
    else if (role == 2 || role == 3) { src0 = ws + WS_GQD + (role & 1) * 8192; off0 = SC_QD + (role & 1) * 8192; }
    else if (role == 4 || role == 5) { src0 = ws + WS_GKD + (role & 1) * 8192; off0 = SC_KD + (role & 1) * 8192; }
    else if (role == 6) { src0 = ws + WS_GQK; ustr0 = 8192; off0 = SC_QK; }
    const unsigned char* srcU = ws + WS_GU + (size_t)sl * 4096;
#define SC_LOAD(c_) do { const int unit_ = bh * NCH + (c_); const int bo_ = ((c_) & 1) * SC_BUF; \
        const unsigned char* p_ = src0 + (size_t)unit_ * ustr0 + lane * 16; \
        _Pragma("unroll") for (int k_ = 0; k_ < 8; ++k_) __builtin_amdgcn_global_load_lds((const unsigned*)(p_ + k_ * 1024), (LAS unsigned*)(lds + bo_ + off0 + k_ * 1024), 16, 0, 0); \
        if (role == 6) { const unsigned char* q_ = srcU + (size_t)unit_ * 32768 + lane * 16; \
            _Pragma("unroll") for (int k_ = 0; k_ < 4; ++k_) __builtin_amdgcn_global_load_lds((const unsigned*)(q_ + k_ * 1024), (LAS unsigned*)(lds + bo_ + SC_U + k_ * 1024), 16, 0, 0); } } while (0)
    f32x4 S[8];
#pragma unroll
    for (int j = 0; j < 8; ++j) S[j] = (f32x4){0.f, 0.f, 0.f, 0.f};
    if (wave != 0) { SC_LOAD(0); asm volatile("s_waitcnt vmcnt(0)" ::: "memory"); }
    asm volatile("" ::: "memory"); __builtin_amdgcn_s_barrier(); asm volatile("" ::: "memory");
    bf16_t* GO = (bf16_t*)(ws + WS_GO);
    const float* GLp = (const float*)(ws + WS_GL) + bh * NCH;
    float gl_next = GLp[0];
    for (int c = 0; c < NCH; ++c) {
        const float gl = gl_next; gl_next = GLp[c + 1 < NCH ? c + 1 : c];
        if (wave != 0) {
            if (c + 1 < NCH) { SC_LOAD(c + 1); asm volatile("s_waitcnt vmcnt(0)" ::: "memory"); }
        } else {
            LAS unsigned char* bb = lds + (c & 1) * SC_BUF + lane * 16;
            bf16x8 Sb[4];
#pragma unroll
            for (int s = 0; s < 4; ++s) Sb[s] = pack2(S[2 * s], S[2 * s + 1]);
            f32x4 vn[4], o[4];
#pragma unroll
            for (int i = 0; i < 4; ++i) { f32x4 p = (f32x4){0.f, 0.f, 0.f, 0.f}; o[i] = (f32x4){0.f, 0.f, 0.f, 0.f};
#pragma unroll
                for (int s = 0; s < 4; ++s) { p = __builtin_amdgcn_mfma_f32_16x16x32_bf16(*(const LAS bf16x8*)(bb + SC_W + (i * 4 + s) * 1024), Sb[s], p, 0, 0, 0);
                    o[i] = __builtin_amdgcn_mfma_f32_16x16x32_bf16(*(const LAS bf16x8*)(bb + SC_QD + (i * 4 + s) * 1024), Sb[s], o[i], 0, 0, 0); }
                vn[i] = *(const LAS f32x4*)(bb + SC_U + i * 1024) - p; }
            bf16x8 vb[2];
            vb[0] = pack2(vn[0], vn[1]); vb[1] = pack2(vn[2], vn[3]);
#pragma unroll
            for (int i = 0; i < 4; ++i)
#pragma unroll
                for (int s = 0; s < 2; ++s) o[i] = __builtin_amdgcn_mfma_f32_16x16x32_bf16(*(const LAS bf16x8*)(bb + SC_QK + (i * 2 + s) * 1024), vb[s], o[i], 0, 0, 0);
#pragma unroll
            for (int j = 0; j < 8; ++j) { S[j] = S[j] * gl;
#pragma unroll
                for (int s = 0; s < 2; ++s) S[j] = __builtin_amdgcn_mfma_f32_16x16x32_bf16(*(const LAS bf16x8*)(bb + SC_KD + (j * 2 + s) * 1024), vb[s], S[j], 0, 0, 0); }
            LAS bf16_t* ost = (LAS bf16_t*)(lds + SC_OST);
#pragma unroll
            for (int i = 0; i < 4; ++i)
#pragma unroll
                for (int r = 0; r < 4; ++r) ost[(16 * i + 4 * (lane >> 4) + r) * 16 + (lane & 15)] = (bf16_t)f2bf(o[i][r]);
            LDS_WAIT();
#pragma unroll
            for (int k = 0; k < 2; ++k) { const int row = 32 * k + (lane >> 1); const u32x4 v = *(const LAS u32x4*)(ost + row * 16 + (lane & 1) * 8);
                *(u32x4*)(GO + ((size_t)b * SEQ + c * CH + row) * GDN_W + h * GDN_D + 16 * sl + (lane & 1) * 8) = v; }
            LDS_WAIT();
        }
        asm volatile("" ::: "memory"); __builtin_amdgcn_s_barrier(); asm volatile("" ::: "memory");
    }
#undef SC_LOAD
}
__device__ __forceinline__ void phase_gdn_post(const Frame& F, const bf16_t* GO, const bf16_t* Z, const float* ng, bf16_t* CAT) {
    const int d0 = (F.lane & 7) * 16;
    float gv[16];
#pragma unroll
    for (int e = 0; e < 16; ++e) gv[e] = ng[d0 + e];
    for (int m = F.gw(); m < M_TOK; m += F.ngw()) {
        const u32x4 o0 = *(const u32x4*)(GO + (size_t)m * GDN_W + F.lane * 16), o1 = *(const u32x4*)(GO + (size_t)m * GDN_W + F.lane * 16 + 8);
        const float v[16] = {bflo(o0.x), bfhi(o0.x), bflo(o0.y), bfhi(o0.y), bflo(o0.z), bfhi(o0.z), bflo(o0.w), bfhi(o0.w), bflo(o1.x), bfhi(o1.x), bflo(o1.y), bfhi(o1.y), bflo(o1.z), bfhi(o1.z), bflo(o1.w), bfhi(o1.w)};
        float ss = 0.f;
#pragma unroll
        for (int e = 0; e < 16; ++e) ss += v[e] * v[e];
        ss += __shfl_xor(ss, 1); ss += __shfl_xor(ss, 2); ss += __shfl_xor(ss, 4);
        const float rn = rsqf_(ss * (1.0f / GDN_D) + RMS_EPS);
        const u32x4 z0 = *(const u32x4*)(Z + (size_t)m * GDN_W + F.lane * 16), z1 = *(const u32x4*)(Z + (size_t)m * GDN_W + F.lane * 16 + 8);
        const float zz[16] = {bflo(z0.x), bfhi(z0.x), bflo(z0.y), bfhi(z0.y), bflo(z0.z), bfhi(z0.z), bflo(z0.w), bfhi(z0.w), bflo(z1.x), bfhi(z1.x), bflo(z1.y), bfhi(z1.y), bflo(z1.z), bfhi(z1.z), bflo(z1.w), bfhi(z1.w)};
        float o[16];
#pragma unroll
        for (int e = 0; e < 16; ++e) o[e] = v[e] * rn * gv[e] * siluf_(zz[e]);
        u32x4 w0, w1; w0.x = cvt_pk_bf16(o[0], o[1]); w0.y = cvt_pk_bf16(o[2], o[3]); w0.z = cvt_pk_bf16(o[4], o[5]); w0.w = cvt_pk_bf16(o[6], o[7]);
        w1.x = cvt_pk_bf16(o[8], o[9]); w1.y = cvt_pk_bf16(o[10], o[11]); w1.z = cvt_pk_bf16(o[12], o[13]); w1.w = cvt_pk_bf16(o[14], o[15]);
        bf16_t* cp = CAT + (size_t)m * D_MODEL + 512 + F.lane * 16; *(u32x4*)cp = w0; *(u32x4*)(cp + 8) = w1;
    }
}

struct DiagOrder { int nunits, G, c; __device__ bool next(int i, Unit& u) const { if (c < 0) return false; const long L = (long)i * G + c; if (L >= nunits) return false; u.pm = (int)L; u.pn = (int)L; return true; } };
struct GeoS5Intra {
    const char* U5; const char* KT;
    __device__ __forceinline__ int nt() const { return 16; }
    __device__ __forceinline__ int a_voff(int R, int C) const { return (R * 1024 + C) * 2; }
    __device__ __forceinline__ int b_voff(int R, int C) const { return (((R & 15) * 128 - (R >> 4)) * 16 + C) * 2; }
    __device__ __forceinline__ long a_hstep() const { return (long)128 * 1024 * 2; }
    __device__ __forceinline__ long b_hstep() const { return -256; }
    __device__ __forceinline__ const char* a_base(const Unit& u) const { return U5 + (size_t)u.pm * 256 * 1024 * 2; }
    __device__ __forceinline__ const char* b_base(const Unit& u) const { return KT + (size_t)u.pm * (16 * 128 * 16 * 2) + (63 - 16 * u.pn) * 32; }
};
struct GeoS5Inter {
    const char* HX; const char* QT;
    __device__ __forceinline__ int nt() const { return 4; }
    __device__ __forceinline__ int a_voff(int R, int C) const { return (R * 256 + C) * 2; }
    __device__ __forceinline__ int b_voff(int R, int C) const { return (R * 256 + C) * 2; }
    __device__ __forceinline__ long a_hstep() const { return (long)128 * 256 * 2; }
    __device__ __forceinline__ long b_hstep() const { return (long)128 * 256 * 2; }
    __device__ __forceinline__ const char* a_base(const Unit& u) const { return HX + (size_t)u.pm * 256 * 256 * 2; }
    __device__ __forceinline__ const char* b_base(const Unit& u) const { return QT + ((size_t)u.pm * 4 + u.pn) * 256 * 256 * 2; }
};

#define PHASE_FN static __device__ __forceinline__ void
extern __shared__ __attribute__((aligned(16))) unsigned char lds_raw[];
#define UNI(x) x = __builtin_amdgcn_readfirstlane(x)
__device__ __forceinline__ Frame make_frame() { Frame F; F.lds = (LAS unsigned char*)lds_raw;
    int t = threadIdx.x; asm volatile("" : "+v"(t)); F.tid = t; F.lane = t & 63; F.wave = __builtin_amdgcn_readfirstlane(t >> 6);
    int b = blockIdx.x, g = gridDim.x; asm volatile("" : "+s"(b), "+s"(g)); F.bid = b; F.G = g; return F; }
PHASE_FN ph_convert(int l) { UNI(l); const Frame F = make_frame(); unsigned char* const ws = KWS();
    phase_convert(F, l);
    if (l == 0) phase_x_to_bf16(F, KIN(0), (bf16_t*)(ws + WS_XN)); }
PHASE_FN ph_ffn_up(int sb) { UNI(sb); const Frame F = make_frame(); unsigned char* const ws = KWS();
    pg8::GeoStd g{(const char*)(ws + WS_XN), (const char*)(ws + (sb ? WS_WGU2 : WS_WGU1)), D_MODEL, D_MODEL, D_MODEL};
    pg8::StaticOrder S; S.init(M_TOK, 2 * D_FF, F.G, F.bid); EpiSwiGLU E{(bf16_t*)(ws + WS_H)};
    pg8::gemm_phase<pg8::GeoStd, EpiSwiGLU, pg8::StaticOrder, true>(F.lds, F.wave, g, S, E); }
PHASE_FN ph_ffn_down(int sb, int first) { UNI(sb); UNI(first); const Frame F = make_frame(); unsigned char* const ws = KWS();
    pg8::GeoStd g{(const char*)(ws + WS_H), (const char*)(ws + (sb ? WS_WD2 : WS_WD1)), D_FF, D_FF, D_FF};
    float* out = KOUT();
    pg8::StaticOrder S; S.init(M_TOK, D_MODEL, F.G, F.bid); EpiResid E{first ? KIN(0) : out, out, 0.5f};
    pg8::gemm_phase<pg8::GeoStd, EpiResid, pg8::StaticOrder, true>(F.lds, F.wave, g, S, E); }
PHASE_FN ph_ln(int l, int which) { UNI(l); UNI(which); const Frame F = make_frame(); unsigned char* const ws = KWS();
    const float* g = (which == 0 ? KIN(4) : which == 1 ? KIN(29) : KIN(34)) + l * D_MODEL; const float* b = (which == 0 ? KIN(5) : which == 1 ? KIN(30) : KIN(35)) + l * D_MODEL;
    phase_ln(F, KOUT(), g, b, (bf16_t*)(ws + WS_XN)); }
PHASE_FN ph_inproj() { const Frame F = make_frame(); unsigned char* const ws = KWS();
    pg8::GeoStd g{(const char*)(ws + WS_XN), (const char*)(ws + WS_WIN), D_MODEL, D_MODEL, D_MODEL};
    pg8::StaticOrder S; S.init(M_TOK, N_IN_PAD, F.G, F.bid);
    EpiInproj E{(bf16_t*)(ws + WS_U5), (bf16_t*)(ws + WS_QKV), (bf16_t*)(ws + WS_Z), (bf16_t*)(ws + WS_LX), (bf16_t*)(ws + WS_LG), (float*)(ws + WS_AB)};
    pg8::gemm_phase<pg8::GeoStd, EpiInproj, pg8::StaticOrder, true>(F.lds, F.wave, g, S, E); }
PHASE_FN ph_gdn_prep(int l) { UNI(l); const Frame F = make_frame();
    for (int uu = F.bid; uu < NUNIT / 8; uu += F.G)
        for (int u8 = 0; u8 < 8; ++u8) gdn_prep_unit(F, l, uu * 8 + u8); }
PHASE_FN ph_lru_conv(int l) { UNI(l); const Frame F = make_frame(); unsigned char* const ws = KWS();
    phase_lru_conv(F, (const bf16_t*)(ws + WS_LX), KIN(21) + l * 4 * LRU_W, KIN(22) + l * LRU_W, (bf16_t*)(ws + WS_XC)); }
PHASE_FN ph_s5_state() { const Frame F = make_frame(); unsigned char* const ws = KWS();
    pg8::GeoStd g{(const char*)(ws + WS_U5), (const char*)(ws + WS_PTAB), 1024, 1024, 1024};
    DiagOrder S{32, F.G, F.bid}; EpiS5S E{(float*)(ws + WS_S5S)};
    pg8::gemm_phase<pg8::GeoStd, EpiS5S, DiagOrder, false>(F.lds, F.wave, g, S, E); }
PHASE_FN ph_s5_intra() { const Frame F = make_frame(); unsigned char* const ws = KWS();
    GeoS5Intra g{(const char*)(ws + WS_U5), (const char*)(ws + WS_KTAB)};
    pg8::GroupOrder S{128, 4, F.G, F.bid - 32}; EpiS5Intra E{(float*)(ws + WS_YIN)};
    pg8::gemm_phase<GeoS5Intra, EpiS5Intra, pg8::GroupOrder, false>(F.lds, F.wave, g, S, E); }
PHASE_FN ph_gdn_scan() { const Frame F = make_frame();
    const int xcd = F.bid & 7, q = F.bid >> 3; gdn_scan_wg(F.lds, F.wave, F.lane, xcd * 2 + (q >> 3), q & 7); }
constexpr int NSCAN = 128, NCHAIN = 256 - NSCAN;
struct OwnUnitOrder { int g, j; __device__ bool next(int i, Unit& u) const { if (i >= 1) return false; u.pm = g; u.pn = j; return true; } };
template <int L> PHASE_FN ph_chain_a(int rep) { const int l = L; UNI(rep); const Frame F = make_frame(); unsigned char* const ws = KWS();
    const int w = F.bid - NSCAN;
    if (w < 128) {
        const int g = w >> 2, j = w & 3;
        bf16_t* hx = (bf16_t*)(ws + WS_HEXT) + (size_t)j * 32 * 256 * 256;
        s5_carry_group(g, F.tid, KIN(7) + l * 2048, KIN(8) + l * 2048, KIN(14) + l * 32, (const float*)(ws + WS_S5S), hx);
        asm volatile("s_waitcnt vmcnt(0)" ::: "memory"); __syncthreads();
        GeoS5Inter gg{(const char*)hx, (const char*)(ws + WS_QTAB)};
        OwnUnitOrder S{g, j}; EpiS5Inter E{(const float*)(ws + WS_YIN), (const bf16_t*)(ws + WS_U5), KIN(13) + l * S5_W, (bf16_t*)(ws + WS_YACT)};
        pg8::gemm_phase<GeoS5Inter, EpiS5Inter, OwnUnitOrder, false>(F.lds, F.wave, gg, S, E);
        STAMP<L>(18, 128);
    }
    {
        pg8::GeoStd g{(const char*)(ws + WS_XC), (const char*)(ws + WS_WLRU), LRU_W, LRU_W, LRU_W};
        pg8::StaticOrder S; S.init(M_TOK, 1024, NCHAIN, w);
        EpiLRU E{(const bf16_t*)(ws + WS_XC), KIN(24) + l * LRU_W, KIN(26) + l * LRU_W, KIN(27) + l * LRU_W, (float*)(ws + WS_LA), (float*)(ws + WS_LB)};
        pg8::gemm_phase<pg8::GeoStd, EpiLRU, pg8::StaticOrder, false>(F.lds, F.wave, g, S, E);
        asm volatile("s_waitcnt vmcnt(0)" ::: "memory"); __syncthreads();
        STAMP<L>(22, 128);
        Unit u; for (int i = 0; S.next(i, u); ++i) lru_p1_tile(F.tid, u.pm, u.pn, (const float*)(ws + WS_LA), (const float*)(ws + WS_LB), (float*)(ws + WS_CA), (float*)(ws + WS_CB));
        STAMP<L>(23, 128);
    }
    sub_barrier((unsigned*)(ws + WS_CTL) + CW_SUB + 64 * (2 * l + rep), (unsigned)NCHAIN);
}
template <int L> PHASE_FN ph_chain_b() { const int l = L; const Frame F = make_frame(); unsigned char* const ws = KWS();
    const int w = F.bid - NSCAN;
    {   pg8::GeoStd g{(const char*)(ws + WS_YACT), (const char*)(ws + WS_WGLU), S5_W, S5_W, S5_W};
        pg8::StaticOrder S; S.init(M_TOK, S5_W, NCHAIN, w); EpiGLU E{(const bf16_t*)(ws + WS_YACT), KIN(16) + l * S5_W, (bf16_t*)(ws + WS_CAT)};
        pg8::gemm_phase<pg8::GeoStd, EpiGLU, pg8::StaticOrder, false>(F.lds, F.wave, g, S, E); }
    STAMP<L>(20, 128);
    phase_lru_p3(w * (NWAVES * 64) + F.tid, NCHAIN * NWAVES * 64, (const float*)(ws + WS_LA), (const float*)(ws + WS_LB), (const float*)(ws + WS_CA), (const float*)(ws + WS_CB), (const bf16_t*)(ws + WS_LG), (bf16_t*)(ws + WS_CAT));
}
PHASE_FN ph_gdn_post(int l) { UNI(l); const Frame F = make_frame(); unsigned char* const ws = KWS();
    phase_gdn_post(F, (const bf16_t*)(ws + WS_GO), (const bf16_t*)(ws + WS_Z), KIN(20) + l * GDN_D, (bf16_t*)(ws + WS_CAT)); }
PHASE_FN ph_outproj() { const Frame F = make_frame(); unsigned char* const ws = KWS();
    pg8::GeoStd g{(const char*)(ws + WS_CAT), (const char*)(ws + WS_WOUT), D_MODEL, D_MODEL, D_MODEL};
    float* out = KOUT();
    pg8::StaticOrder S; S.init(M_TOK, D_MODEL, F.G, F.bid); EpiResid E{out, out, 1.0f};
    pg8::gemm_phase<pg8::GeoStd, EpiResid, pg8::StaticOrder, true>(F.lds, F.wave, g, S, E); }
PHASE_FN ph_grid_bar() { XcdBarrier b; b.bar = (unsigned*)(KWS() + WS_CTL) + CW_BAR; b.x = xb_xcc_id(); b.st = (volatile LAS unsigned*)((LAS unsigned char*)lds_raw + MISC_OFF) + 8; xcd_barrier(b); }

#ifndef PROBE_CONVERT
#define PROBE_CONVERT 1
#endif
#ifndef PROBE_FFNUP
#define PROBE_FFNUP 1
#endif
#ifndef PROBE_PREP
#define PROBE_PREP 1
#endif
#ifndef PROBE_SCAN
#define PROBE_SCAN 1
#endif
#ifndef PROBE_MIXER
#define PROBE_MIXER 1
#endif
#define GRID_BAR() ph_grid_bar()
#define REPEAT(N, stmt) do { { constexpr int mixrep_ = 0; (void)mixrep_; stmt; } if constexpr ((N) > 1) { GRID_BAR(); constexpr int mixrep_ = 1; (void)mixrep_; stmt; } } while (0)
template <int L, int SB> __device__ __forceinline__ void half_layer(int bid) {
    REPEAT(PROBE_FFNUP, ph_ffn_up(SB));
    GRID_BAR(); STAMP<L>(SB ? 11 : 2, 0);
    ph_ffn_down(SB, (L == 0 && SB == 0) ? 1 : 0);
    GRID_BAR(); STAMP<L>(SB ? 12 : 3, 0);
    ph_ln(L, SB ? 2 : 0);
    GRID_BAR(); STAMP<L>(SB ? 13 : 4, 0);
    if constexpr (SB == 0) {
        ph_inproj();
        GRID_BAR(); STAMP<L>(5, 0);
#define MIXER_BODY do { \
          \
        ph_gdn_prep(L); if constexpr (PROBE_PREP > 1) ph_gdn_prep(L); STAMP<L>(14, 40); ph_lru_conv(L); STAMP<L>(15, 40); ph_s5_state(); ph_s5_intra(); STAMP<L>(16, 40); \
        GRID_BAR(); STAMP<L>(6, 0); \
          \
        if (bid < NSCAN) { ph_gdn_scan(); if constexpr (PROBE_SCAN > 1) ph_gdn_scan(); STAMP<L>(17, 0); } else { ph_chain_a<L>(mixrep_); STAMP<L>(19, 128); ph_chain_b<L>(); STAMP<L>(21, 128); } \
        GRID_BAR(); STAMP<L>(7, 0); \
          \
        ph_gdn_post(L); } while (0)
        REPEAT(PROBE_MIXER, MIXER_BODY);
#undef MIXER_BODY
        GRID_BAR(); STAMP<L>(8, 0);
        ph_outproj();
        GRID_BAR(); STAMP<L>(9, 0);
        ph_ln(L, 1);
        GRID_BAR(); STAMP<L>(10, 0);
    }
}
template <int L> __device__ __forceinline__ void layer(int bid) {
    STAMP<L>(0, 0);
    REPEAT(PROBE_CONVERT, ph_convert(L));
    GRID_BAR(); STAMP<L>(1, 0);
    half_layer<L, 0>(bid);
    half_layer<L, 1>(bid);
}
__global__ void __launch_bounds__(NWAVES * 64, 2) fwd_kernel(Params Pdummy) {
    LAS unsigned char* lds = (LAS unsigned char*)lds_raw;
    for (int u = threadIdx.x; u < (LDS_BYTES - LDSCTL_OFF) / 4; u += NWAVES * 64) ((LAS unsigned*)(lds + LDSCTL_OFF))[u] = 0u;
    __syncthreads();
    LAS unsigned* st = (LAS unsigned*)(lds + MISC_OFF) + 8;
    unsigned* barw = (unsigned*)(KWS() + WS_CTL) + CW_BAR;
    (void)xcd_barrier_post(barw, (volatile LAS unsigned*)st);
    int bid = blockIdx.x; asm volatile("" : "+s"(bid));
    layer<0>(bid); layer<1>(bid); layer<2>(bid); layer<3>(bid);
    probe_tail();
}
#undef GRID_BAR

extern "C" void kernel_launch(void* const* d_in, const int* in_sizes, int n_in, void* d_out, int out_size, void* d_ws, size_t ws_size, hipStream_t stream) {
    static int grid = 0;
    if (grid == 0) {
        if (n_in != 36 || in_sizes[0] != M_TOK * D_MODEL || out_size != M_TOK * D_MODEL || ws_size < WS_END) { fprintf(stderr, "kernel_launch: unexpected shapes (n_in %d, ws %zu < %zu?)\n", n_in, ws_size, (size_t)WS_END); grid = -1; return; }
        int dev = 0, cus = 0, per_cu = 0;
        if (hipGetDevice(&dev) != hipSuccess || hipDeviceGetAttribute(&cus, hipDeviceAttributeMultiprocessorCount, dev) != hipSuccess) { grid = -1; return; }
        if (hipFuncSetAttribute((const void*)fwd_kernel, hipFuncAttributeMaxDynamicSharedMemorySize, LDS_BYTES) != hipSuccess) { fprintf(stderr, "kernel_launch: hipFuncSetAttribute failed\n"); grid = -1; return; }
        if (hipOccupancyMaxActiveBlocksPerMultiprocessor(&per_cu, (const void*)fwd_kernel, NWAVES * 64, LDS_BYTES) != hipSuccess || per_cu < 1) { fprintf(stderr, "kernel_launch: occupancy query reports %d\n", per_cu); }
        (void)hipGetLastError();
        if (cus < 256) { fprintf(stderr, "kernel_launch: needs 256 CUs, device has %d\n", cus); grid = -1; return; }
        grid = 256;
    }
    if (grid < 0) return;
    (void)hipMemsetAsync((char*)d_ws + WS_CTL, 0, CTL_BYTES, stream);
    Params p{};
    for (int i = 0; i < 36; ++i) p.in[i] = (const float*)d_in[i];
    p.out = (float*)d_out; p.ws = (unsigned char*)d_ws;
    hipLaunchKernelGGL(fwd_kernel, dim3(grid), dim3(NWAVES * 64), LDS_BYTES, stream, p);
}
```

```cpp
#include <hip/hip_runtime.h>
#include <cstdio>
#include <cstdint>

#define LAS __attribute__((address_space(3)))
#define GAS __attribute__((address_space(1)))
typedef unsigned short bf16_t;
typedef short bf16x8 __attribute__((ext_vector_type(8)));
typedef float f32x4 __attribute__((ext_vector_type(4)));
typedef float f32x2 __attribute__((ext_vector_type(2)));
typedef unsigned u32x4 __attribute__((ext_vector_type(4)));
typedef unsigned u32x2 __attribute__((ext_vector_type(2)));

constexpr int D_MODEL = 2048, BATCH = 2, SEQ = 8192, DEPTH = 4, M_TOK = BATCH * SEQ;
constexpr int D_FF = 5632, S5_W = 512, S5_G = 32, S5_P = 16, S5_N = 64;
constexpr int GDN_W = 1024, GDN_H = 8, GDN_D = 128, CH = 64, NCH = SEQ / CH  , NCHT = BATCH * NCH  ;
constexpr int LRU_W = 512;
constexpr int D_IN = 5648;
constexpr int N_IN_PAD = 5888;
constexpr float LN_EPS = 1e-5f, RMS_EPS = 1e-6f;
constexpr float DN_ALPHA = 1.6817928305074290f;

typedef __bf16 bf16x2_t __attribute__((ext_vector_type(2)));
__device__ __forceinline__ unsigned cvt_pk_bf16(float lo, float hi) { f32x2 v = {lo, hi}; bf16x2_t b = __builtin_convertvector(v, bf16x2_t); return __builtin_bit_cast(unsigned, b); }
__device__ __forceinline__ unsigned f2bf(float f) { unsigned u = __builtin_bit_cast(unsigned, f); return (u + 0x7fffu + ((u >> 16) & 1u)) >> 16; }
__device__ __forceinline__ float bf2f(unsigned h) { return __builtin_bit_cast(float, h << 16); }
__device__ __forceinline__ float bflo(unsigned w) { return __builtin_bit_cast(float, w << 16); }
__device__ __forceinline__ float bfhi(unsigned w) { return __builtin_bit_cast(float, w & 0xffff0000u); }
__device__ __forceinline__ float rcpf_(float x) { return __builtin_amdgcn_rcpf(x); }
__device__ __forceinline__ float rsqf_(float x) { return __builtin_amdgcn_rsqf(x); }
__device__ __forceinline__ float sqrtf_(float x) { return __builtin_amdgcn_sqrtf(x); }
__device__ __forceinline__ float sigmoidf_(float x) { return rcpf_(1.0f + __expf(-x)); }
__device__ __forceinline__ float siluf_(float x) { return x * rcpf_(1.0f + __expf(-x)); }
__device__ __forceinline__ float gelu_tanh(float x) { const float u = 0.7978845608028654f * (x + 0.044715f * x * x * x); return x * rcpf_(1.0f + __expf(-2.0f * u)); }
__device__ __forceinline__ float log1p_small(float e) { return e < 0.01f ? e * (1.0f - e * (0.5f - e * (1.0f / 3.0f))) : __logf(1.0f + e); }
__device__ __forceinline__ float softplusf_(float x) { return fmaxf(x, 0.f) + log1p_small(__expf(-fabsf(x))); }
__device__ __forceinline__ float expm1_neg(float z) {
    return fabsf(z) < 0.1f ? z * (1.0f + z * (0.5f + z * ((1.0f / 6.0f) + z * ((1.0f / 24.0f) + z * (1.0f / 120.0f))))) : __expf(z) - 1.0f; }
__device__ __forceinline__ float wave_sum(float v) {
#pragma unroll
    for (int o = 1; o < 64; o <<= 1) v += __shfl_xor(v, o);
    return v;
}

namespace pg8 {
constexpr int BM = 256, BK = 64, HALF = 128, HTB = HALF * BK * 2, STAGE_BYTES = 8 * HTB, NXCD = 8, WGM = 8;
__host__ __device__ __forceinline__ int lds_byte(int r, int c) { const int st = (r >> 4) * 2 + (c >> 5), rr = r & 15, cc = c & 31, ob = rr * 64 + cc * 2; return st * 1024 + (ob ^ (((ob >> 9) & 1) << 5)); }
__host__ __device__ __forceinline__ void stage_rc(int b, int& R, int& C) { const int st = b / 1024, sb = b % 1024, swz = sb ^ (((sb >> 9) & 1) << 5); R = (st >> 1) * 16 + swz / 64; C = (st & 1) * 32 + (swz % 64) / 2; }
__host__ __device__ __forceinline__ int perm32(int rho) { const int n = rho >> 4, i = rho & 15; return 8 * (i >> 2) + 4 * n + (i & 3); }

struct Unit { int pm, pn; };

struct GeoStd {
    const char* A; const char* B; int lda, ldb, K;
    __device__ __forceinline__ int nt() const { return K / BK; }
    __device__ __forceinline__ int a_voff(int R, int C) const { return (R * lda + C) * 2; }
    __device__ __forceinline__ int b_voff(int R, int C) const { return (R * ldb + C) * 2; }
    __device__ __forceinline__ long a_hstep() const { return (long)HALF * lda * 2; }
    __device__ __forceinline__ long b_hstep() const { return (long)HALF * ldb * 2; }
    __device__ __forceinline__ const char* a_base(const Unit& u) const { return A + (size_t)u.pm * BM * lda * 2; }
    __device__ __forceinline__ const char* b_base(const Unit& u) const { return B + (size_t)u.pn * BM * ldb * 2; }
};

struct StaticOrder {
    int nM, nN, nwg, G, c;
    __device__ void init(int M, int N, int G_, int c_) { nM = M / BM; nN = N / BM; nwg = nM * nN; G = G_; c = c_; }
    __device__ bool next(int i, Unit& u) const {
        if (c < 0) return false;
        const long L = (long)i * G + c; if (L >= nwg) return false;
        int wgid = (int)L; { const int q = nwg / NXCD, r = nwg % NXCD, xcd = wgid % NXCD, off = wgid / NXCD; wgid = (xcd < r ? xcd * (q + 1) : r * (q + 1) + (xcd - r) * q) + off; }
        const int nig = WGM * nN, gid = wgid / nig, fm = gid * WGM, gsz = (nM - fm) < WGM ? (nM - fm) : WGM;
        u.pm = fm + ((wgid % nig) % gsz); u.pn = (wgid % nig) / gsz; return true;
    }
};
struct GroupOrder {
    int nunits, per, G, c;
    __device__ bool next(int i, Unit& u) const { if (c < 0) return false; const long L = (long)i * G + c; if (L >= nunits) return false; u.pm = (int)L / per; u.pn = (int)L % per; return true; }
};

template <class Geo, class Epi, class Sched, bool ALIGN_EPI>
__device__ __forceinline__ void gemm_phase(LAS unsigned char* lds, int wave_id, const Geo& g, const Sched& S, const Epi& E) {
    int tid = threadIdx.x; asm volatile("" : "+v"(tid));
    const int wid = __builtin_amdgcn_readfirstlane(tid >> 6), lane = tid & 63, wr = wid >> 2, wc = wid & 3, fr = lane & 15, fq = lane >> 4;
    const int nt = g.nt();
    int voffA[2], voffB[2];
#pragma unroll
    for (int i = 0; i < 2; ++i) { int R, C; stage_rc(tid * 16 + i * 8192, R, C); const int Rb = Epi::PERM ? ((R & ~31) + perm32(R & 31)) : R;
        voffA[i] = g.a_voff(R, C); voffB[i] = g.b_voff(Rb, C); }
    const long kstep = (long)(BK * 2);
    const long hstepA = g.a_hstep(), hstepB = g.b_hstep();
    const unsigned ldsw = (unsigned)wid * 1024u;
    const int aoff = lds_byte(wr * 64 + fr, fq * 8), boff = lds_byte(wc * 32 + fr, fq * 8);
#define PG8_SA(b, h) (((b) * 2 + (h)) * HTB)
#define PG8_SB(b, h) ((4 + (b) * 2 + (h)) * HTB)
#define PG8_STAGE(bufoff, gbase, voff) do { _Pragma("unroll") for (int _i = 0; _i < 2; ++_i) \
        __builtin_amdgcn_global_load_lds((const unsigned*)((const char*)(gbase) + (voff)[_i]), (LAS unsigned*)(lds + (bufoff) + ldsw + _i * 8192), 16, 0, 0); } while (0)
#define PG8_LDA(dst, b, h) do { _Pragma("unroll") for (int m = 0; m < 4; ++m) _Pragma("unroll") for (int k = 0; k < 2; ++k) dst[m][k] = *(const LAS bf16x8*)(lds + PG8_SA(b, h) + aoff + m * 2048 + k * 1024); } while (0)
#define PG8_LDB(dst, b, h) do { _Pragma("unroll") for (int n = 0; n < 2; ++n) _Pragma("unroll") for (int k = 0; k < 2; ++k) dst[n][k] = *(const LAS bf16x8*)(lds + PG8_SB(b, h) + boff + n * 2048 + k * 1024); } while (0)
#define PG8_MMA(ai, bj, At, Bt) do { __builtin_amdgcn_s_setprio(1); _Pragma("unroll") for (int m = 0; m < 4; ++m) _Pragma("unroll") for (int n = 0; n < 2; ++n) _Pragma("unroll") for (int k = 0; k < 2; ++k) \
        acc[ai][bj][m][n] = __builtin_amdgcn_mfma_f32_16x16x32_bf16(Bt[n][k], At[m][k], acc[ai][bj][m][n], 0, 0, 0); __builtin_amdgcn_s_setprio(0); } while (0)
#define PG8_WAIT_V(n) asm volatile("s_waitcnt vmcnt(" #n ")" ::: "memory")
#define PG8_WAIT_L(n) asm volatile("s_waitcnt lgkmcnt(" #n ")" ::: "memory")
#define PG8_BAR __builtin_amdgcn_s_barrier()
#define PG8_SCHED __builtin_amdgcn_sched_barrier(0)
    Unit cur, nxt; int ui = 0;
    if (!S.next(0, cur)) return;
    f32x4 acc[2][2][4][2];
#pragma unroll
    for (int a = 0; a < 2; ++a)
#pragma unroll
        for (int b = 0; b < 2; ++b)
#pragma unroll
            for (int m = 0; m < 4; ++m)
#pragma unroll
                for (int n = 0; n < 2; ++n) acc[a][b][m][n] = (f32x4){0.f, 0.f, 0.f, 0.f};
    bf16x8 At[4][2], B0[2][2], B1[2][2];
    const char* cA = g.a_base(cur); const char* cB = g.b_base(cur);
    PG8_STAGE(PG8_SB(0, 0), cB, voffB); PG8_STAGE(PG8_SB(0, 1), cB + hstepB, voffB); PG8_STAGE(PG8_SA(0, 0), cA, voffA); PG8_STAGE(PG8_SA(0, 1), cA + hstepA, voffA);
    if (wr == 1) PG8_BAR;
    PG8_WAIT_V(2); PG8_BAR;
    PG8_STAGE(PG8_SB(1, 0), cB + kstep, voffB); PG8_STAGE(PG8_SA(1, 0), cA + kstep, voffA); PG8_STAGE(PG8_SB(1, 1), cB + hstepB + kstep, voffB);
    PG8_WAIT_V(6); PG8_BAR;
    for (;;) {
        const bool has_next = S.next(ui + 1, nxt);
        const char* nA = has_next ? g.a_base(nxt) : cA; const char* nB = has_next ? g.b_base(nxt) : cB;
        for (int t = 0; t < nt; t += 2) {
            const bool last = (t == nt - 2);
            const char* a1 = cA + (long)(t + 1) * kstep;
            const char* a2 = last ? nA : cA + (long)(t + 2) * kstep; const char* b2 = last ? nB : cB + (long)(t + 2) * kstep;
            const char* a3 = a2 + kstep; const char* b3 = b2 + kstep;
            PG8_LDB(B0, 0, 0); PG8_LDB(B1, 0, 1); PG8_SCHED; PG8_LDA(At, 0, 0); PG8_STAGE(PG8_SA(1, 1), a1 + hstepA, voffA);
            PG8_WAIT_V(8); PG8_WAIT_L(0); PG8_BAR; PG8_MMA(0, 0, At, B0); PG8_MMA(0, 1, At, B1); PG8_BAR; PG8_SCHED;
            PG8_LDA(At, 0, 1); PG8_STAGE(PG8_SB(0, 0), b2, voffB); PG8_STAGE(PG8_SB(0, 1), b2 + hstepB, voffB); PG8_STAGE(PG8_SA(0, 0), a2, voffA);
            PG8_WAIT_V(8); PG8_WAIT_L(0); PG8_BAR; PG8_MMA(1, 0, At, B0); PG8_MMA(1, 1, At, B1); PG8_BAR; PG8_SCHED;
            PG8_LDB(B0, 1, 0); PG8_LDB(B1, 1, 1); PG8_SCHED; PG8_LDA(At, 1, 0); PG8_STAGE(PG8_SA(0, 1), a2 + hstepA, voffA);
            PG8_WAIT_V(8); PG8_WAIT_L(0); PG8_BAR; PG8_MMA(0, 0, At, B0); PG8_MMA(0, 1, At, B1); PG8_BAR; PG8_SCHED;
            PG8_LDA(At, 1, 1); PG8_STAGE(PG8_SB(1, 0), b3, voffB); PG8_STAGE(PG8_SB(1, 1), b3 + hstepB, voffB); PG8_STAGE(PG8_SA(1, 0), a3, voffA);
            PG8_WAIT_V(8); PG8_WAIT_L(0); PG8_BAR; PG8_MMA(1, 0, At, B0); PG8_MMA(1, 1, At, B1); PG8_BAR; PG8_SCHED;
        }
        if constexpr (ALIGN_EPI) { if (wr == 0) PG8_BAR; }
        {
            Unit ue = cur; int fr_e = fr, fq_e = fq; asm volatile("" : "+s"(ue.pm), "+s"(ue.pn), "+v"(fr_e), "+v"(fq_e));
            E(acc, ue, wr, wc, fr_e, fq_e); }
        if (!has_next) break;
#pragma unroll
        for (int a = 0; a < 2; ++a)
#pragma unroll
            for (int b = 0; b < 2; ++b)
#pragma unroll
                for (int m = 0; m < 4; ++m)
#pragma unroll
                    for (int n = 0; n < 2; ++n) acc[a][b][m][n] = (f32x4){0.f, 0.f, 0.f, 0.f};
        cur = nxt; cA = nA; cB = nB; ++ui;
        if constexpr (ALIGN_EPI) { if (wr == 1) PG8_BAR; }
    }
    PG8_WAIT_V(0);
    if constexpr (!ALIGN_EPI) { if (wr == 0) PG8_BAR; }
    PG8_BAR;
#undef PG8_SA
#undef PG8_SB
#undef PG8_STAGE
#undef PG8_LDA
#undef PG8_LDB
#undef PG8_MMA
#undef PG8_WAIT_V
#undef PG8_WAIT_L
#undef PG8_BAR
#undef PG8_SCHED
}
}

using pg8::Unit;
struct EpiSwiGLU {
    static constexpr bool PERM = true;
    bf16_t* H;
    __device__ __forceinline__ void operator()(const f32x4 (&acc)[2][2][4][2], const Unit& u, int wr, int wc, int fr, int fq) const {
        const int row0 = u.pm * 256 + wr * 64 + fr, col0 = u.pn * 128 + wc * 32 + 8 * fq;
#pragma unroll
        for (int ai = 0; ai < 2; ++ai)
#pragma unroll
            for (int m = 0; m < 4; ++m) {
                bf16_t* rowp = H + (size_t)(row0 + ai * 128 + m * 16) * D_FF + col0;
                const f32x4 g0 = acc[ai][0][m][0], g1 = acc[ai][0][m][1], u0 = acc[ai][1][m][0], u1 = acc[ai][1][m][1];
                u32x4 w;
                w.x = cvt_pk_bf16(siluf_(g0[0]) * u0[0], siluf_(g0[1]) * u0[1]); w.y = cvt_pk_bf16(siluf_(g0[2]) * u0[2], siluf_(g0[3]) * u0[3]);
                w.z = cvt_pk_bf16(siluf_(g1[0]) * u1[0], siluf_(g1[1]) * u1[1]); w.w = cvt_pk_bf16(siluf_(g1[2]) * u1[2], siluf_(g1[3]) * u1[3]);
                *(u32x4*)rowp = w;
            }
    }
};
struct EpiResid {
    static constexpr bool PERM = false;
    const float* res; float* out; float scale;
    __device__ __forceinline__ void operator()(const f32x4 (&acc)[2][2][4][2], const Unit& u, int wr, int wc, int fr, int fq) const {
        const int row0 = u.pm * 256 + wr * 64 + fr, col0 = u.pn * 256 + wc * 32 + 4 * fq;
#pragma unroll
        for (int ai = 0; ai < 2; ++ai)
#pragma unroll
            for (int m = 0; m < 4; ++m) {
                const size_t off = (size_t)(row0 + ai * 128 + m * 16) * D_MODEL + col0;
#pragma unroll
                for (int bj = 0; bj < 2; ++bj)
#pragma unroll
                    for (int n = 0; n < 2; ++n) { const f32x4 r = *(const f32x4*)(res + off + bj * 128 + n * 16); *(f32x4*)(out + off + bj * 128 + n * 16) = r * DN_ALPHA + acc[ai][bj][m][n] * scale; }
            }
    }
};
struct EpiInproj {
    static constexpr bool PERM = true;
    bf16_t *U5, *QKV, *Z, *LX, *LG; float* AB;
    __device__ __forceinline__ void operator()(const f32x4 (&acc)[2][2][4][2], const Unit& u, int wr, int wc, int fr, int fq) const {
        const int row0 = u.pm * 256 + wr * 64 + fr;
        const int pn = u.pn;
#pragma unroll
        for (int ai = 0; ai < 2; ++ai)
#pragma unroll
            for (int m = 0; m < 4; ++m) {
                const int row = row0 + ai * 128 + m * 16;
#pragma unroll
                for (int bj = 0; bj < 2; ++bj) {
                    const int c = pn * 256 + bj * 128 + wc * 32 + 8 * fq;
                    const f32x4 v0 = acc[ai][bj][m][0], v1 = acc[ai][bj][m][1];
                    if (pn == 22) {
                        if (bj == 0 && wc == 0 && fq < 2) { float* p = AB + (size_t)row * 16 + 8 * fq; *(f32x4*)p = v0; *(f32x4*)(p + 4) = v1; }
                    } else {
                        u32x4 w; w.x = cvt_pk_bf16(v0[0], v0[1]); w.y = cvt_pk_bf16(v0[2], v0[3]); w.z = cvt_pk_bf16(v1[0], v1[1]); w.w = cvt_pk_bf16(v1[2], v1[3]);
                        bf16_t* p;
                        if (pn < 2) { const int g = c >> 4, hf = c & 8; p = U5 + ((size_t)g * M_TOK + row) * 16 + hf; }
                        else if (pn < 14) p = QKV + (size_t)row * 3072 + (c - 512);
                        else if (pn < 18) p = Z + (size_t)row * 1024 + (c - 3584);
                        else if (pn < 20) p = LX + (size_t)row * 512 + (c - 4608);
                        else p = LG + (size_t)row * 512 + (c - 5120);
                        *(u32x4*)p = w;
                    }
                }
            }
    }
};
struct EpiS5S {
    static constexpr bool PERM = false;
    float* S;
    __device__ __forceinline__ void operator()(const f32x4 (&acc)[2][2][4][2], const Unit& u, int wr, int wc, int fr, int fq) const {
        const int g = u.pm, row0 = wr * 64 + fr, col0 = wc * 32 + 4 * fq;
#pragma unroll
        for (int ai = 0; ai < 2; ++ai)
#pragma unroll
            for (int m = 0; m < 4; ++m) { float* p = S + ((size_t)g * NCHT + row0 + ai * 128 + m * 16) * 128 + col0;
#pragma unroll
                for (int n = 0; n < 2; ++n) *(f32x4*)(p + n * 16) = acc[ai][0][m][n]; }
    }
};
struct EpiS5Intra {
    static constexpr bool PERM = false;
    float* Y;
    __device__ __forceinline__ void operator()(const f32x4 (&acc)[2][2][4][2], const Unit& u, int wr, int wc, int fr, int fq) const {
        const int g = u.pm, j = u.pn, row0 = wr * 64 + fr;
#pragma unroll
        for (int ai = 0; ai < 2; ++ai)
#pragma unroll
            for (int m = 0; m < 4; ++m) { const int bc = row0 + ai * 128 + m * 16;
#pragma unroll
                for (int bj = 0; bj < 2; ++bj)
#pragma unroll
                    for (int n = 0; n < 2; ++n) { const int col = j * 256 + bj * 128 + wc * 32 + 16 * n + 4 * fq, t = col >> 4, p = col & 15;
                        *(f32x4*)(Y + ((size_t)bc * CH + t) * S5_W + g * 16 + p) = acc[ai][bj][m][n]; }
            }
    }
};
struct EpiS5Inter {
    static constexpr bool PERM = false;
    const float* Y; const bf16_t* U5; const float* dvec; bf16_t* YACT;
    __device__ __forceinline__ void operator()(const f32x4 (&acc)[2][2][4][2], const Unit& u, int wr, int wc, int fr, int fq) const {
        const int g = u.pm, j = u.pn, row0 = wr * 64 + fr;
#pragma unroll
        for (int ai = 0; ai < 2; ++ai)
#pragma unroll
            for (int m = 0; m < 4; ++m) { const int bc = row0 + ai * 128 + m * 16;
#pragma unroll
                for (int bj = 0; bj < 2; ++bj)
#pragma unroll
                    for (int n = 0; n < 2; ++n) { const int col = j * 256 + bj * 128 + wc * 32 + 16 * n + 4 * fq, t = col >> 4, p = col & 15;
                        const size_t tok = (size_t)bc * CH + t; const int ch = g * 16 + p;
                        const f32x4 y0 = *(const f32x4*)(Y + tok * S5_W + ch);
                        const u32x2 uu = *(const u32x2*)(U5 + ((size_t)g * M_TOK + tok) * 16 + p);
                        const f32x4 d0 = *(const f32x4*)(dvec + ch);
                        const f32x4 a0 = acc[ai][bj][m][n];
                        const float o0 = gelu_tanh(a0[0] + y0[0] + d0[0] * bflo(uu.x)), o1 = gelu_tanh(a0[1] + y0[1] + d0[1] * bfhi(uu.x));
                        const float o2 = gelu_tanh(a0[2] + y0[2] + d0[2] * bflo(uu.y)), o3 = gelu_tanh(a0[3] + y0[3] + d0[3] * bfhi(uu.y));
                        u32x2 w; w.x = cvt_pk_bf16(o0, o1); w.y = cvt_pk_bf16(o2, o3);
                        *(u32x2*)(YACT + tok * S5_W + ch) = w; }
                asm volatile("" ::: "memory");
            }
    }
};
struct EpiGLU {
    static constexpr bool PERM = true;
    const bf16_t* YACT; const float* bglu; bf16_t* CAT;
    __device__ __forceinline__ void operator()(const f32x4 (&acc)[2][2][4][2], const Unit& u, int wr, int wc, int fr, int fq) const {
        const int row0 = u.pm * 256 + wr * 64 + fr;
#pragma unroll
        for (int ai = 0; ai < 2; ++ai)
#pragma unroll
            for (int m = 0; m < 4; ++m) { const size_t row = (size_t)(row0 + ai * 128 + m * 16);
#pragma unroll
                for (int bj = 0; bj < 2; ++bj) { const int col = u.pn * 256 + bj * 128 + wc * 32 + 8 * fq;
                    const u32x4 yy = *(const u32x4*)(YACT + row * S5_W + col);
                    const f32x4 b0 = *(const f32x4*)(bglu + col), b1 = *(const f32x4*)(bglu + col + 4);
                    const f32x4 a0 = acc[ai][bj][m][0] + b0, a1 = acc[ai][bj][m][1] + b1;
                    u32x4 w;
                    w.x = cvt_pk_bf16(bflo(yy.x) * sigmoidf_(a0[0]), bfhi(yy.x) * sigmoidf_(a0[1])); w.y = cvt_pk_bf16(bflo(yy.y) * sigmoidf_(a0[2]), bfhi(yy.y) * sigmoidf_(a0[3]));
                    w.z = cvt_pk_bf16(bflo(yy.z) * sigmoidf_(a1[0]), bfhi(yy.z) * sigmoidf_(a1[1])); w.w = cvt_pk_bf16(bflo(yy.w) * sigmoidf_(a1[2]), bfhi(yy.w) * sigmoidf_(a1[3]));
                    *(u32x4*)(CAT + row * D_MODEL + col) = w; }
            }
    }
};
struct EpiLRU {
    static constexpr bool PERM = true;
    const bf16_t* XC; const float *ba, *bx, *lam; float *LA, *LB;
    __device__ __forceinline__ void operator()(const f32x4 (&acc)[2][2][4][2], const Unit& u, int wr, int wc, int fr, int fq) const {
        const int row0 = u.pm * 256 + wr * 64 + fr, ch = u.pn * 128 + wc * 32 + 8 * fq;
        float sp[8], bav[8], bxv[8];
#pragma unroll
        for (int e = 0; e < 8; ++e) { sp[e] = -8.0f * softplusf_(-lam[ch + e]); bav[e] = ba[ch + e]; bxv[e] = bx[ch + e]; }
#pragma unroll
        for (int ai = 0; ai < 2; ++ai)
#pragma unroll
            for (int m = 0; m < 4; ++m) { const size_t row = (size_t)(row0 + ai * 128 + m * 16);
                const u32x4 xx = *(const u32x4*)(XC + row * LRU_W + ch);
                float xc[8] = {bflo(xx.x), bfhi(xx.x), bflo(xx.y), bfhi(xx.y), bflo(xx.z), bfhi(xx.z), bflo(xx.w), bfhi(xx.w)};
                float av[8], bv[8];
#pragma unroll
                for (int e = 0; e < 8; ++e) { const float ra = acc[ai][0][m][e >> 2][e & 3] + bav[e], rx = acc[ai][1][m][e >> 2][e & 3] + bxv[e];
                    const float r = sigmoidf_(ra), ig = sigmoidf_(rx), la = sp[e] * r; av[e] = __expf(la); bv[e] = sqrtf_(fmaxf(-expm1_neg(2.0f * la), 0.f)) * (ig * xc[e]); }
                *(f32x4*)(LA + row * LRU_W + ch) = (f32x4){av[0], av[1], av[2], av[3]}; *(f32x4*)(LA + row * LRU_W + ch + 4) = (f32x4){av[4], av[5], av[6], av[7]};
                *(f32x4*)(LB + row * LRU_W + ch) = (f32x4){bv[0], bv[1], bv[2], bv[3]}; *(f32x4*)(LB + row * LRU_W + ch + 4) = (f32x4){bv[4], bv[5], bv[6], bv[7]};
            }
    }
};

#define XB_TMO      128
#define XB_XCNT(j)  (256  + 64 * (j))
#define XB_XSUB(j)  (1280 + 64 * (j))
#define XB_XGEN(j)  (2304 + 64 * (j))
#define XB_TOP      3328
#define XB_TOPGEN   3392
#define XCD_BAR_WORDS 3456
#define XB_SPIN_CAP (1u << 22)
__device__ __forceinline__ unsigned xb_ld(unsigned* p)              { return __hip_atomic_load(p, __ATOMIC_RELAXED, __HIP_MEMORY_SCOPE_AGENT); }
__device__ __forceinline__ unsigned xb_add(unsigned* p, unsigned v) { return __hip_atomic_fetch_add(p, v, __ATOMIC_RELAXED, __HIP_MEMORY_SCOPE_AGENT); }
__device__ __forceinline__ unsigned xb_xcc_id() { return (unsigned)__builtin_amdgcn_s_getreg((3 << 11) | 20) & 0xFu; }
#define XB_SPIN(cond, bar) do { unsigned _sp = 0; while (cond) { __builtin_amdgcn_s_sleep(1); \
    if ((++_sp & 255u) == 0u) { if (xb_ld(&(bar)[XB_TMO])) break; if (_sp > XB_SPIN_CAP) { atomicAdd(&(bar)[XB_TMO], 1u); break; } } } } while (0)
struct XcdBarrier { unsigned* bar; unsigned x; volatile LAS unsigned* st; };
__device__ __forceinline__ XcdBarrier xcd_barrier_post(unsigned* bar, volatile LAS unsigned* st) {
    XcdBarrier b; b.bar = bar; b.x = xb_xcc_id(); b.st = st;
    if (threadIdx.x == 0) (void)xb_add(&bar[XB_XCNT(b.x)], 1u);
    return b;
}
__device__ __forceinline__ void xcd_barrier_complete(unsigned* bar, unsigned x, unsigned& nloc, unsigned& nx) {
    const unsigned G = gridDim.x * gridDim.y * gridDim.z;
    unsigned sum, cnt, mine, sp = 0u;
    for (;;) {
        sum = 0u; cnt = 0u; mine = 0u;
#pragma unroll
        for (unsigned j = 0; j < 16; ++j) { const unsigned c = xb_ld(&bar[XB_XCNT(j)]); sum += c; cnt += (c > 0u) ? 1u : 0u; mine = (j == x) ? c : mine; }
        if (sum == G) break;
        __builtin_amdgcn_s_sleep(1);
        if ((++sp & 255u) == 0u) { if (xb_ld(&bar[XB_TMO])) break; if (sp > XB_SPIN_CAP) { atomicAdd(&bar[XB_TMO], 1u); break; } }
    }
    nloc = mine > 0u ? mine : 1u; nx = cnt > 0u ? cnt : 1u;
}
__device__ __forceinline__ void xcd_barrier(const XcdBarrier& b) {
    asm volatile("s_waitcnt vmcnt(0)" ::: "memory");
    __syncthreads();
    if (threadIdx.x == 0) {
        unsigned* bar = b.bar; unsigned bx = b.x;
        __builtin_amdgcn_s_waitcnt(0);
        unsigned nloc = b.st[0], nx = b.st[1];
        if (nloc == 0u) { xcd_barrier_complete(bar, bx, nloc, nx); b.st[0] = nloc; b.st[1] = nx; }
        const unsigned old = xb_add(&bar[XB_XSUB(bx)], 1u);
        const unsigned gen = old / nloc;
        if (old + 1u == (gen + 1u) * nloc) {
            __builtin_amdgcn_fence(__ATOMIC_RELEASE, "agent");
            asm volatile("s_waitcnt vmcnt(0)" ::: "memory");
            const unsigned og = xb_add(&bar[XB_TOP], 1u);
            const unsigned tg = og / nx;
            if (og + 1u == (tg + 1u) * nx) xb_add(&bar[XB_TOPGEN], 1u);
            else XB_SPIN(xb_ld(&bar[XB_TOPGEN]) == tg, bar);
            __builtin_amdgcn_fence(__ATOMIC_ACQUIRE, "agent");
            xb_add(&bar[XB_XGEN(bx)], 1u);
            asm volatile("s_waitcnt vmcnt(0)" ::: "memory");
        } else {
            XB_SPIN(xb_ld(&bar[XB_XGEN(bx)]) == gen, bar);
            __builtin_amdgcn_fence(__ATOMIC_ACQUIRE, "agent");
            asm volatile("s_waitcnt vmcnt(0)" ::: "memory");
        }
    }
    __syncthreads();
}

__device__ __forceinline__ void sub_barrier(unsigned* cnt, unsigned target) {
    asm volatile("s_waitcnt vmcnt(0)" ::: "memory");
    __syncthreads();
    if (threadIdx.x == 0) {
        __builtin_amdgcn_fence(__ATOMIC_RELEASE, "agent");
        asm volatile("s_waitcnt vmcnt(0)" ::: "memory");
        (void)xb_add(cnt, 1u);
        unsigned sp = 0u; while (xb_ld(cnt) < target) { __builtin_amdgcn_s_sleep(1); if (++sp > XB_SPIN_CAP) break; }
        __builtin_amdgcn_fence(__ATOMIC_ACQUIRE, "agent");
        asm volatile("s_waitcnt vmcnt(0)" ::: "memory");
    }
    __syncthreads();
}

constexpr size_t al256(size_t x) { return (x + 255) & ~(size_t)255; }
constexpr size_t WS_CTL = 0, CTL_BYTES = 1u << 20;
constexpr size_t SZ_WGU = (size_t)2 * D_FF * D_MODEL * 2, SZ_WD = (size_t)D_MODEL * D_FF * 2, SZ_WIN = (size_t)N_IN_PAD * D_MODEL * 2, SZ_WOUT = (size_t)D_MODEL * D_MODEL * 2;
constexpr size_t WS_WGU1 = WS_CTL + CTL_BYTES, WS_WGU2 = WS_WGU1 + SZ_WGU, WS_WD1 = WS_WGU2 + SZ_WGU, WS_WD2 = WS_WD1 + SZ_WD, WS_WIN = WS_WD2 + SZ_WD, WS_WOUT = WS_WIN + SZ_WIN;
constexpr size_t WS_WGLU = WS_WOUT + SZ_WOUT, WS_WLRU = WS_WGLU + (size_t)512 * 512 * 2;
constexpr size_t WS_KTAB = WS_WLRU + (size_t)1024 * 512 * 2;
constexpr size_t WS_PTAB = WS_KTAB + (size_t)32 * 16 * 128 * 16 * 2;
constexpr size_t WS_QTAB = WS_PTAB + (size_t)32 * 256 * 1024 * 2;
constexpr size_t WS_XN = WS_QTAB + (size_t)32 * 1024 * 256 * 2;
constexpr size_t WS_H = WS_XN + (size_t)M_TOK * D_MODEL * 2;
constexpr size_t WS_U5 = WS_H + (size_t)M_TOK * D_FF * 2;
constexpr size_t WS_QKV = WS_U5 + (size_t)M_TOK * 512 * 2;
constexpr size_t WS_Z = WS_QKV + (size_t)M_TOK * 3072 * 2;
constexpr size_t WS_AB = WS_Z + (size_t)M_TOK * 1024 * 2;
constexpr size_t WS_LX = WS_AB + (size_t)M_TOK * 16 * 4;
constexpr size_t WS_LG = WS_LX + (size_t)M_TOK * 512 * 2;
constexpr size_t WS_XC = WS_LG + (size_t)M_TOK * 512 * 2;
constexpr int NUNIT = BATCH * GDN_H * NCH;
constexpr size_t WS_GU = WS_XC + (size_t)M_TOK * 512 * 2;
constexpr size_t WS_GW = WS_GU + (size_t)NUNIT * 64 * 128 * 4;
constexpr size_t WS_GQD = WS_GW + (size_t)NUNIT * 16384;
constexpr size_t WS_GKD = WS_GQD + (size_t)NUNIT * 16384;
constexpr size_t WS_GQK = WS_GKD + (size_t)NUNIT * 16384;
constexpr size_t WS_GL = WS_GQK + (size_t)NUNIT * 8192;
constexpr size_t WS_GO = WS_GL + al256((size_t)NUNIT * 4);
constexpr size_t WS_S5S = WS_GO + (size_t)M_TOK * 1024 * 4;
constexpr size_t WS_HEXT = WS_S5S + (size_t)32 * 256 * 128 * 4;
constexpr size_t WS_YIN = WS_HEXT + (size_t)4 * 32 * 256 * 256 * 2;
constexpr size_t WS_YACT = WS_YIN + (size_t)M_TOK * 512 * 4;
constexpr size_t WS_LA = WS_YACT + (size_t)M_TOK * 512 * 2;
constexpr size_t WS_LB = WS_LA + (size_t)M_TOK * 512 * 4;
constexpr size_t WS_CA = WS_LB + (size_t)M_TOK * 512 * 4;
constexpr size_t WS_CB = WS_CA + (size_t)NCHT * 512 * 4;
constexpr size_t WS_CIN = WS_CB + (size_t)NCHT * 512 * 4;
constexpr size_t WS_CAT = WS_CIN + (size_t)NCHT * 512 * 4;
constexpr size_t WS_END = WS_CAT + (size_t)M_TOK * D_MODEL * 2;
constexpr int CW_BAR = 4096, CW_SUB = 8192;

constexpr int RING_BYTES = 131072, LDSCTL_OFF = 155648, MISC_OFF = LDSCTL_OFF + 320, LDS_BYTES = 157696;
constexpr int NWAVES = 8;

struct Params { const float* in[36]; float* out; unsigned char* ws; };
typedef const __attribute__((address_space(4))) unsigned char* kptr_t;
__device__ __forceinline__ kptr_t karg_base() { kptr_t k = (kptr_t)__builtin_amdgcn_kernarg_segment_ptr(); asm volatile("" : "+s"(k)); return k; }
__device__ __forceinline__ const float* KIN(int i) { return *(const float* const __attribute__((address_space(4)))*)(karg_base() + 8 * i); }
__device__ __forceinline__ float* KOUT() { return *(float* const __attribute__((address_space(4)))*)(karg_base() + 8 * 36); }
__device__ __forceinline__ unsigned char* KWS() { return *(unsigned char* const __attribute__((address_space(4)))*)(karg_base() + 8 * 37); }
struct Frame {
    LAS unsigned char* lds; int tid, lane, wave, G, bid;
    __device__ __forceinline__ int gw() const { return bid * NWAVES + wave; }
    __device__ __forceinline__ int ngw() const { return G * NWAVES; }
    __device__ __forceinline__ int gt() const { return bid * (NWAVES * 64) + tid; }
    __device__ __forceinline__ int ngt() const { return G * NWAVES * 64; }
};
#define LDS_WAIT() asm volatile("s_waitcnt lgkmcnt(0)" ::: "memory")
__device__ __forceinline__ Frame fresh(const Frame& F0) { Frame F = F0; int w = F0.wave; asm volatile("" : "+s"(w)); int ln = (int)__builtin_amdgcn_mbcnt_hi(~0u, __builtin_amdgcn_mbcnt_lo(~0u, 0u)); asm volatile("" : "+v"(ln));
    F.wave = w; F.lane = ln; F.tid = w * 64 + ln;
    int b = blockIdx.x, g = gridDim.x; asm volatile("" : "+s"(b), "+s"(g)); F.bid = b; F.G = g; return F; }

#ifndef PROBE_TS_A
#define PROBE_TS_A -1
#endif
#ifndef PROBE_TS_B
#define PROBE_TS_B -1
#endif
#ifndef PROBE_TS_MULT
#define PROBE_TS_MULT 8
#endif
constexpr int CW_TS = 12288;
template <int L> __device__ __forceinline__ void STAMP(int slot, int blk) {
    if constexpr (PROBE_TS_A >= 0) { if (threadIdx.x == 0 && (int)blockIdx.x == blk && (slot == PROBE_TS_A || slot == PROBE_TS_B)) {
        unsigned long long* ts = (unsigned long long*)((unsigned*)(KWS() + WS_CTL) + CW_TS); __hip_atomic_store(ts + L * 32 + slot, __builtin_amdgcn_s_memrealtime(), __ATOMIC_RELAXED, __HIP_MEMORY_SCOPE_AGENT); } }
}
__device__ __forceinline__ void STAMPR(int l, int slot, int blk) {
    if constexpr (PROBE_TS_A >= 0) { if (threadIdx.x == 0 && (int)blockIdx.x == blk && (slot == PROBE_TS_A || slot == PROBE_TS_B)) {
        unsigned long long* ts = (unsigned long long*)((unsigned*)(KWS() + WS_CTL) + CW_TS); __hip_atomic_store(ts + l * 32 + slot, __builtin_amdgcn_s_memrealtime(), __ATOMIC_RELAXED, __HIP_MEMORY_SCOPE_AGENT); } }
}
__device__ __forceinline__ void probe_tail() {
    if constexpr (PROBE_TS_A >= 0) { if (threadIdx.x == 0 && blockIdx.x == 0) {
        unsigned long long* ts = (unsigned long long*)((unsigned*)(KWS() + WS_CTL) + CW_TS); unsigned long long tot = 0;
        for (int l = 0; l < DEPTH; ++l) { const unsigned long long a = __hip_atomic_load(ts + l * 32 + PROBE_TS_A, __ATOMIC_RELAXED, __HIP_MEMORY_SCOPE_AGENT), b = __hip_atomic_load(ts + l * 32 + PROBE_TS_B, __ATOMIC_RELAXED, __HIP_MEMORY_SCOPE_AGENT); if (b > a) tot += b - a; }
        tot *= PROBE_TS_MULT; if (tot > 40000000ull) tot = 40000000ull;
        const unsigned long long t0 = __builtin_amdgcn_s_memrealtime();
        while (__builtin_amdgcn_s_memrealtime() - t0 < tot) __builtin_amdgcn_s_sleep(32); } }
}

struct MapId { __device__ __forceinline__ int operator()(int n) const { return n; } };
struct MapGU { int half; __device__ __forceinline__ int operator()(int n) const { return 256 * (n >> 7) + 128 * half + (n & 127); } };
struct MapIn { __device__ __forceinline__ int operator()(int n) const { return n < 4608 ? n : (n < 4624 ? 5632 + (n - 4608) : n - 16); } };
template <int K, int N, class Map>
__device__ __forceinline__ void transpose_item(const float* W, bf16_t* WT, int item, int lane, const Map map) {
    constexpr int nblk = (N + 63) >> 6;
    const int kb = item / nblk, nb = item - kb * nblk, k0 = 64 * kb, n = 64 * nb + lane;
    if (n < N) {
        const float* p = W + (size_t)k0 * N + n;
        float v[64];
#pragma unroll
        for (int i = 0; i < 64; ++i) v[i] = p[(size_t)i * N];
        bf16_t* q = WT + (size_t)map(n) * K + k0;
#pragma unroll
        for (int j = 0; j < 8; ++j) { u32x4 o; o.x = cvt_pk_bf16(v[8 * j], v[8 * j + 1]); o.y = cvt_pk_bf16(v[8 * j + 2], v[8 * j + 3]); o.z = cvt_pk_bf16(v[8 * j + 4], v[8 * j + 5]); o.w = cvt_pk_bf16(v[8 * j + 6], v[8 * j + 7]);
            *(u32x4*)(q + 8 * j) = o; }
    }
}
__device__ __forceinline__ void cplx_pow(float lre, float lim, float dt, int d, float& zr, float& zi) {
    const float mag = __expf((float)d * lre * dt);
    const double rev = (double)d * ((double)dt * (double)lim) * 0.15915494309189535;
    const float r = (float)(rev - rint(rev));
    zr = mag * __builtin_amdgcn_cosf(r); zi = mag * __builtin_amdgcn_sinf(r);
}
__device__ __forceinline__ void s5_coef(float lre, float lim, float dt, float& cr, float& ci) {
    const float a = lre * dt; const double rev = ((double)dt * (double)lim) * 0.15915494309189535; const float r = (float)(rev - rint(rev));
    const float cb = __builtin_amdgcn_cosf(r), sb = __builtin_amdgcn_sinf(r), sh = __builtin_amdgcn_sinf(0.5f * r);
    const float er = expm1_neg(a) * cb - 2.0f * sh * sh, ei = __expf(a) * sb;
    const float den = rcpf_(lre * lre + lim * lim);
    cr = (er * lre + ei * lim) * den; ci = (ei * lre - er * lim) * den;
}
__device__ __forceinline__ void phase_convert(const Frame& F, int l) {
    unsigned char* ws = KWS();
    const int gw = F.gw(), NGW = F.ngw();
    constexpr int I_GU = (D_MODEL / 64) * (D_FF / 64), I_DN = (D_FF / 64) * (D_MODEL / 64), I_IN = (D_MODEL / 64) * ((D_IN + 63) / 64), I_OUT = (D_MODEL / 64) * (D_MODEL / 64), I_GLU = (512 / 64) * (512 / 64);
    constexpr int NITEMS = 4 * I_GU + 2 * I_DN + I_IN + I_OUT + I_GLU;
    const size_t oGU = (size_t)l * D_MODEL * D_FF, oIN = (size_t)l * D_MODEL * D_IN, oOUT = (size_t)l * D_MODEL * D_MODEL, oGLU = (size_t)l * 512 * 512;
    for (int it = gw; it < NITEMS; it += NGW) {
        int r = it;
        if (r < I_GU) { transpose_item<D_MODEL, D_FF>(KIN(1) + oGU, (bf16_t*)(ws + WS_WGU1), r, F.lane, MapGU{0}); continue; } r -= I_GU;
        if (r < I_GU) { transpose_item<D_MODEL, D_FF>(KIN(2) + oGU, (bf16_t*)(ws + WS_WGU1), r, F.lane, MapGU{1}); continue; } r -= I_GU;
        if (r < I_DN) { transpose_item<D_FF, D_MODEL>(KIN(3) + oGU, (bf16_t*)(ws + WS_WD1), r, F.lane, MapId{}); continue; } r -= I_DN;
        if (r < I_GU) { transpose_item<D_MODEL, D_FF>(KIN(31) + oGU, (bf16_t*)(ws + WS_WGU2), r, F.lane, MapGU{0}); continue; } r -= I_GU;
        if (r < I_GU) { transpose_item<D_MODEL, D_FF>(KIN(32) + oGU, (bf16_t*)(ws + WS_WGU2), r, F.lane, MapGU{1}); continue; } r -= I_GU;
        if (r < I_DN) { transpose_item<D_FF, D_MODEL>(KIN(33) + oGU, (bf16_t*)(ws + WS_WD2), r, F.lane, MapId{}); continue; } r -= I_DN;
        if (r < I_IN) { transpose_item<D_MODEL, D_IN>(KIN(6) + oIN, (bf16_t*)(ws + WS_WIN), r, F.lane, MapIn{}); continue; } r -= I_IN;
        if (r < I_OUT) { transpose_item<D_MODEL, D_MODEL>(KIN(28) + oOUT, (bf16_t*)(ws + WS_WOUT), r, F.lane, MapId{}); continue; } r -= I_OUT;
        transpose_item<512, 512>(KIN(15) + oGLU, (bf16_t*)(ws + WS_WGLU), r, F.lane, MapId{});
    }
    STAMPR(l, 25, 40);
    const int gt = F.gt(), NGT = F.ngt();
    { const float* wa = KIN(23) + (size_t)l * 8 * 64 * 64; const float* wx = KIN(25) + (size_t)l * 8 * 64 * 64; bf16_t* WL = (bf16_t*)(ws + WS_WLRU);
      for (int idx = gt; idx < 1024 * 512; idx += NGT) { const int row = idx >> 9, k = idx & 511, pn = row >> 8, bj = (row >> 7) & 1, j = row & 127, c = 128 * pn + j, h = c >> 6;
          float v = 0.f; if ((k >> 6) == h) v = (bj ? wx : wa)[(h * 64 + (k & 63)) * 64 + (c & 63)];
          WL[idx] = (bf16_t)f2bf(v); } }
    STAMPR(l, 26, 40);
    if (F.G == 256) {
        __syncthreads();
        const float* lre_ = KIN(7) + l * 2048; const float* lim_ = KIN(8) + l * 2048; const float* bre = KIN(9) + (size_t)l * 32768; const float* bim = KIN(10) + (size_t)l * 32768;
        const float* cre = KIN(11) + (size_t)l * 32768; const float* cim = KIN(12) + (size_t)l * 32768; const float* lstep = KIN(14) + l * 32;
        const int g = F.bid & 31, sl8 = F.bid >> 5, tid = F.tid;
        LAS float* PW = (LAS float*)F.lds;
        LAS float* LB = PW + 64 * 18;
        LAS float* CF = LB + 128;
        const float dt = __expf(lstep[g]);
        for (int e = tid; e < 64 * 9; e += 512) { const int n = e / 9, k = e - 9 * n; const float lre = fminf(lre_[g * 64 + n], -1e-4f), lim = lim_[g * 64 + n];
            float zr, zi; cplx_pow(lre, lim, dt, 8 * k, zr, zi); PW[e * 2] = zr; PW[e * 2 + 1] = zi; }
        if (tid < 64) { const float lre = fminf(lre_[g * 64 + tid], -1e-4f), lim = lim_[g * 64 + tid]; float ar, ai, cr, ci; cplx_pow(lre, lim, dt, 1, ar, ai); s5_coef(lre, lim, dt, cr, ci);
            LB[2 * tid] = ar; LB[2 * tid + 1] = ai; CF[2 * tid] = cr; CF[2 * tid + 1] = ci; }
        LAS float* BR = CF + 128; LAS float* BI = BR + 1024; LAS float* CR = BI + 1024; LAS float* CI = CR + 1024;
        for (int e = tid; e < 1024; e += 512) { BR[e] = bre[g * 1024 + e]; BI[e] = bim[g * 1024 + e]; CR[e] = cre[g * 1024 + e]; CI[e] = cim[g * 1024 + e]; }
        __syncthreads();
        bf16_t* KT = (bf16_t*)(ws + WS_KTAB); bf16_t* PT = (bf16_t*)(ws + WS_PTAB); bf16_t* QT = (bf16_t*)(ws + WS_QTAB);
        if (tid < 256) {
            const int it = sl8 * 256 + tid, q = it & 15, d8 = (it >> 4) & 7, p = it >> 7;
            float acc[8];
#pragma unroll
            for (int dd = 0; dd < 8; ++dd) acc[dd] = 0.f;
            for (int n = 0; n < 64; ++n) { const float zr = PW[(n * 9 + d8) * 2], zi = PW[(n * 9 + d8) * 2 + 1], ar = LB[2 * n], ai = LB[2 * n + 1], cr = CF[2 * n], ci = CF[2 * n + 1];
                const float br = BR[n * 16 + q], bi = BI[n * 16 + q];
                const float bbr = cr * br - ci * bi, bbi = cr * bi + ci * br;
                float wr_ = zr * bbr - zi * bbi, wi_ = zr * bbi + zi * bbr;
                const float c_r = CR[p * 64 + n], c_i = CI[p * 64 + n];
#pragma unroll
                for (int dd = 0; dd < 8; ++dd) { acc[dd] += c_r * wr_ - c_i * wi_; const float t = wr_ * ar - wi_ * ai; wi_ = wr_ * ai + wi_ * ar; wr_ = t; } }
#pragma unroll
            for (int dd = 0; dd < 8; ++dd) KT[(((size_t)g * 16 + p) * 128 + (63 - 8 * d8 - dd)) * 16 + q] = (bf16_t)f2bf(acc[dd]);
        }
#pragma unroll
        for (int rep = 0; rep < 2; ++rep) {
            const int it = sl8 * 1024 + rep * 512 + tid, q = it & 15, s8 = (it >> 4) & 7, n = it >> 7;
            const float zr = PW[(n * 9 + (7 - s8)) * 2], zi = PW[(n * 9 + (7 - s8)) * 2 + 1], ar = LB[2 * n], ai = LB[2 * n + 1], cr = CF[2 * n], ci = CF[2 * n + 1];
            const float br = BR[n * 16 + q], bi = BI[n * 16 + q];
            const float bbr = cr * br - ci * bi, bbi = cr * bi + ci * br;
            float wr_ = zr * bbr - zi * bbi, wi_ = zr * bbi + zi * bbr;
#pragma unroll
            for (int ss = 7; ss >= 0; --ss) { const int s_ = 8 * s8 + ss;
                PT[((size_t)g * 256 + 2 * n) * 1024 + s_ * 16 + q] = (bf16_t)f2bf(wr_); PT[((size_t)g * 256 + 2 * n + 1) * 1024 + s_ * 16 + q] = (bf16_t)f2bf(wi_);
                const float t = wr_ * ar - wi_ * ai; wi_ = wr_ * ai + wi_ * ar; wr_ = t; }
        }
#pragma unroll
        for (int rep = 0; rep < 2; ++rep) {
            const int it = sl8 * 1024 + rep * 512 + tid, n = it & 63, t8 = (it >> 6) & 7, p = it >> 9;
            const float ar = LB[2 * n], ai = LB[2 * n + 1]; const float z0r = PW[(n * 9 + t8) * 2], z0i = PW[(n * 9 + t8) * 2 + 1];
            const float zr = z0r * ar - z0i * ai, zi = z0r * ai + z0i * ar;
            const float c_r = CR[p * 64 + n], c_i = CI[p * 64 + n];
            float wr_ = c_r * zr - c_i * zi, wi_ = c_r * zi + c_i * zr;
#pragma unroll
            for (int tt = 0; tt < 8; ++tt) { const int t = 8 * t8 + tt;
                *(unsigned*)(QT + ((size_t)g * 1024 + t * 16 + p) * 256 + 2 * n) = cvt_pk_bf16(wr_, -wi_);
                const float tmp = wr_ * ar - wi_ * ai; wi_ = wr_ * ai + wi_ * ar; wr_ = tmp; }
        }
        if (l == 0) {
            for (int idx = gt; idx < 32 * 16 * 64 * 2; idx += NGT) { const int gp = idx >> 7, r = idx & 127; *(u32x4*)(KT + ((size_t)gp * 128 + 64) * 16 + r * 8) = (u32x4){0u, 0u, 0u, 0u}; }
            for (int idx = gt; idx < 32 * 1024 * 16; idx += NGT) { const int row = idx >> 4, r = idx & 15; *(u32x4*)(QT + (size_t)row * 256 + 128 + r * 8) = (u32x4){0u, 0u, 0u, 0u}; } }
        __syncthreads();
    }
    STAMPR(l, 27, 40);
}
__device__ __forceinline__ void phase_x_to_bf16(const Frame& F, const float* x, bf16_t* XN) {
    const size_t n8 = (size_t)M_TOK * D_MODEL / 8;
    for (size_t i = F.gt(); i < n8; i += F.ngt()) { const f32x4 a = *(const f32x4*)(x + i * 8), b = *(const f32x4*)(x + i * 8 + 4);
        u32x4 w; w.x = cvt_pk_bf16(a[0], a[1]); w.y = cvt_pk_bf16(a[2], a[3]); w.z = cvt_pk_bf16(b[0], b[1]); w.w = cvt_pk_bf16(b[2], b[3]); *(u32x4*)(XN + i * 8) = w; }
}
__device__ __forceinline__ void phase_ln(const Frame& F, float* X, const float* gam, const float* bet, bf16_t* XN) {
    f32x4 gv[8], bv[8];
#pragma unroll
    for (int j = 0; j < 8; ++j) { gv[j] = *(const f32x4*)(gam + 4 * F.lane + 256 * j); bv[j] = *(const f32x4*)(bet + 4 * F.lane + 256 * j); }
    for (int m = F.gw(); m < M_TOK; m += F.ngw()) {
        float* xr = X + (size_t)m * D_MODEL + 4 * F.lane; f32x4 v[8]; float s = 0.f;
#pragma unroll
        for (int j = 0; j < 8; ++j) { v[j] = *(const f32x4*)(xr + 256 * j); s += (v[j][0] + v[j][1]) + (v[j][2] + v[j][3]); }
        const float mean = wave_sum(s) * (1.f / D_MODEL); float s2 = 0.f;
#pragma unroll
        for (int j = 0; j < 8; ++j) { v[j] = v[j] - mean; s2 += (v[j][0] * v[j][0] + v[j][1] * v[j][1]) + (v[j][2] * v[j][2] + v[j][3] * v[j][3]); }
        const float rstd = rsqf_(wave_sum(s2) * (1.f / D_MODEL) + LN_EPS);
        bf16_t* xo = XN + (size_t)m * D_MODEL + 4 * F.lane;
#pragma unroll
        for (int j = 0; j < 8; ++j) { const f32x4 o = v[j] * rstd * gv[j] + bv[j]; *(f32x4*)(xr + 256 * j) = o;
            u32x2 w; w.x = cvt_pk_bf16(o[0], o[1]); w.y = cvt_pk_bf16(o[2], o[3]); *(u32x2*)(xo + 256 * j) = w; }
    }
}

__device__ __forceinline__ void phase_lru_conv(const Frame& F, const bf16_t* LX, const float* cw, const float* cb, bf16_t* XC) {
    const int nitems = M_TOK * 64;
    for (int it = F.gt(); it < nitems; it += F.ngt()) {
        const int row = it >> 6, c8 = (it & 63) * 8, t = row & (SEQ - 1);
        float acc[8];
#pragma unroll
        for (int e = 0; e < 8; ++e) acc[e] = cb[c8 + e];
#pragma unroll
        for (int k = 0; k < 4; ++k) { const int dt_ = 3 - k; if (t - dt_ >= 0) {
                const u32x4 xx = *(const u32x4*)(LX + (size_t)(row - dt_) * LRU_W + c8);
                const f32x4 w0 = *(const f32x4*)(cw + k * LRU_W + c8), w1 = *(const f32x4*)(cw + k * LRU_W + c8 + 4);
                acc[0] += w0[0] * bflo(xx.x); acc[1] += w0[1] * bfhi(xx.x); acc[2] += w0[2] * bflo(xx.y); acc[3] += w0[3] * bfhi(xx.y);
                acc[4] += w1[0] * bflo(xx.z); acc[5] += w1[1] * bfhi(xx.z); acc[6] += w1[2] * bflo(xx.w); acc[7] += w1[3] * bfhi(xx.w); } }
        u32x4 w; w.x = cvt_pk_bf16(acc[0], acc[1]); w.y = cvt_pk_bf16(acc[2], acc[3]); w.z = cvt_pk_bf16(acc[4], acc[5]); w.w = cvt_pk_bf16(acc[6], acc[7]);
        *(u32x4*)(XC + (size_t)row * LRU_W + c8) = w;
    }
}
__device__ __forceinline__ void lru_p1_tile(int tid, int pm, int pn, const float* LA, const float* LB, float* CA, float* CB) {
    const int bc = pm * 4 + (tid >> 7), ch = pn * 128 + (tid & 127); const size_t base = (size_t)bc * CH * LRU_W + ch;
    float A = 1.f, B = 0.f;
#pragma unroll 16
    for (int t = 0; t < CH; ++t) { const float a = LA[base + (size_t)t * LRU_W], b = LB[base + (size_t)t * LRU_W]; B = a * B + b; A *= a; }
    CA[bc * LRU_W + ch] = A; CB[bc * LRU_W + ch] = B;
}
__device__ __forceinline__ void phase_lru_p3(int gt, int ngt, const float* LA, const float* LB, const float* CA, const float* CB, const bf16_t* LG, bf16_t* CAT) {
    for (int it = gt; it < NCHT * LRU_W; it += ngt) {
        const int bc = it >> 9, ch = it & 511, b = bc >> 7, c = bc & (NCH - 1); const size_t row0 = (size_t)bc * CH;
        float h = 0.f;
        for (int cc = 0; cc < c; ++cc) { const int o = (b * NCH + cc) * LRU_W + ch; h = CA[o] * h + CB[o]; }
#pragma unroll 8
        for (int t = 0; t < CH; ++t) { const size_t row = row0 + t; h = LA[row * LRU_W + ch] * h + LB[row * LRU_W + ch];
            const float gt_ = bf2f(LG[row * LRU_W + ch]); CAT[row * D_MODEL + 1536 + ch] = (bf16_t)f2bf(h * gelu_tanh(gt_)); }
    }
}

__device__ __forceinline__ void s5_carry_group(int g, int tix, const float* lre_, const float* lim_, const float* lstep, const float* S5S, bf16_t* HEXT) {
    if (tix >= BATCH * 64) return;
    const int b = tix >> 6, n = tix & 63;
    const float dt = __expf(lstep[g]); const float lre = fminf(lre_[g * 64 + n], -1e-4f), lim = lim_[g * 64 + n];
    float ar, ai; cplx_pow(lre, lim, dt, 64, ar, ai);
    float hr = 0.f, hi = 0.f;
    for (int c0 = 0; c0 < NCH; c0 += 16) {
        f32x2 sv[16];
#pragma unroll
        for (int k = 0; k < 16; ++k) sv[k] = *(const f32x2*)(S5S + ((size_t)g * NCHT + b * NCH + c0 + k) * 128 + 2 * n);
#pragma unroll
        for (int k = 0; k < 16; ++k) { const size_t rowi = (size_t)g * NCHT + b * NCH + c0 + k;
            *(unsigned*)(HEXT + rowi * 256 + 2 * n) = cvt_pk_bf16(hr, hi); *(unsigned*)(HEXT + rowi * 256 + 128 + 2 * n) = 0u;
            const float nr = ar * hr - ai * hi + sv[k][0], ni = ar * hi + ai * hr + sv[k][1]; hr = nr; hi = ni; } }
}

__device__ __forceinline__ int fragoff(int m, int k, int KS) { const int idx = k & 31, g = (idx & 15) >> 2, j = (idx & 3) + 4 * (idx >> 4); return ((((m >> 4) * KS + (k >> 5)) * 64) + 16 * g + (m & 15)) * 8 + j; }
__device__ __forceinline__ bf16x8 ldsfrag(LAS unsigned char* lds, int base, int stride, int row0, int k0, int lane) { return *(const LAS bf16x8*)(lds + base + (row0 + (lane & 15)) * stride + (k0 + 8 * (lane >> 4)) * 2); }
typedef short v4i16_t __attribute__((ext_vector_type(4)));
__device__ __forceinline__ bf16x8 ldstr(LAS unsigned char* lds, int base, int stride, int row_lo, int row_hi, int col0, int lane) {
#if defined(TR_SLOW)
    const int n = lane & 15; bf16x8 r;
#pragma unroll
    for (int j = 0; j < 4; ++j) { r[j] = *(const LAS short*)(lds + base + (row_lo + j) * stride + (col0 + n) * 2); r[4 + j] = *(const LAS short*)(lds + base + (row_hi + j) * stride + (col0 + n) * 2); }
    return r;
#else
    const int q = (lane & 15) >> 2, p = lane & 3;
    const v4i16_t lo = __builtin_amdgcn_ds_read_tr16_b64_v4i16((LAS v4i16_t*)(lds + base + (row_lo + q) * stride + (col0 + 4 * p) * 2));
    const v4i16_t hi = __builtin_amdgcn_ds_read_tr16_b64_v4i16((LAS v4i16_t*)(lds + base + (row_hi + q) * stride + (col0 + 4 * p) * 2));
    return (bf16x8){lo[0], lo[1], lo[2], lo[3], hi[0], hi[1], hi[2], hi[3]};
#endif
}
__device__ __forceinline__ bf16x8 pack2(const f32x4& a, const f32x4& b) { u32x4 w; w.x = cvt_pk_bf16(a[0], a[1]); w.y = cvt_pk_bf16(a[2], a[3]); w.z = cvt_pk_bf16(b[0], b[1]); w.w = cvt_pk_bf16(b[2], b[3]); return __builtin_bit_cast(bf16x8, w); }
constexpr int GP_QS = 0, GP_KS = 18432, GP_KB = 36864, GP_KD = 55296, GP_VB = 73728, GP_QD = 92160, GP_MF = 110592, GP_TB = 126976, GP_MISC = 137216, GP_TMP = GP_MISC + 1024, GP_RS = 288;
__device__ __forceinline__ void gdn_prep_unit(const Frame& F, int l, int unit) {
    unsigned char* ws = KWS(); LAS unsigned char* lds = F.lds;
    const int tid = F.tid, lane = F.lane, wave = F.wave;
    const int c = unit & (NCH - 1), bh = unit >> 7, h = bh & 7, b = bh >> 3, t0 = c * CH; const size_t tok0 = (size_t)b * SEQ + t0;
    const bf16_t* QKV = (const bf16_t*)(ws + WS_QKV); const float* AB = (const float*)(ws + WS_AB);
    LAS float* gcs = (LAS float*)(lds + GP_MISC); LAS float* betas = gcs + 64; LAS float* egs = gcs + 128; LAS float* egls = gcs + 192;
    LAS float* Mf = (LAS float*)(lds + GP_MF); LAS float* Xf = (LAS float*)(lds + GP_KS); LAS float* Tmp = (LAS float*)(lds + GP_TMP);
    if (wave == 0) {
        const float al = AB[(tok0 + lane) * 16 + h], bl = AB[(tok0 + lane) * 16 + 8 + h];
        float g = -__expf(KIN(18)[l * 8 + h]) * softplusf_(al + KIN(19)[l * 8 + h]);
#pragma unroll
        for (int o = 1; o < 64; o <<= 1) { const float t = __shfl_up(g, o); if (lane >= o) g += t; }
        const float glast = __shfl(g, 63);
        gcs[lane] = g; betas[lane] = sigmoidf_(bl); egs[lane] = __expf(g); egls[lane] = __expf(glast - g);
        if (lane == 0) ((float*)(ws + WS_GL))[unit] = __expf(glast);
    }
    __syncthreads();
    {
        const float* convw = KIN(17) + (size_t)l * 4 * 3072;
        float cw[3][4][2];
#pragma unroll
        for (int sg = 0; sg < 3; ++sg)
#pragma unroll
            for (int k = 0; k < 4; ++k) { const f32x2 w = *(const f32x2*)(convw + k * 3072 + sg * 1024 + h * 128 + 2 * lane); cw[sg][k][0] = w[0]; cw[sg][k][1] = w[1]; }
        float xw[3][3][2];
        const int i0 = wave * 8;
#pragma unroll
        for (int j = 0; j < 3; ++j) { const int tt = t0 + i0 - 3 + j;
#pragma unroll
            for (int sg = 0; sg < 3; ++sg) { unsigned v = 0u; if (tt >= 0) v = *(const unsigned*)(QKV + ((size_t)b * SEQ + tt) * 3072 + sg * 1024 + h * 128 + 2 * lane); xw[sg][j][0] = bflo(v); xw[sg][j][1] = bfhi(v); } }
#pragma unroll
        for (int ii = 0; ii < 8; ++ii) { const int i = i0 + ii; float y[3][2];
#pragma unroll
            for (int sg = 0; sg < 3; ++sg) { const unsigned v = *(const unsigned*)(QKV + (tok0 + i) * 3072 + sg * 1024 + h * 128 + 2 * lane); const float x0 = bflo(v), x1 = bfhi(v);
                y[sg][0] = siluf_(cw[sg][0][0] * xw[sg][0][0] + cw[sg][1][0] * xw[sg][1][0] + cw[sg][2][0] * xw[sg][2][0] + cw[sg][3][0] * x0);
                y[sg][1] = siluf_(cw[sg][0][1] * xw[sg][0][1] + cw[sg][1][1] * xw[sg][1][1] + cw[sg][2][1] * xw[sg][2][1] + cw[sg][3][1] * x1);
                xw[sg][0][0] = xw[sg][1][0]; xw[sg][0][1] = xw[sg][1][1]; xw[sg][1][0] = xw[sg][2][0]; xw[sg][1][1] = xw[sg][2][1]; xw[sg][2][0] = x0; xw[sg][2][1] = x1; }
            const float ssq = wave_sum(y[0][0] * y[0][0] + y[0][1] * y[0][1]), ssk = wave_sum(y[1][0] * y[1][0] + y[1][1] * y[1][1]);
            const float rq = rsqf_(ssq + RMS_EPS) * 0.08838834764831845f, rk = rsqf_(ssk + RMS_EPS);
            const float q0 = y[0][0] * rq, q1 = y[0][1] * rq, k0 = y[1][0] * rk, k1 = y[1][1] * rk;
            const float be = betas[i], eg = egs[i], egl = egls[i];
            const int ro = i * GP_RS + lane * 4;
            *(LAS unsigned*)(lds + GP_QS + ro) = cvt_pk_bf16(q0, q1);
            *(LAS unsigned*)(lds + GP_KS + ro) = cvt_pk_bf16(k0, k1);
            *(LAS unsigned*)(lds + GP_KB + ro) = cvt_pk_bf16(k0 * be * eg, k1 * be * eg);
            *(LAS unsigned*)(lds + GP_KD + ro) = cvt_pk_bf16(k0 * egl, k1 * egl);
            *(LAS unsigned*)(lds + GP_VB + ro) = cvt_pk_bf16(y[2][0] * be, y[2][1] * be);
            *(LAS unsigned*)(lds + GP_QD + ro) = cvt_pk_bf16(q0 * eg, q1 * eg);
        }
    }
    __syncthreads();
    {
        u32x4* dq = (u32x4*)(ws + WS_GQD + (size_t)unit * 16384);
#pragma unroll
        for (int rep = 0; rep < 2; ++rep) { const int e = tid + 512 * rep, f = e >> 6, ln = e & 63, i4 = f >> 2, s4 = f & 3, r = ln & 15, g = ln >> 4;
            const u32x2 lo = *(const LAS u32x2*)(lds + GP_QD + (16 * i4 + r) * GP_RS + (32 * s4 + 4 * g) * 2), hi = *(const LAS u32x2*)(lds + GP_QD + (16 * i4 + r) * GP_RS + (32 * s4 + 16 + 4 * g) * 2);
            dq[e] = (u32x4){lo.x, lo.y, hi.x, hi.y}; }
    }
    {
        u32x4* dk = (u32x4*)(ws + WS_GKD + (size_t)unit * 16384);
#pragma unroll
        for (int s2 = 0; s2 < 2; ++s2) { const int G = lane >> 4;
            const bf16x8 fr = ldstr(lds, GP_KD, GP_RS, 32 * s2 + 4 * G, 32 * s2 + 16 + 4 * G, 16 * wave, lane);
            dk[(wave * 2 + s2) * 64 + lane] = __builtin_bit_cast(u32x4, fr); }
    }
    {
        const int it = wave >> 1, s2 = wave & 1;
        f32x4 kk[2], qk[2];
#pragma unroll
        for (int jj = 0; jj < 2; ++jj) { kk[jj] = (f32x4){0.f, 0.f, 0.f, 0.f}; qk[jj] = (f32x4){0.f, 0.f, 0.f, 0.f}; }
#pragma unroll
        for (int s = 0; s < 4; ++s) { const bf16x8 bK = ldsfrag(lds, GP_KS, GP_RS, 16 * it, 32 * s, lane), bQ = ldsfrag(lds, GP_QS, GP_RS, 16 * it, 32 * s, lane);
#pragma unroll
            for (int jj = 0; jj < 2; ++jj) { const bf16x8 aK = ldsfrag(lds, GP_KS, GP_RS, 16 * (2 * s2 + jj), 32 * s, lane);
                kk[jj] = __builtin_amdgcn_mfma_f32_16x16x32_bf16(aK, bK, kk[jj], 0, 0, 0); qk[jj] = __builtin_amdgcn_mfma_f32_16x16x32_bf16(aK, bQ, qk[jj], 0, 0, 0); } }
        const int i = 16 * it + (lane & 15); const float gci = gcs[i], bei = betas[i];
        f32x4 qm[2];
#pragma unroll
        for (int jj = 0; jj < 2; ++jj) { f32x4 mrow;
#pragma unroll
            for (int r = 0; r < 4; ++r) { const int j = 16 * (2 * s2 + jj) + 4 * (lane >> 4) + r;
                const float dec = (i >= j) ? __expf(gci - gcs[j]) : 0.f;
                mrow[r] = (i > j) ? bei * kk[jj][r] * dec : 0.f; qm[jj][r] = qk[jj][r] * dec; }
            *(LAS f32x4*)(Mf + i * 64 + 16 * (2 * s2 + jj) + 4 * (lane >> 4)) = mrow; }
        ((u32x4*)(ws + WS_GQK + (size_t)unit * 8192))[(it * 2 + s2) * 64 + lane] = __builtin_bit_cast(u32x4, pack2(qm[0], qm[1]));
    }
    __syncthreads();
    {   for (int e = tid; e < 6 * 256; e += 512) { const int blk = e >> 8, i = (e >> 4) & 15, j = e & 15; const int br = blk < 3 ? 0 : (blk < 5 ? 1 : 2), bc = blk < 3 ? blk + 1 : (blk < 5 ? blk - 1 : 3);
            Xf[(16 * br + i) * 64 + 16 * bc + j] = 0.f; }
        if (wave == 0) { const int bb = lane >> 4, cc = lane & 15; float x[16];
#pragma unroll
            for (int i = 0; i < 16; ++i) { float s_ = (i == cc) ? 1.f : 0.f;
#pragma unroll
                for (int j = 0; j < i; ++j) s_ -= Mf[(16 * bb + i) * 64 + 16 * bb + j] * x[j];
                x[i] = s_; }
#pragma unroll
            for (int i = 0; i < 16; ++i) Xf[(16 * bb + i) * 64 + 16 * bb + cc] = x[i]; }
    }
    __syncthreads();
    { const int pr = tid >> 8, i = (tid >> 4) & 15, j = tid & 15, lo = 32 * pr, hi = lo + 16; float s_ = 0.f;
#pragma unroll
      for (int k = 0; k < 16; ++k) s_ += Mf[(hi + i) * 64 + lo + k] * Xf[(lo + k) * 64 + lo + j];
      Tmp[pr * 256 + i * 16 + j] = s_; }
    __syncthreads();
    { const int pr = tid >> 8, i = (tid >> 4) & 15, j = tid & 15, lo = 32 * pr, hi = lo + 16; float s_ = 0.f;
#pragma unroll
      for (int k = 0; k < 16; ++k) s_ += Xf[(hi + i) * 64 + hi + k] * Tmp[pr * 256 + k * 16 + j];
      Xf[(hi + i) * 64 + lo + j] = -s_; }
    __syncthreads();
#pragma unroll
    for (int rep = 0; rep < 2; ++rep) { const int e = tid + 512 * rep, i = e >> 5, j = e & 31; float s_ = 0.f;
#pragma unroll 8
        for (int k = 0; k < 32; ++k) s_ += Mf[(32 + i) * 64 + k] * Xf[k * 64 + j];
        Tmp[i * 32 + j] = s_; }
    __syncthreads();
#pragma unroll
    for (int rep = 0; rep < 2; ++rep) { const int e = tid + 512 * rep, i = e >> 5, j = e & 31; float s_ = 0.f;
#pragma unroll 8
        for (int k = 0; k < 32; ++k) s_ += Xf[(32 + i) * 64 + 32 + k] * Tmp[k * 32 + j];
        Xf[(32 + i) * 64 + j] = -s_; }
    __syncthreads();
    { const int row = tid >> 3, c0 = (tid & 7) * 8; const LAS float* sp = Xf + row * 64 + c0;
      u32x4 w; w.x = cvt_pk_bf16(sp[0], sp[1]); w.y = cvt_pk_bf16(sp[2], sp[3]); w.z = cvt_pk_bf16(sp[4], sp[5]); w.w = cvt_pk_bf16(sp[6], sp[7]);
      *(LAS u32x4*)(lds + GP_TB + row * 160 + c0 * 2) = w; }
    __syncthreads();
    {
        float* GU = (float*)(ws + WS_GU); const int G = lane >> 4;
        bf16x8 tb[4][2];
#pragma unroll
        for (int i = 0; i < 4; ++i)
#pragma unroll
            for (int s = 0; s < 2; ++s) tb[i][s] = ldsfrag(lds, GP_TB, 160, 16 * i, 32 * s, lane);
        bf16x8 vbf[2];
#pragma unroll
        for (int s = 0; s < 2; ++s) vbf[s] = ldstr(lds, GP_VB, GP_RS, 32 * s + 8 * G, 32 * s + 8 * G + 4, 16 * wave, lane);
#pragma unroll
        for (int i = 0; i < 4; ++i) { f32x4 au = (f32x4){0.f, 0.f, 0.f, 0.f};
#pragma unroll
            for (int s = 0; s < 2; ++s) au = __builtin_amdgcn_mfma_f32_16x16x32_bf16(tb[i][s], vbf[s], au, 0, 0, 0);
            *(f32x4*)(GU + ((((size_t)unit * 8 + wave) * 4 + i) * 64 + lane) * 4) = au; }
        const int ct = wave >> 1;
#pragma unroll
        for (int ss = 0; ss < 2; ++ss) { const int s4 = 2 * (wave & 1) + ss; f32x4 aw[2];
#pragma unroll
            for (int kp = 0; kp < 2; ++kp) { const int kt = 2 * s4 + kp; aw[kp] = (f32x4){0.f, 0.f, 0.f, 0.f};
#pragma unroll
                for (int s = 0; s < 2; ++s) aw[kp] = __builtin_amdgcn_mfma_f32_16x16x32_bf16(ldstr(lds, GP_KB, GP_RS, 32 * s + 8 * G, 32 * s + 8 * G + 4, 16 * kt, lane), ldsfrag(lds, GP_TB, 160, 16 * ct, 32 * s, lane), aw[kp], 0, 0, 0); }
            ((u32x4*)(ws + WS_GW + (size_t)unit * 16384))[(ct * 4 + s4) * 64 + lane] = __builtin_bit_cast(u32x4, pack2(aw[0], aw[1])); }
    }
    __syncthreads();
}
constexpr int SC_BUF = 61440, SC_W = 0, SC_QD = 16384, SC_KD = 32768, SC_QK = 49152, SC_U = 57344, SC_OST = 2 * SC_BUF, SC_AHEAD = 3;
__device__ __forceinline__ void gdn_scan_wg(LAS unsigned char* lds, int wave, int lane, int bh, int sl) {
    unsigned char* ws = KWS(); const int b = bh >> 3, h = bh & 7;
    const int role = wave - 1;
    const unsigned char* src0 = ws; size_t ustr0 = 16384; int off0 = 0;
    if (role == 0 || role == 1) { src0 = ws + WS_GW + (role & 1) * 8192; off0 = SC_W + (role & 1) * 8192; }
    else if (role == 2 || role == 3) { src0 = ws + WS_GQD + (role & 1) * 8192; off0 = SC_QD + (role & 1) * 8192; }
    else if (role == 4 || role == 5) { src0 = ws + WS_GKD + (role & 1) * 8192; off0 = SC_KD + (role & 1) * 8192; }
    else if (role == 6) { src0 = ws + WS_GQK; ustr0 = 8192; off0 = SC_QK; }
    const unsigned char* srcU = ws + WS_GU + (size_t)sl * 4096;
#define SC_LOAD(c_) do { const int unit_ = bh * NCH + (c_); const int bo_ = ((c_) & 1) * SC_BUF; \
        const unsigned char* p_ = src0 + (size_t)unit_ * ustr0 + lane * 16; \
        _Pragma("unroll") for (int k_ = 0; k_ < 8; ++k_) __builtin_amdgcn_global_load_lds((const unsigned*)(p_ + k_ * 1024), (LAS unsigned*)(lds + bo_ + off0 + k_ * 1024), 16, 0, 0); \
        if (role == 6) { const unsigned char* q_ = srcU + (size_t)unit_ * 32768 + lane * 16; \
            _Pragma("unroll") for (int k_ = 0; k_ < 4; ++k_) __builtin_amdgcn_global_load_lds((const unsigned*)(q_ + k_ * 1024), (LAS unsigned*)(lds + bo_ + SC_U + k_ * 1024), 16, 0, 0); } } while (0)
    f32x4 S[8];
#pragma unroll
    for (int j = 0; j < 8; ++j) S[j] = (f32x4){0.f, 0.f, 0.f, 0.f};
    if (wave != 0) { SC_LOAD(0); asm volatile("s_waitcnt vmcnt(0)" ::: "memory"); }
    asm volatile("" ::: "memory"); __builtin_amdgcn_s_barrier(); asm volatile("" ::: "memory");
    bf16_t* GO = (bf16_t*)(ws + WS_GO);
    const float* GLp = (const float*)(ws + WS_GL) + bh * NCH;
    float gl_next = GLp[0];
    for (int c = 0; c < NCH; ++c) {
        const float gl = gl_next; gl_next = GLp[c + 1 < NCH ? c + 1 : c];
        if (wave != 0) {
            if (c + 1 < NCH) { SC_LOAD(c + 1); asm volatile("s_waitcnt vmcnt(0)" ::: "memory"); }
        } else {
            LAS unsigned char* bb = lds + (c & 1) * SC_BUF + lane * 16;
            bf16x8 Sb[4];
#pragma unroll
            for (int s = 0; s < 4; ++s) Sb[s] = pack2(S[2 * s], S[2 * s + 1]);
            f32x4 vn[4], o[4];
#pragma unroll
            for (int i = 0; i < 4; ++i) { f32x4 p = (f32x4){0.f, 0.f, 0.f, 0.f}; o[i] = (f32x4){0.f, 0.f, 0.f, 0.f};
#pragma unroll
                for (int s = 0; s < 4; ++s) { p = __builtin_amdgcn_mfma_f32_16x16x32_bf16(*(const LAS bf16x8*)(bb + SC_W + (i * 4 + s) * 1024), Sb[s], p, 0, 0, 0);
                    o[i] = __builtin_amdgcn_mfma_f32_16x16x32_bf16(*(const LAS bf16x8*)(bb + SC_QD + (i * 4 + s) * 1024), Sb[s], o[i], 0, 0, 0); }
                vn[i] = *(const LAS f32x4*)(bb + SC_U + i * 1024) - p; }
            bf16x8 vb[2];
            vb[0] = pack2(vn[0], vn[1]); vb[1] = pack2(vn[2], vn[3]);
#pragma unroll
            for (int i = 0; i < 4; ++i)
#pragma unroll
                for (int s = 0; s < 2; ++s) o[i] = __builtin_amdgcn_mfma_f32_16x16x32_bf16(*(const LAS bf16x8*)(bb + SC_QK + (i * 2 + s) * 1024), vb[s], o[i], 0, 0, 0);
#pragma unroll
            for (int j = 0; j < 8; ++j) { S[j] = S[j] * gl;
#pragma unroll
                for (int s = 0; s < 2; ++s) S[j] = __builtin_amdgcn_mfma_f32_16x16x32_bf16(*(const LAS bf16x8*)(bb + SC_KD + (j * 2 + s) * 1024), vb[s], S[j], 0, 0, 0); }
            LAS bf16_t* ost = (LAS bf16_t*)(lds + SC_OST);
#pragma unroll
            for (int i = 0; i < 4; ++i)
#pragma unroll
                for (int r = 0; r < 4; ++r) ost[(16 * i + 4 * (lane >> 4) + r) * 16 + (lane & 15)] = (bf16_t)f2bf(o[i][r]);
            LDS_WAIT();
#pragma unroll
            for (int k = 0; k < 2; ++k) { const int row = 32 * k + (lane >> 1); const u32x4 v = *(const LAS u32x4*)(ost + row * 16 + (lane & 1) * 8);
                *(u32x4*)(GO + ((size_t)b * SEQ + c * CH + row) * GDN_W + h * GDN_D + 16 * sl + (lane & 1) * 8) = v; }
            LDS_WAIT();
        }
        asm volatile("" ::: "memory"); __builtin_amdgcn_s_barrier(); asm volatile("" ::: "memory");
    }
#undef SC_LOAD
}
__device__ __forceinline__ void phase_gdn_post(const Frame& F, const bf16_t* GO, const bf16_t* Z, const float* ng, bf16_t* CAT) {
    const int d0 = (F.lane & 7) * 16;
    float gv[16];
#pragma unroll
    for (int e = 0; e < 16; ++e) gv[e] = ng[d0 + e];
    for (int m = F.gw(); m < M_TOK; m += F.ngw()) {
        const u32x4 o0 = *(const u32x4*)(GO + (size_t)m * GDN_W + F.lane * 16), o1 = *(const u32x4*)(GO + (size_t)m * GDN_W + F.lane * 16 + 8);
        const float v[16] = {bflo(o0.x), bfhi(o0.x), bflo(o0.y), bfhi(o0.y), bflo(o0.z), bfhi(o0.z), bflo(o0.w), bfhi(o0.w), bflo(o1.x), bfhi(o1.x), bflo(o1.y), bfhi(o1.y), bflo(o1.z), bfhi(o1.z), bflo(o1.w), bfhi(o1.w)};
        float ss = 0.f;
#pragma unroll
        for (int e = 0; e < 16; ++e) ss += v[e] * v[e];
        ss += __shfl_xor(ss, 1); ss += __shfl_xor(ss, 2); ss += __shfl_xor(ss, 4);
        const float rn = rsqf_(ss * (1.0f / GDN_D) + RMS_EPS);
        const u32x4 z0 = *(const u32x4*)(Z + (size_t)m * GDN_W + F.lane * 16), z1 = *(const u32x4*)(Z + (size_t)m * GDN_W + F.lane * 16 + 8);
        const float zz[16] = {bflo(z0.x), bfhi(z0.x), bflo(z0.y), bfhi(z0.y), bflo(z0.z), bfhi(z0.z), bflo(z0.w), bfhi(z0.w), bflo(z1.x), bfhi(z1.x), bflo(z1.y), bfhi(z1.y), bflo(z1.z), bfhi(z1.z), bflo(z1.w), bfhi(z1.w)};
        float o[16];
#pragma unroll
        for (int e = 0; e < 16; ++e) o[e] = v[e] * rn * gv[e] * siluf_(zz[e]);
        u32x4 w0, w1; w0.x = cvt_pk_bf16(o[0], o[1]); w0.y = cvt_pk_bf16(o[2], o[3]); w0.z = cvt_pk_bf16(o[4], o[5]); w0.w = cvt_pk_bf16(o[6], o[7]);
        w1.x = cvt_pk_bf16(o[8], o[9]); w1.y = cvt_pk_bf16(o[10], o[11]); w1.z = cvt_pk_bf16(o[12], o[13]); w1.w = cvt_pk_bf16(o[14], o[15]);
        bf16_t* cp = CAT + (size_t)m * D_MODEL + 512 + F.lane * 16; *(u32x4*)cp = w0; *(u32x4*)(cp + 8) = w1;
    }
}

struct DiagOrder { int nunits, G, c; __device__ bool next(int i, Unit& u) const { if (c < 0) return false; const long L = (long)i * G + c; if (L >= nunits) return false; u.pm = (int)L; u.pn = (int)L; return true; } };
struct GeoS5Intra {
    const char* U5; const char* KT;
    __device__ __forceinline__ int nt() const { return 16; }
    __device__ __forceinline__ int a_voff(int R, int C) const { return (R * 1024 + C) * 2; }
    __device__ __forceinline__ int b_voff(int R, int C) const { return (((R & 15) * 128 - (R >> 4)) * 16 + C) * 2; }
    __device__ __forceinline__ long a_hstep() const { return (long)128 * 1024 * 2; }
    __device__ __forceinline__ long b_hstep() const { return -256; }
    __device__ __forceinline__ const char* a_base(const Unit& u) const { return U5 + (size_t)u.pm * 256 * 1024 * 2; }
    __device__ __forceinline__ const char* b_base(const Unit& u) const { return KT + (size_t)u.pm * (16 * 128 * 16 * 2) + (63 - 16 * u.pn) * 32; }
};
struct GeoS5Inter {
    const char* HX; const char* QT;
    __device__ __forceinline__ int nt() const { return 4; }
    __device__ __forceinline__ int a_voff(int R, int C) const { return (R * 256 + C) * 2; }
    __device__ __forceinline__ int b_voff(int R, int C) const { return (R * 256 + C) * 2; }
    __device__ __forceinline__ long a_hstep() const { return (long)128 * 256 * 2; }
    __device__ __forceinline__ long b_hstep() const { return (long)128 * 256 * 2; }
    __device__ __forceinline__ const char* a_base(const Unit& u) const { return HX + (size_t)u.pm * 256 * 256 * 2; }
    __device__ __forceinline__ const char* b_base(const Unit& u) const { return QT + ((size_t)u.pm * 4 + u.pn) * 256 * 256 * 2; }
};

#define PHASE_FN static __device__ __forceinline__ void
extern __shared__ __attribute__((aligned(16))) unsigned char lds_raw[];
#define UNI(x) x = __builtin_amdgcn_readfirstlane(x)
__device__ __forceinline__ Frame make_frame() { Frame F; F.lds = (LAS unsigned char*)lds_raw;
    int t = threadIdx.x; asm volatile("" : "+v"(t)); F.tid = t; F.lane = t & 63; F.wave = __builtin_amdgcn_readfirstlane(t >> 6);
    int b = blockIdx.x, g = gridDim.x; asm volatile("" : "+s"(b), "+s"(g)); F.bid = b; F.G = g; return F; }
PHASE_FN ph_convert(int l) { UNI(l); const Frame F = make_frame(); unsigned char* const ws = KWS();
    phase_convert(F, l);
    if (l == 0) phase_x_to_bf16(F, KIN(0), (bf16_t*)(ws + WS_XN)); }
PHASE_FN ph_ffn_up(int sb) { UNI(sb); const Frame F = make_frame(); unsigned char* const ws = KWS();
    pg8::GeoStd g{(const char*)(ws + WS_XN), (const char*)(ws + (sb ? WS_WGU2 : WS_WGU1)), D_MODEL, D_MODEL, D_MODEL};
    pg8::StaticOrder S; S.init(M_TOK, 2 * D_FF, F.G, F.bid); EpiSwiGLU E{(bf16_t*)(ws + WS_H)};
    pg8::gemm_phase<pg8::GeoStd, EpiSwiGLU, pg8::StaticOrder, true>(F.lds, F.wave, g, S, E); }
PHASE_FN ph_ffn_down(int sb, int first) { UNI(sb); UNI(first); const Frame F = make_frame(); unsigned char* const ws = KWS();
    pg8::GeoStd g{(const char*)(ws + WS_H), (const char*)(ws + (sb ? WS_WD2 : WS_WD1)), D_FF, D_FF, D_FF};
    float* out = KOUT();
    pg8::StaticOrder S; S.init(M_TOK, D_MODEL, F.G, F.bid); EpiResid E{first ? KIN(0) : out, out, 0.5f};
    pg8::gemm_phase<pg8::GeoStd, EpiResid, pg8::StaticOrder, true>(F.lds, F.wave, g, S, E); }
PHASE_FN ph_ln(int l, int which) { UNI(l); UNI(which); const Frame F = make_frame(); unsigned char* const ws = KWS();
    const float* g = (which == 0 ? KIN(4) : which == 1 ? KIN(29) : KIN(34)) + l * D_MODEL; const float* b = (which == 0 ? KIN(5) : which == 1 ? KIN(30) : KIN(35)) + l * D_MODEL;
    phase_ln(F, KOUT(), g, b, (bf16_t*)(ws + WS_XN)); }
PHASE_FN ph_inproj() { const Frame F = make_frame(); unsigned char* const ws = KWS();
    pg8::GeoStd g{(const char*)(ws + WS_XN), (const char*)(ws + WS_WIN), D_MODEL, D_MODEL, D_MODEL};
    pg8::StaticOrder S; S.init(M_TOK, N_IN_PAD, F.G, F.bid);
    EpiInproj E{(bf16_t*)(ws + WS_U5), (bf16_t*)(ws + WS_QKV), (bf16_t*)(ws + WS_Z), (bf16_t*)(ws + WS_LX), (bf16_t*)(ws + WS_LG), (float*)(ws + WS_AB)};
    pg8::gemm_phase<pg8::GeoStd, EpiInproj, pg8::StaticOrder, true>(F.lds, F.wave, g, S, E); }
PHASE_FN ph_gdn_prep(int l) { UNI(l); const Frame F = make_frame();
    for (int uu = F.bid; uu < NUNIT / 8; uu += F.G)
        for (int u8 = 0; u8 < 8; ++u8) gdn_prep_unit(F, l, uu * 8 + u8); }
PHASE_FN ph_lru_conv(int l) { UNI(l); const Frame F = make_frame(); unsigned char* const ws = KWS();
    phase_lru_conv(F, (const bf16_t*)(ws + WS_LX), KIN(21) + l * 4 * LRU_W, KIN(22) + l * LRU_W, (bf16_t*)(ws + WS_XC)); }
PHASE_FN ph_s5_state() { const Frame F = make_frame(); unsigned char* const ws = KWS();
    pg8::GeoStd g{(const char*)(ws + WS_U5), (const char*)(ws + WS_PTAB), 1024, 1024, 1024};
    DiagOrder S{32, F.G, F.bid}; EpiS5S E{(float*)(ws + WS_S5S)};
    pg8::gemm_phase<pg8::GeoStd, EpiS5S, DiagOrder, false>(F.lds, F.wave, g, S, E); }
PHASE_FN ph_s5_intra() { const Frame F = make_frame(); unsigned char* const ws = KWS();
    GeoS5Intra g{(const char*)(ws + WS_U5), (const char*)(ws + WS_KTAB)};
    pg8::GroupOrder S{128, 4, F.G, F.bid - 32}; EpiS5Intra E{(float*)(ws + WS_YIN)};
    pg8::gemm_phase<GeoS5Intra, EpiS5Intra, pg8::GroupOrder, false>(F.lds, F.wave, g, S, E); }
PHASE_FN ph_gdn_scan() { const Frame F = make_frame();
    const int xcd = F.bid & 7, q = F.bid >> 3; gdn_scan_wg(F.lds, F.wave, F.lane, xcd * 2 + (q >> 3), q & 7); }
constexpr int NSCAN = 128, NCHAIN = 256 - NSCAN;
struct OwnUnitOrder { int g, j; __device__ bool next(int i, Unit& u) const { if (i >= 1) return false; u.pm = g; u.pn = j; return true; } };
template <int L> PHASE_FN ph_chain_a(int rep) { const int l = L; UNI(rep); const Frame F = make_frame(); unsigned char* const ws = KWS();
    const int w = F.bid - NSCAN;
    if (w < 128) {
        const int g = w >> 2, j = w & 3;
        bf16_t* hx = (bf16_t*)(ws + WS_HEXT) + (size_t)j * 32 * 256 * 256;
        s5_carry_group(g, F.tid, KIN(7) + l * 2048, KIN(8) + l * 2048, KIN(14) + l * 32, (const float*)(ws + WS_S5S), hx);
        asm volatile("s_waitcnt vmcnt(0)" ::: "memory"); __syncthreads();
        GeoS5Inter gg{(const char*)hx, (const char*)(ws + WS_QTAB)};
        OwnUnitOrder S{g, j}; EpiS5Inter E{(const float*)(ws + WS_YIN), (const bf16_t*)(ws + WS_U5), KIN(13) + l * S5_W, (bf16_t*)(ws + WS_YACT)};
        pg8::gemm_phase<GeoS5Inter, EpiS5Inter, OwnUnitOrder, false>(F.lds, F.wave, gg, S, E);
        STAMP<L>(18, 128);
    }
    {
        pg8::GeoStd g{(const char*)(ws + WS_XC), (const char*)(ws + WS_WLRU), LRU_W, LRU_W, LRU_W};
        pg8::StaticOrder S; S.init(M_TOK, 1024, NCHAIN, w);
        EpiLRU E{(const bf16_t*)(ws + WS_XC), KIN(24) + l * LRU_W, KIN(26) + l * LRU_W, KIN(27) + l * LRU_W, (float*)(ws + WS_LA), (float*)(ws + WS_LB)};
        pg8::gemm_phase<pg8::GeoStd, EpiLRU, pg8::StaticOrder, false>(F.lds, F.wave, g, S, E);
        asm volatile("s_waitcnt vmcnt(0)" ::: "memory"); __syncthreads();
        STAMP<L>(22, 128);
        Unit u; for (int i = 0; S.next(i, u); ++i) lru_p1_tile(F.tid, u.pm, u.pn, (const float*)(ws + WS_LA), (const float*)(ws + WS_LB), (float*)(ws + WS_CA), (float*)(ws + WS_CB));
        STAMP<L>(23, 128);
    }
    sub_barrier((unsigned*)(ws + WS_CTL) + CW_SUB + 64 * (2 * l + rep), (unsigned)NCHAIN);
}
template <int L> PHASE_FN ph_chain_b() { const int l = L; const Frame F = make_frame(); unsigned char* const ws = KWS();
    const int w = F.bid - NSCAN;
    {   pg8::GeoStd g{(const char*)(ws + WS_YACT), (const char*)(ws + WS_WGLU), S5_W, S5_W, S5_W};
        pg8::StaticOrder S; S.init(M_TOK, S5_W, NCHAIN, w); EpiGLU E{(const bf16_t*)(ws + WS_YACT), KIN(16) + l * S5_W, (bf16_t*)(ws + WS_CAT)};
        pg8::gemm_phase<pg8::GeoStd, EpiGLU, pg8::StaticOrder, false>(F.lds, F.wave, g, S, E); }
    STAMP<L>(20, 128);
    phase_lru_p3(w * (NWAVES * 64) + F.tid, NCHAIN * NWAVES * 64, (const float*)(ws + WS_LA), (const float*)(ws + WS_LB), (const float*)(ws + WS_CA), (const float*)(ws + WS_CB), (const bf16_t*)(ws + WS_LG), (bf16_t*)(ws + WS_CAT));
}
PHASE_FN ph_gdn_post(int l) { UNI(l); const Frame F = make_frame(); unsigned char* const ws = KWS();
    phase_gdn_post(F, (const bf16_t*)(ws + WS_GO), (const bf16_t*)(ws + WS_Z), KIN(20) + l * GDN_D, (bf16_t*)(ws + WS_CAT)); }
PHASE_FN ph_outproj() { const Frame F = make_frame(); unsigned char* const ws = KWS();
    pg8::GeoStd g{(const char*)(ws + WS_CAT), (const char*)(ws + WS_WOUT), D_MODEL, D_MODEL, D_MODEL};
    float* out = KOUT();
    pg8::StaticOrder S; S.init(M_TOK, D_MODEL, F.G, F.bid); EpiResid E{out, out, 1.0f};
    pg8::gemm_phase<pg8::GeoStd, EpiResid, pg8::StaticOrder, true>(F.lds, F.wave, g, S, E); }
PHASE_FN ph_grid_bar() { XcdBarrier b; b.bar = (unsigned*)(KWS() + WS_CTL) + CW_BAR; b.x = xb_xcc_id(); b.st = (volatile LAS unsigned*)((LAS unsigned char*)lds_raw + MISC_OFF) + 8; xcd_barrier(b); }

#ifndef PROBE_CONVERT
#define PROBE_CONVERT 1
#endif
#ifndef PROBE_FFNUP
#define PROBE_FFNUP 1
#endif
#ifndef PROBE_PREP
#define PROBE_PREP 1
#endif
#ifndef PROBE_SCAN
#define PROBE_SCAN 1
#endif
#ifndef PROBE_MIXER
#define PROBE_MIXER 1
#endif
#define GRID_BAR() ph_grid_bar()
#define REPEAT(N, stmt) do { { constexpr int mixrep_ = 0; (void)mixrep_; stmt; } if constexpr ((N) > 1) { GRID_BAR(); constexpr int mixrep_ = 1; (void)mixrep_; stmt; } } while (0)
template <int L, int SB> __device__ __forceinline__ void half_layer(int bid) {
    REPEAT(PROBE_FFNUP, ph_ffn_up(SB));
    GRID_BAR(); STAMP<L>(SB ? 11 : 2, 0);
    ph_ffn_down(SB, (L == 0 && SB == 0) ? 1 : 0);
    GRID_BAR(); STAMP<L>(SB ? 12 : 3, 0);
    ph_ln(L, SB ? 2 : 0);
    GRID_BAR(); STAMP<L>(SB ? 13 : 4, 0);
    if constexpr (SB == 0) {
        ph_inproj();
        GRID_BAR(); STAMP<L>(5, 0);
#define MIXER_BODY do { \
          \
        ph_gdn_prep(L); if constexpr (PROBE_PREP > 1) ph_gdn_prep(L); STAMP<L>(14, 40); ph_lru_conv(L); STAMP<L>(15, 40); ph_s5_state(); ph_s5_intra(); STAMP<L>(16, 40); \
        GRID_BAR(); STAMP<L>(6, 0); \
          \
        if (bid < NSCAN) { ph_gdn_scan(); if constexpr (PROBE_SCAN > 1) ph_gdn_scan(); STAMP<L>(17, 0); } else { ph_chain_a<L>(mixrep_); STAMP<L>(19, 128); ph_chain_b<L>(); STAMP<L>(21, 128); } \
        GRID_BAR(); STAMP<L>(7, 0); \
          \
        ph_gdn_post(L); } while (0)
        REPEAT(PROBE_MIXER, MIXER_BODY);
#undef MIXER_BODY
        GRID_BAR(); STAMP<L>(8, 0);
        ph_outproj();
        GRID_BAR(); STAMP<L>(9, 0);
        ph_ln(L, 1);
        GRID_BAR(); STAMP<L>(10, 0);
    }
}
template <int L> __device__ __forceinline__ void layer(int bid) {
    STAMP<L>(0, 0);
    REPEAT(PROBE_CONVERT, ph_convert(L));
    GRID_BAR(); STAMP<L>(1, 0);
    half_layer<L, 0>(bid);
    half_layer<L, 1>(bid);
}
__global__ void __launch_bounds__(NWAVES * 64, 2) fwd_kernel(Params Pdummy) {
    LAS unsigned char* lds = (LAS unsigned char*)lds_raw;
    for (int u = threadIdx.x; u < (LDS_BYTES - LDSCTL_OFF) / 4; u += NWAVES * 64) ((LAS unsigned*)(lds + LDSCTL_OFF))[u] = 0u;
    __syncthreads();
    LAS unsigned* st = (LAS unsigned*)(lds + MISC_OFF) + 8;
    unsigned* barw = (unsigned*)(KWS() + WS_CTL) + CW_BAR;
    (void)xcd_barrier_post(barw, (volatile LAS unsigned*)st);
    int bid = blockIdx.x; asm volatile("" : "+s"(bid));
    layer<0>(bid); layer<1>(bid); layer<2>(bid); layer<3>(bid);
    probe_tail();
}
#undef GRID_BAR

extern "C" void kernel_launch(void* const* d_in, const int* in_sizes, int n_in, void* d_out, int out_size, void* d_ws, size_t ws_size, hipStream_t stream) {
    static int grid = 0;
    if (grid == 0) {
        if (n_in != 36 || in_sizes[0] != M_TOK * D_MODEL || out_size != M_TOK * D_MODEL || ws_size < WS_END) { fprintf(stderr, "kernel_launch: unexpected shapes (n_in %d, ws %zu < %zu?)\n", n_in, ws_size, (size_t)WS_END); grid = -1; return; }
        int dev = 0, cus = 0, per_cu = 0;
        if (hipGetDevice(&dev) != hipSuccess || hipDeviceGetAttribute(&cus, hipDeviceAttributeMultiprocessorCount, dev) != hipSuccess) { grid = -1; return; }
        if (hipFuncSetAttribute((const void*)fwd_kernel, hipFuncAttributeMaxDynamicSharedMemorySize, LDS_BYTES) != hipSuccess) { fprintf(stderr, "kernel_launch: hipFuncSetAttribute failed\n"); grid = -1; return; }
        if (hipOccupancyMaxActiveBlocksPerMultiprocessor(&per_cu, (const void*)fwd_kernel, NWAVES * 64, LDS_BYTES) != hipSuccess || per_cu < 1) { fprintf(stderr, "kernel_launch: occupancy query reports %d\n", per_cu); }
        (void)hipGetLastError();
        if (cus < 256) { fprintf(stderr, "kernel_launch: needs 256 CUs, device has %d\n", cus); grid = -1; return; }
        grid = 256;
    }
    if (grid < 0) return;
    (void)hipMemsetAsync((char*)d_ws + WS_CTL, 0, CTL_BYTES, stream);
    Params p{};
    for (int i = 0; i < 36; ++i) p.in[i] = (const float*)d_in[i];
    p.out = (float*)d_out; p.ws = (unsigned char*)d_ws;
    hipLaunchKernelGGL(fwd_kernel, dim3(grid), dim3(NWAVES * 64), LDS_BYTES, stream, p);
}
```

```cpp
#include <hip/hip_runtime.h>
#include <cstdio>
#include <cstdint>

#define LAS __attribute__((address_space(3)))
#define GAS __attribute__((address_space(1)))
typedef unsigned short bf16_t;
typedef short bf16x8 __attribute__((ext_vector_type(8)));
typedef float f32x4 __attribute__((ext_vector_type(4)));
typedef float f32x2 __attribute__((ext_vector_type(2)));
typedef unsigned u32x4 __attribute__((ext_vector_type(4)));
typedef unsigned u32x2 __attribute__((ext_vector_type(2)));

constexpr int D_MODEL = 2048, BATCH = 2, SEQ = 8192, DEPTH = 4, M_TOK = BATCH * SEQ;
constexpr int D_FF = 5632, S5_W = 512, S5_G = 32, S5_P = 16, S5_N = 64;
constexpr int GDN_W = 1024, GDN_H = 8, GDN_D = 128, CH = 64, NCH = SEQ / CH  , NCHT = BATCH * NCH  ;
constexpr int LRU_W = 512;
constexpr int D_IN = 5648;
constexpr int N_IN_PAD = 5888;
constexpr float LN_EPS = 1e-5f, RMS_EPS = 1e-6f;
constexpr float DN_ALPHA = 1.6817928305074290f;

typedef __bf16 bf16x2_t __attribute__((ext_vector_type(2)));
__device__ __forceinline__ unsigned cvt_pk_bf16(float lo, float hi) { f32x2 v = {lo, hi}; bf16x2_t b = __builtin_convertvector(v, bf16x2_t); return __builtin_bit_cast(unsigned, b); }
__device__ __forceinline__ unsigned f2bf(float f) { unsigned u = __builtin_bit_cast(unsigned, f); return (u + 0x7fffu + ((u >> 16) & 1u)) >> 16; }
__device__ __forceinline__ float bf2f(unsigned h) { return __builtin_bit_cast(float, h << 16); }
__device__ __forceinline__ float bflo(unsigned w) { return __builtin_bit_cast(float, w << 16); }
__device__ __forceinline__ float bfhi(unsigned w) { return __builtin_bit_cast(float, w & 0xffff0000u); }
__device__ __forceinline__ float rcpf_(float x) { return __builtin_amdgcn_rcpf(x); }
__device__ __forceinline__ float rsqf_(float x) { return __builtin_amdgcn_rsqf(x); }
__device__ __forceinline__ float sqrtf_(float x) { return __builtin_amdgcn_sqrtf(x); }
__device__ __forceinline__ float sigmoidf_(float x) { return rcpf_(1.0f + __expf(-x)); }
__device__ __forceinline__ float siluf_(float x) { return x * rcpf_(1.0f + __expf(-x)); }
__device__ __forceinline__ float gelu_tanh(float x) { const float u = 0.7978845608028654f * (x + 0.044715f * x * x * x); return x * rcpf_(1.0f + __expf(-2.0f * u)); }
__device__ __forceinline__ float log1p_small(float e) { return e < 0.01f ? e * (1.0f - e * (0.5f - e * (1.0f / 3.0f))) : __logf(1.0f + e); }
__device__ __forceinline__ float softplusf_(float x) { return fmaxf(x, 0.f) + log1p_small(__expf(-fabsf(x))); }
__device__ __forceinline__ float expm1_neg(float z) {
    return fabsf(z) < 0.1f ? z * (1.0f + z * (0.5f + z * ((1.0f / 6.0f) + z * ((1.0f / 24.0f) + z * (1.0f / 120.0f))))) : __expf(z) - 1.0f; }
__device__ __forceinline__ float row16_sum(float v) {
    int t;
    t = __builtin_amdgcn_update_dpp(0, __builtin_bit_cast(int, v), 0xB1, 0xF, 0xF, true); v += __builtin_bit_cast(float, t);
    t = __builtin_amdgcn_update_dpp(0, __builtin_bit_cast(int, v), 0x4E, 0xF, 0xF, true); v += __builtin_bit_cast(float, t);
    t = __builtin_amdgcn_update_dpp(0, __builtin_bit_cast(int, v), 0x141, 0xF, 0xF, true); v += __builtin_bit_cast(float, t);
    t = __builtin_amdgcn_update_dpp(0, __builtin_bit_cast(int, v), 0x140, 0xF, 0xF, true); v += __builtin_bit_cast(float, t);
    return v;
}
__device__ __forceinline__ float wave_sum(float v) {
#pragma unroll
    for (int o = 1; o < 64; o <<= 1) v += __shfl_xor(v, o);
    return v;
}

namespace pg8 {
constexpr int BM = 256, BK = 64, HALF = 128, HTB = HALF * BK * 2, STAGE_BYTES = 8 * HTB, NXCD = 8, WGM = 8;
__host__ __device__ __forceinline__ int lds_byte(int r, int c) { const int st = (r >> 4) * 2 + (c >> 5), rr = r & 15, cc = c & 31, ob = rr * 64 + cc * 2; return st * 1024 + (ob ^ (((ob >> 9) & 1) << 5)); }
__host__ __device__ __forceinline__ void stage_rc(int b, int& R, int& C) { const int st = b / 1024, sb = b % 1024, swz = sb ^ (((sb >> 9) & 1) << 5); R = (st >> 1) * 16 + swz / 64; C = (st & 1) * 32 + (swz % 64) / 2; }
__host__ __device__ __forceinline__ int perm32(int rho) { const int n = rho >> 4, i = rho & 15; return 8 * (i >> 2) + 4 * n + (i & 3); }

struct Unit { int pm, pn; };

struct GeoStd {
    const char* A; const char* B; int lda, ldb, K;
    __device__ __forceinline__ int nt() const { return K / BK; }
    __device__ __forceinline__ int a_voff(int R, int C) const { return (R * lda + C) * 2; }
    __device__ __forceinline__ int b_voff(int R, int C) const { return (R * ldb + C) * 2; }
    __device__ __forceinline__ long a_hstep() const { return (long)HALF * lda * 2; }
    __device__ __forceinline__ long b_hstep() const { return (long)HALF * ldb * 2; }
    __device__ __forceinline__ const char* a_base(const Unit& u) const { return A + (size_t)u.pm * BM * lda * 2; }
    __device__ __forceinline__ const char* b_base(const Unit& u) const { return B + (size_t)u.pn * BM * ldb * 2; }
};

struct StaticOrder {
    int nM, nN, nwg, G, c;
    __device__ void init(int M, int N, int G_, int c_) { nM = M / BM; nN = N / BM; nwg = nM * nN; G = G_; c = c_; }
    __device__ bool next(int i, Unit& u) const {
        if (c < 0) return false;
        const long L = (long)i * G + c; if (L >= nwg) return false;
        int wgid = (int)L; { const int q = nwg / NXCD, r = nwg % NXCD, xcd = wgid % NXCD, off = wgid / NXCD; wgid = (xcd < r ? xcd * (q + 1) : r * (q + 1) + (xcd - r) * q) + off; }
        const int nig = WGM * nN, gid = wgid / nig, fm = gid * WGM, gsz = (nM - fm) < WGM ? (nM - fm) : WGM;
        u.pm = fm + ((wgid % nig) % gsz); u.pn = (wgid % nig) / gsz; return true;
    }
};
struct GroupOrder {
    int nunits, per, G, c;
    __device__ bool next(int i, Unit& u) const { if (c < 0) return false; const long L = (long)i * G + c; if (L >= nunits) return false; u.pm = (int)L / per; u.pn = (int)L % per; return true; }
};

template <class Geo, class Epi, class Sched, bool ALIGN_EPI>
__device__ __forceinline__ void gemm_phase(LAS unsigned char* lds, int wave_id, const Geo& g, const Sched& S, const Epi& E) {
    int tid = threadIdx.x; asm volatile("" : "+v"(tid));
    const int wid = __builtin_amdgcn_readfirstlane(tid >> 6), lane = tid & 63, wr = wid >> 2, wc = wid & 3, fr = lane & 15, fq = lane >> 4;
    const int nt = g.nt();
    int voffA[2], voffB[2];
#pragma unroll
    for (int i = 0; i < 2; ++i) { int R, C; stage_rc(tid * 16 + i * 8192, R, C); const int Rb = Epi::PERM ? ((R & ~31) + perm32(R & 31)) : R;
        voffA[i] = g.a_voff(R, C); voffB[i] = g.b_voff(Rb, C); }
    const long kstep = (long)(BK * 2);
    const long hstepA = g.a_hstep(), hstepB = g.b_hstep();
    const unsigned ldsw = (unsigned)wid * 1024u;
    const int aoff = lds_byte(wr * 64 + fr, fq * 8), boff = lds_byte(wc * 32 + fr, fq * 8);
#define PG8_SA(b, h) (((b) * 2 + (h)) * HTB)
#define PG8_SB(b, h) ((4 + (b) * 2 + (h)) * HTB)
#define PG8_STAGE(bufoff, gbase, voff) do { _Pragma("unroll") for (int _i = 0; _i < 2; ++_i) \
        __builtin_amdgcn_global_load_lds((const unsigned*)((const char*)(gbase) + (voff)[_i]), (LAS unsigned*)(lds + (bufoff) + ldsw + _i * 8192), 16, 0, 0); } while (0)
#define PG8_LDA(dst, b, h) do { _Pragma("unroll") for (int m = 0; m < 4; ++m) _Pragma("unroll") for (int k = 0; k < 2; ++k) dst[m][k] = *(const LAS bf16x8*)(lds + PG8_SA(b, h) + aoff + m * 2048 + k * 1024); } while (0)
#define PG8_LDB(dst, b, h) do { _Pragma("unroll") for (int n = 0; n < 2; ++n) _Pragma("unroll") for (int k = 0; k < 2; ++k) dst[n][k] = *(const LAS bf16x8*)(lds + PG8_SB(b, h) + boff + n * 2048 + k * 1024); } while (0)
#define PG8_MMA(ai, bj, At, Bt) do { __builtin_amdgcn_s_setprio(1); _Pragma("unroll") for (int m = 0; m < 4; ++m) _Pragma("unroll") for (int n = 0; n < 2; ++n) _Pragma("unroll") for (int k = 0; k < 2; ++k) \
        acc[ai][bj][m][n] = __builtin_amdgcn_mfma_f32_16x16x32_bf16(Bt[n][k], At[m][k], acc[ai][bj][m][n], 0, 0, 0); __builtin_amdgcn_s_setprio(0); } while (0)
#define PG8_WAIT_V(n) asm volatile("s_waitcnt vmcnt(" #n ")" ::: "memory")
#define PG8_WAIT_L(n) asm volatile("s_waitcnt lgkmcnt(" #n ")" ::: "memory")
#define PG8_BAR __builtin_amdgcn_s_barrier()
#define PG8_SCHED __builtin_amdgcn_sched_barrier(0)
    Unit cur, nxt; int ui = 0;
    if (!S.next(0, cur)) return;
    f32x4 acc[2][2][4][2];
#pragma unroll
    for (int a = 0; a < 2; ++a)
#pragma unroll
        for (int b = 0; b < 2; ++b)
#pragma unroll
            for (int m = 0; m < 4; ++m)
#pragma unroll
                for (int n = 0; n < 2; ++n) acc[a][b][m][n] = (f32x4){0.f, 0.f, 0.f, 0.f};
    bf16x8 At[4][2], B0[2][2], B1[2][2];
    const char* cA = g.a_base(cur); const char* cB = g.b_base(cur);
    PG8_STAGE(PG8_SB(0, 0), cB, voffB); PG8_STAGE(PG8_SB(0, 1), cB + hstepB, voffB); PG8_STAGE(PG8_SA(0, 0), cA, voffA); PG8_STAGE(PG8_SA(0, 1), cA + hstepA, voffA);
    if (wr == 1) PG8_BAR;
    PG8_WAIT_V(2); PG8_BAR;
    PG8_STAGE(PG8_SB(1, 0), cB + kstep, voffB); PG8_STAGE(PG8_SA(1, 0), cA + kstep, voffA); PG8_STAGE(PG8_SB(1, 1), cB + hstepB + kstep, voffB);
    PG8_WAIT_V(6); PG8_BAR;
    for (;;) {
        const bool has_next = S.next(ui + 1, nxt);
        const char* nA = has_next ? g.a_base(nxt) : cA; const char* nB = has_next ? g.b_base(nxt) : cB;
        for (int t = 0; t < nt; t += 2) {
            const bool last = (t == nt - 2);
            const char* a1 = cA + (long)(t + 1) * kstep;
            const char* a2 = last ? nA : cA + (long)(t + 2) * kstep; const char* b2 = last ? nB : cB + (long)(t + 2) * kstep;
            const char* a3 = a2 + kstep; const char* b3 = b2 + kstep;
            PG8_LDB(B0, 0, 0); PG8_LDB(B1, 0, 1); PG8_SCHED; PG8_LDA(At, 0, 0); PG8_STAGE(PG8_SA(1, 1), a1 + hstepA, voffA);
            PG8_WAIT_V(8); PG8_WAIT_L(0); PG8_BAR; PG8_MMA(0, 0, At, B0); PG8_MMA(0, 1, At, B1); PG8_BAR; PG8_SCHED;
            PG8_LDA(At, 0, 1); PG8_STAGE(PG8_SB(0, 0), b2, voffB); PG8_STAGE(PG8_SB(0, 1), b2 + hstepB, voffB); PG8_STAGE(PG8_SA(0, 0), a2, voffA);
            PG8_WAIT_V(8); PG8_WAIT_L(0); PG8_BAR; PG8_MMA(1, 0, At, B0); PG8_MMA(1, 1, At, B1); PG8_BAR; PG8_SCHED;
            PG8_LDB(B0, 1, 0); PG8_LDB(B1, 1, 1); PG8_SCHED; PG8_LDA(At, 1, 0); PG8_STAGE(PG8_SA(0, 1), a2 + hstepA, voffA);
            PG8_WAIT_V(8); PG8_WAIT_L(0); PG8_BAR; PG8_MMA(0, 0, At, B0); PG8_MMA(0, 1, At, B1); PG8_BAR; PG8_SCHED;
            PG8_LDA(At, 1, 1); PG8_STAGE(PG8_SB(1, 0), b3, voffB); PG8_STAGE(PG8_SB(1, 1), b3 + hstepB, voffB); PG8_STAGE(PG8_SA(1, 0), a3, voffA);
            PG8_WAIT_V(8); PG8_WAIT_L(0); PG8_BAR; PG8_MMA(1, 0, At, B0); PG8_MMA(1, 1, At, B1); PG8_BAR; PG8_SCHED;
        }
        if constexpr (ALIGN_EPI) { if (wr == 0) PG8_BAR; }
        {
            Unit ue = cur; int fr_e = fr, fq_e = fq; asm volatile("" : "+s"(ue.pm), "+s"(ue.pn), "+v"(fr_e), "+v"(fq_e));
            E(acc, ue, wr, wc, fr_e, fq_e); }
        if (!has_next) break;
#pragma unroll
        for (int a = 0; a < 2; ++a)
#pragma unroll
            for (int b = 0; b < 2; ++b)
#pragma unroll
                for (int m = 0; m < 4; ++m)
#pragma unroll
                    for (int n = 0; n < 2; ++n) acc[a][b][m][n] = (f32x4){0.f, 0.f, 0.f, 0.f};
        cur = nxt; cA = nA; cB = nB; ++ui;
        if constexpr (ALIGN_EPI) { if (wr == 1) PG8_BAR; }
    }
    PG8_WAIT_V(0);
    if constexpr (!ALIGN_EPI) { if (wr == 0) PG8_BAR; }
    PG8_BAR;
#undef PG8_SA
#undef PG8_SB
#undef PG8_STAGE
#undef PG8_LDA
#undef PG8_LDB
#undef PG8_MMA
#undef PG8_WAIT_V
#undef PG8_WAIT_L
#undef PG8_BAR
#undef PG8_SCHED
}
}

using pg8::Unit;
struct EpiSwiGLU {
    static constexpr bool PERM = true;
    bf16_t* H;
    __device__ __forceinline__ void operator()(const f32x4 (&acc)[2][2][4][2], const Unit& u, int wr, int wc, int fr, int fq) const {
        const int row0 = u.pm * 256 + wr * 64 + fr, col0 = u.pn * 128 + wc * 32 + 8 * fq;
#pragma unroll
        for (int ai = 0; ai < 2; ++ai)
#pragma unroll
            for (int m = 0; m < 4; ++m) {
                bf16_t* rowp = H + (size_t)(row0 + ai * 128 + m * 16) * D_FF + col0;
                const f32x4 g0 = acc[ai][0][m][0], g1 = acc[ai][0][m][1], u0 = acc[ai][1][m][0], u1 = acc[ai][1][m][1];
                u32x4 w;
                w.x = cvt_pk_bf16(siluf_(g0[0]) * u0[0], siluf_(g0[1]) * u0[1]); w.y = cvt_pk_bf16(siluf_(g0[2]) * u0[2], siluf_(g0[3]) * u0[3]);
                w.z = cvt_pk_bf16(siluf_(g1[0]) * u1[0], siluf_(g1[1]) * u1[1]); w.w = cvt_pk_bf16(siluf_(g1[2]) * u1[2], siluf_(g1[3]) * u1[3]);
                *(u32x4*)rowp = w;
            }
    }
};
struct EpiResid {
    static constexpr bool PERM = false;
    const float* res; float* out; float scale;
    __device__ __forceinline__ void operator()(const f32x4 (&acc)[2][2][4][2], const Unit& u, int wr, int wc, int fr, int fq) const {
        const int row0 = u.pm * 256 + wr * 64 + fr, col0 = u.pn * 256 + wc * 32 + 4 * fq;
#pragma unroll
        for (int ai = 0; ai < 2; ++ai)
#pragma unroll
            for (int m = 0; m < 4; ++m) {
                const size_t off = (size_t)(row0 + ai * 128 + m * 16) * D_MODEL + col0;
#pragma unroll
                for (int bj = 0; bj < 2; ++bj)
#pragma unroll
                    for (int n = 0; n < 2; ++n) { const f32x4 r = *(const f32x4*)(res + off + bj * 128 + n * 16); *(f32x4*)(out + off + bj * 128 + n * 16) = r * DN_ALPHA + acc[ai][bj][m][n] * scale; }
            }
    }
};
struct EpiInproj {
    static constexpr bool PERM = true;
    bf16_t *U5, *QKV, *Z, *LX, *LG; float* AB;
    __device__ __forceinline__ void operator()(const f32x4 (&acc)[2][2][4][2], const Unit& u, int wr, int wc, int fr, int fq) const {
        const int row0 = u.pm * 256 + wr * 64 + fr;
        const int pn = u.pn;
#pragma unroll
        for (int ai = 0; ai < 2; ++ai)
#pragma unroll
            for (int m = 0; m < 4; ++m) {
                const int row = row0 + ai * 128 + m * 16;
#pragma unroll
                for (int bj = 0; bj < 2; ++bj) {
                    const int c = pn * 256 + bj * 128 + wc * 32 + 8 * fq;
                    const f32x4 v0 = acc[ai][bj][m][0], v1 = acc[ai][bj][m][1];
                    if (pn == 22) {
                        if (bj == 0 && wc == 0 && fq < 2) { float* p = AB + (size_t)row * 16 + 8 * fq; *(f32x4*)p = v0; *(f32x4*)(p + 4) = v1; }
                    } else {
                        u32x4 w; w.x = cvt_pk_bf16(v0[0], v0[1]); w.y = cvt_pk_bf16(v0[2], v0[3]); w.z = cvt_pk_bf16(v1[0], v1[1]); w.w = cvt_pk_bf16(v1[2], v1[3]);
                        bf16_t* p;
                        if (pn < 2) { const int g = c >> 4, hf = c & 8; p = U5 + ((size_t)g * M_TOK + row) * 16 + hf; }
                        else if (pn < 14) p = QKV + (size_t)row * 3072 + (c - 512);
                        else if (pn < 18) p = Z + (size_t)row * 1024 + (c - 3584);
                        else if (pn < 20) p = LX + (size_t)row * 512 + (c - 4608);
                        else p = LG + (size_t)row * 512 + (c - 5120);
                        *(u32x4*)p = w;
                    }
                }
            }
    }
};
struct EpiS5S {
    static constexpr bool PERM = false;
    float* S;
    __device__ __forceinline__ void operator()(const f32x4 (&acc)[2][2][4][2], const Unit& u, int wr, int wc, int fr, int fq) const {
        const int g = u.pm, row0 = wr * 64 + fr, col0 = wc * 32 + 4 * fq;
#pragma unroll
        for (int ai = 0; ai < 2; ++ai)
#pragma unroll
            for (int m = 0; m < 4; ++m) { float* p = S + ((size_t)g * NCHT + row0 + ai * 128 + m * 16) * 128 + col0;
#pragma unroll
                for (int n = 0; n < 2; ++n) *(f32x4*)(p + n * 16) = acc[ai][0][m][n]; }
    }
};
struct EpiS5Intra {
    static constexpr bool PERM = false;
    float* Y;
    __device__ __forceinline__ void operator()(const f32x4 (&acc)[2][2][4][2], const Unit& u, int wr, int wc, int fr, int fq) const {
        const int g = u.pm, j = u.pn, row0 = wr * 64 + fr;
#pragma unroll
        for (int ai = 0; ai < 2; ++ai)
#pragma unroll
            for (int m = 0; m < 4; ++m) { const int bc = row0 + ai * 128 + m * 16;
#pragma unroll
                for (int bj = 0; bj < 2; ++bj)
#pragma unroll
                    for (int n = 0; n < 2; ++n) { const int col = j * 256 + bj * 128 + wc * 32 + 16 * n + 4 * fq, t = col >> 4, p = col & 15;
                        *(f32x4*)(Y + ((size_t)bc * CH + t) * S5_W + g * 16 + p) = acc[ai][bj][m][n]; }
            }
    }
};
struct EpiS5Inter {
    static constexpr bool PERM = false;
    const float* Y; const bf16_t* U5; const float* dvec; bf16_t* YACT;
    __device__ __forceinline__ void operator()(const f32x4 (&acc)[2][2][4][2], const Unit& u, int wr, int wc, int fr, int fq) const {
        const int g = u.pm, j = u.pn, row0 = wr * 64 + fr;
#pragma unroll
        for (int ai = 0; ai < 2; ++ai)
#pragma unroll
            for (int m = 0; m < 4; ++m) { const int bc = row0 + ai * 128 + m * 16;
#pragma unroll
                for (int bj = 0; bj < 2; ++bj)
#pragma unroll
                    for (int n = 0; n < 2; ++n) { const int col = j * 256 + bj * 128 + wc * 32 + 16 * n + 4 * fq, t = col >> 4, p = col & 15;
                        const size_t tok = (size_t)bc * CH + t; const int ch = g * 16 + p;
                        const f32x4 y0 = *(const f32x4*)(Y + tok * S5_W + ch);
                        const u32x2 uu = *(const u32x2*)(U5 + ((size_t)g * M_TOK + tok) * 16 + p);
                        const f32x4 d0 = *(const f32x4*)(dvec + ch);
                        const f32x4 a0 = acc[ai][bj][m][n];
                        const float o0 = gelu_tanh(a0[0] + y0[0] + d0[0] * bflo(uu.x)), o1 = gelu_tanh(a0[1] + y0[1] + d0[1] * bfhi(uu.x));
                        const float o2 = gelu_tanh(a0[2] + y0[2] + d0[2] * bflo(uu.y)), o3 = gelu_tanh(a0[3] + y0[3] + d0[3] * bfhi(uu.y));
                        u32x2 w; w.x = cvt_pk_bf16(o0, o1); w.y = cvt_pk_bf16(o2, o3);
                        *(u32x2*)(YACT + tok * S5_W + ch) = w; }
                asm volatile("" ::: "memory");
            }
    }
};
struct EpiGLU {
    static constexpr bool PERM = true;
    const bf16_t* YACT; const float* bglu; bf16_t* CAT;
    __device__ __forceinline__ void operator()(const f32x4 (&acc)[2][2][4][2], const Unit& u, int wr, int wc, int fr, int fq) const {
        const int row0 = u.pm * 256 + wr * 64 + fr;
#pragma unroll
        for (int ai = 0; ai < 2; ++ai)
#pragma unroll
            for (int m = 0; m < 4; ++m) { const size_t row = (size_t)(row0 + ai * 128 + m * 16);
#pragma unroll
                for (int bj = 0; bj < 2; ++bj) { const int col = u.pn * 256 + bj * 128 + wc * 32 + 8 * fq;
                    const u32x4 yy = *(const u32x4*)(YACT + row * S5_W + col);
                    const f32x4 b0 = *(const f32x4*)(bglu + col), b1 = *(const f32x4*)(bglu + col + 4);
                    const f32x4 a0 = acc[ai][bj][m][0] + b0, a1 = acc[ai][bj][m][1] + b1;
                    u32x4 w;
                    w.x = cvt_pk_bf16(bflo(yy.x) * sigmoidf_(a0[0]), bfhi(yy.x) * sigmoidf_(a0[1])); w.y = cvt_pk_bf16(bflo(yy.y) * sigmoidf_(a0[2]), bfhi(yy.y) * sigmoidf_(a0[3]));
                    w.z = cvt_pk_bf16(bflo(yy.z) * sigmoidf_(a1[0]), bfhi(yy.z) * sigmoidf_(a1[1])); w.w = cvt_pk_bf16(bflo(yy.w) * sigmoidf_(a1[2]), bfhi(yy.w) * sigmoidf_(a1[3]));
                    *(u32x4*)(CAT + row * D_MODEL + col) = w; }
            }
    }
};
struct EpiLRU {
    static constexpr bool PERM = true;
    const bf16_t* XC; const float *ba, *bx, *lam; float *LA, *LB;
    __device__ __forceinline__ void operator()(const f32x4 (&acc)[2][2][4][2], const Unit& u, int wr, int wc, int fr, int fq) const {
        const int row0 = u.pm * 256 + wr * 64 + fr, ch = u.pn * 128 + wc * 32 + 8 * fq;
        float sp[8], bav[8], bxv[8];
#pragma unroll
        for (int e = 0; e < 8; ++e) { sp[e] = -8.0f * softplusf_(-lam[ch + e]); bav[e] = ba[ch + e]; bxv[e] = bx[ch + e]; }
#pragma unroll
        for (int ai = 0; ai < 2; ++ai)
#pragma unroll
            for (int m = 0; m < 4; ++m) { const size_t row = (size_t)(row0 + ai * 128 + m * 16);
                const u32x4 xx = *(const u32x4*)(XC + row * LRU_W + ch);
                float xc[8] = {bflo(xx.x), bfhi(xx.x), bflo(xx.y), bfhi(xx.y), bflo(xx.z), bfhi(xx.z), bflo(xx.w), bfhi(xx.w)};
                float av[8], bv[8];
#pragma unroll
                for (int e = 0; e < 8; ++e) { const float ra = acc[ai][0][m][e >> 2][e & 3] + bav[e], rx = acc[ai][1][m][e >> 2][e & 3] + bxv[e];
                    const float r = sigmoidf_(ra), ig = sigmoidf_(rx), la = sp[e] * r; av[e] = __expf(la); bv[e] = sqrtf_(fmaxf(-expm1_neg(2.0f * la), 0.f)) * (ig * xc[e]); }
                *(f32x4*)(LA + row * LRU_W + ch) = (f32x4){av[0], av[1], av[2], av[3]}; *(f32x4*)(LA + row * LRU_W + ch + 4) = (f32x4){av[4], av[5], av[6], av[7]};
                *(f32x4*)(LB + row * LRU_W + ch) = (f32x4){bv[0], bv[1], bv[2], bv[3]}; *(f32x4*)(LB + row * LRU_W + ch + 4) = (f32x4){bv[4], bv[5], bv[6], bv[7]};
            }
    }
};

#define XB_TMO      128
#define XB_XCNT(j)  (256  + 64 * (j))
#define XB_XSUB(j)  (1280 + 64 * (j))
#define XB_XGEN(j)  (2304 + 64 * (j))
#define XB_TOP      3328
#define XB_TOPGEN   3392
#define XCD_BAR_WORDS 3456
#define XB_SPIN_CAP (1u << 22)
__device__ __forceinline__ unsigned xb_ld(unsigned* p)              { return __hip_atomic_load(p, __ATOMIC_RELAXED, __HIP_MEMORY_SCOPE_AGENT); }
__device__ __forceinline__ unsigned xb_add(unsigned* p, unsigned v) { return __hip_atomic_fetch_add(p, v, __ATOMIC_RELAXED, __HIP_MEMORY_SCOPE_AGENT); }
__device__ __forceinline__ unsigned xb_xcc_id() { return (unsigned)__builtin_amdgcn_s_getreg((3 << 11) | 20) & 0xFu; }
#define XB_SPIN(cond, bar) do { unsigned _sp = 0; while (cond) { __builtin_amdgcn_s_sleep(1); \
    if ((++_sp & 255u) == 0u) { if (xb_ld(&(bar)[XB_TMO])) break; if (_sp > XB_SPIN_CAP) { atomicAdd(&(bar)[XB_TMO], 1u); break; } } } } while (0)
struct XcdBarrier { unsigned* bar; unsigned x; volatile LAS unsigned* st; };
__device__ __forceinline__ XcdBarrier xcd_barrier_post(unsigned* bar, volatile LAS unsigned* st) {
    XcdBarrier b; b.bar = bar; b.x = xb_xcc_id(); b.st = st;
    if (threadIdx.x == 0) (void)xb_add(&bar[XB_XCNT(b.x)], 1u);
    return b;
}
__device__ __forceinline__ void xcd_barrier_complete(unsigned* bar, unsigned x, unsigned& nloc, unsigned& nx) {
    const unsigned G = gridDim.x * gridDim.y * gridDim.z;
    unsigned sum, cnt, mine, sp = 0u;
    for (;;) {
        sum = 0u; cnt = 0u; mine = 0u;
#pragma unroll
        for (unsigned j = 0; j < 16; ++j) { const unsigned c = xb_ld(&bar[XB_XCNT(j)]); sum += c; cnt += (c > 0u) ? 1u : 0u; mine = (j == x) ? c : mine; }
        if (sum == G) break;
        __builtin_amdgcn_s_sleep(1);
        if ((++sp & 255u) == 0u) { if (xb_ld(&bar[XB_TMO])) break; if (sp > XB_SPIN_CAP) { atomicAdd(&bar[XB_TMO], 1u); break; } }
    }
    nloc = mine > 0u ? mine : 1u; nx = cnt > 0u ? cnt : 1u;
}
__device__ __forceinline__ void xcd_barrier(const XcdBarrier& b) {
    asm volatile("s_waitcnt vmcnt(0)" ::: "memory");
    __syncthreads();
    if (threadIdx.x == 0) {
        unsigned* bar = b.bar; unsigned bx = b.x;
        __builtin_amdgcn_s_waitcnt(0);
        unsigned nloc = b.st[0], nx = b.st[1];
        if (nloc == 0u) { xcd_barrier_complete(bar, bx, nloc, nx); b.st[0] = nloc; b.st[1] = nx; }
        const unsigned old = xb_add(&bar[XB_XSUB(bx)], 1u);
        const unsigned gen = old / nloc;
        if (old + 1u == (gen + 1u) * nloc) {
            __builtin_amdgcn_fence(__ATOMIC_RELEASE, "agent");
            asm volatile("s_waitcnt vmcnt(0)" ::: "memory");
            const unsigned og = xb_add(&bar[XB_TOP], 1u);
            const unsigned tg = og / nx;
            if (og + 1u == (tg + 1u) * nx) xb_add(&bar[XB_TOPGEN], 1u);
            else XB_SPIN(xb_ld(&bar[XB_TOPGEN]) == tg, bar);
            __builtin_amdgcn_fence(__ATOMIC_ACQUIRE, "agent");
            xb_add(&bar[XB_XGEN(bx)], 1u);
            asm volatile("s_waitcnt vmcnt(0)" ::: "memory");
        } else {
            XB_SPIN(xb_ld(&bar[XB_XGEN(bx)]) == gen, bar);
            __builtin_amdgcn_fence(__ATOMIC_ACQUIRE, "agent");
            asm volatile("s_waitcnt vmcnt(0)" ::: "memory");
        }
    }
    __syncthreads();
}

__device__ __forceinline__ void sub_barrier(unsigned* cnt, unsigned target) {
    asm volatile("s_waitcnt vmcnt(0)" ::: "memory");
    __syncthreads();
    if (threadIdx.x == 0) {
        __builtin_amdgcn_fence(__ATOMIC_RELEASE, "agent");
        asm volatile("s_waitcnt vmcnt(0)" ::: "memory");
        (void)xb_add(cnt, 1u);
        unsigned sp = 0u; while (xb_ld(cnt) < target) { __builtin_amdgcn_s_sleep(1); if (++sp > XB_SPIN_CAP) break; }
        __builtin_amdgcn_fence(__ATOMIC_ACQUIRE, "agent");
        asm volatile("s_waitcnt vmcnt(0)" ::: "memory");
    }
    __syncthreads();
}

constexpr size_t al256(size_t x) { return (x + 255) & ~(size_t)255; }
constexpr size_t WS_CTL = 0, CTL_BYTES = 1u << 20;
constexpr size_t SZ_WGU = (size_t)2 * D_FF * D_MODEL * 2, SZ_WD = (size_t)D_MODEL * D_FF * 2, SZ_WIN = (size_t)N_IN_PAD * D_MODEL * 2, SZ_WOUT = (size_t)D_MODEL * D_MODEL * 2;
constexpr size_t WS_WGU1 = WS_CTL + CTL_BYTES, WS_WGU2 = WS_WGU1 + SZ_WGU, WS_WD1 = WS_WGU2 + SZ_WGU, WS_WD2 = WS_WD1 + SZ_WD, WS_WIN = WS_WD2 + SZ_WD, WS_WOUT = WS_WIN + SZ_WIN;
constexpr size_t WS_WGLU = WS_WOUT + SZ_WOUT, WS_WLRU = WS_WGLU + (size_t)512 * 512 * 2;
constexpr size_t WS_KTAB = WS_WLRU + (size_t)1024 * 512 * 2;
constexpr size_t WS_PTAB = WS_KTAB + (size_t)32 * 16 * 128 * 16 * 2;
constexpr size_t WS_QTAB = WS_PTAB + (size_t)32 * 256 * 1024 * 2;
constexpr size_t WS_XN = WS_QTAB + (size_t)32 * 1024 * 256 * 2;
constexpr size_t WS_H = WS_XN + (size_t)M_TOK * D_MODEL * 2;
constexpr size_t WS_U5 = WS_H + (size_t)M_TOK * D_FF * 2;
constexpr size_t WS_QKV = WS_U5 + (size_t)M_TOK * 512 * 2;
constexpr size_t WS_Z = WS_QKV + (size_t)M_TOK * 3072 * 2;
constexpr size_t WS_AB = WS_Z + (size_t)M_TOK * 1024 * 2;
constexpr size_t WS_LX = WS_AB + (size_t)M_TOK * 16 * 4;
constexpr size_t WS_LG = WS_LX + (size_t)M_TOK * 512 * 2;
constexpr size_t WS_XC = WS_LG + (size_t)M_TOK * 512 * 2;
constexpr int NUNIT = BATCH * GDN_H * NCH;
constexpr size_t WS_GU = WS_XC + (size_t)M_TOK * 512 * 2;
constexpr size_t WS_GW = WS_GU + (size_t)NUNIT * 64 * 128 * 4;
constexpr size_t WS_GQD = WS_GW + (size_t)NUNIT * 16384;
constexpr size_t WS_GKD = WS_GQD + (size_t)NUNIT * 16384;
constexpr size_t WS_GQK = WS_GKD + (size_t)NUNIT * 16384;
constexpr size_t WS_GL = WS_GQK + (size_t)NUNIT * 8192;
constexpr size_t WS_GO = WS_GL + al256((size_t)NUNIT * 4);
constexpr size_t WS_S5S = WS_GO + (size_t)M_TOK * 1024 * 4;
constexpr size_t WS_HEXT = WS_S5S + (size_t)32 * 256 * 128 * 4;
constexpr size_t WS_YIN = WS_HEXT + (size_t)4 * 32 * 256 * 256 * 2;
constexpr size_t WS_YACT = WS_YIN + (size_t)M_TOK * 512 * 4;
constexpr size_t WS_LA = WS_YACT + (size_t)M_TOK * 512 * 2;
constexpr size_t WS_LB = WS_LA + (size_t)M_TOK * 512 * 4;
constexpr size_t WS_CA = WS_LB + (size_t)M_TOK * 512 * 4;
constexpr size_t WS_CB = WS_CA + (size_t)NCHT * 512 * 4;
constexpr size_t WS_CIN = WS_CB + (size_t)NCHT * 512 * 4;
constexpr size_t WS_CAT = WS_CIN + (size_t)NCHT * 512 * 4;
constexpr size_t WS_END = WS_CAT + (size_t)M_TOK * D_MODEL * 2;
constexpr int CW_BAR = 4096, CW_SUB = 8192;

constexpr int RING_BYTES = 131072, LDSCTL_OFF = 155648, MISC_OFF = LDSCTL_OFF + 320, LDS_BYTES = 157696;
constexpr int NWAVES = 8;

struct Params { const float* in[36]; float* out; unsigned char* ws; };
typedef const __attribute__((address_space(4))) unsigned char* kptr_t;
__device__ __forceinline__ kptr_t karg_base() { kptr_t k = (kptr_t)__builtin_amdgcn_kernarg_segment_ptr(); asm volatile("" : "+s"(k)); return k; }
__device__ __forceinline__ const float* KIN(int i) { return *(const float* const __attribute__((address_space(4)))*)(karg_base() + 8 * i); }
__device__ __forceinline__ float* KOUT() { return *(float* const __attribute__((address_space(4)))*)(karg_base() + 8 * 36); }
__device__ __forceinline__ unsigned char* KWS() { return *(unsigned char* const __attribute__((address_space(4)))*)(karg_base() + 8 * 37); }
struct Frame {
    LAS unsigned char* lds; int tid, lane, wave, G, bid;
    __device__ __forceinline__ int gw() const { return bid * NWAVES + wave; }
    __device__ __forceinline__ int ngw() const { return G * NWAVES; }
    __device__ __forceinline__ int gt() const { return bid * (NWAVES * 64) + tid; }
    __device__ __forceinline__ int ngt() const { return G * NWAVES * 64; }
};
#define LDS_WAIT() asm volatile("s_waitcnt lgkmcnt(0)" ::: "memory")
__device__ __forceinline__ Frame fresh(const Frame& F0) { Frame F = F0; int w = F0.wave; asm volatile("" : "+s"(w)); int ln = (int)__builtin_amdgcn_mbcnt_hi(~0u, __builtin_amdgcn_mbcnt_lo(~0u, 0u)); asm volatile("" : "+v"(ln));
    F.wave = w; F.lane = ln; F.tid = w * 64 + ln;
    int b = blockIdx.x, g = gridDim.x; asm volatile("" : "+s"(b), "+s"(g)); F.bid = b; F.G = g; return F; }

#ifndef PROBE_TS_A
#define PROBE_TS_A -1
#endif
#ifndef PROBE_TS_B
#define PROBE_TS_B -1
#endif
#ifndef PROBE_TS_MULT
#define PROBE_TS_MULT 8
#endif
constexpr int CW_TS = 12288;
template <int L> __device__ __forceinline__ void STAMP(int slot, int blk) {
    if constexpr (PROBE_TS_A >= 0) { if (threadIdx.x == 0 && (int)blockIdx.x == blk && (slot == PROBE_TS_A || slot == PROBE_TS_B)) {
        unsigned long long* ts = (unsigned long long*)((unsigned*)(KWS() + WS_CTL) + CW_TS); __hip_atomic_store(ts + L * 32 + slot, __builtin_amdgcn_s_memrealtime(), __ATOMIC_RELAXED, __HIP_MEMORY_SCOPE_AGENT); } }
}
__device__ __forceinline__ void STAMPR(int l, int slot, int blk) {
    if constexpr (PROBE_TS_A >= 0) { if (threadIdx.x == 0 && (int)blockIdx.x == blk && (slot == PROBE_TS_A || slot == PROBE_TS_B)) {
        unsigned long long* ts = (unsigned long long*)((unsigned*)(KWS() + WS_CTL) + CW_TS); __hip_atomic_store(ts + l * 32 + slot, __builtin_amdgcn_s_memrealtime(), __ATOMIC_RELAXED, __HIP_MEMORY_SCOPE_AGENT); } }
}
__device__ __forceinline__ void probe_tail() {
    if constexpr (PROBE_TS_A >= 0) { if (threadIdx.x == 0 && blockIdx.x == 0) {
        unsigned long long* ts = (unsigned long long*)((unsigned*)(KWS() + WS_CTL) + CW_TS); unsigned long long tot = 0;
        for (int l = 0; l < DEPTH; ++l) { const unsigned long long a = __hip_atomic_load(ts + l * 32 + PROBE_TS_A, __ATOMIC_RELAXED, __HIP_MEMORY_SCOPE_AGENT), b = __hip_atomic_load(ts + l * 32 + PROBE_TS_B, __ATOMIC_RELAXED, __HIP_MEMORY_SCOPE_AGENT); if (b > a) tot += b - a; }
        tot *= PROBE_TS_MULT; if (tot > 40000000ull) tot = 40000000ull;
        const unsigned long long t0 = __builtin_amdgcn_s_memrealtime();
        while (__builtin_amdgcn_s_memrealtime() - t0 < tot) __builtin_amdgcn_s_sleep(32); } }
}

struct MapId { __device__ __forceinline__ int operator()(int n) const { return n; } };
struct MapGU { int half; __device__ __forceinline__ int operator()(int n) const { return 256 * (n >> 7) + 128 * half + (n & 127); } };
struct MapIn { __device__ __forceinline__ int operator()(int n) const { return n < 4608 ? n : (n < 4624 ? 5632 + (n - 4608) : n - 16); } };
template <int K, int N, class Map>
__device__ __forceinline__ void transpose_item(const float* W, bf16_t* WT, int item, int lane, const Map map) {
    constexpr int nblk = (N + 63) >> 6;
    const int kb = item / nblk, nb = item - kb * nblk, k0 = 64 * kb, n = 64 * nb + lane;
    if (n < N) {
        const float* p = W + (size_t)k0 * N + n;
        float v[64];
#pragma unroll
        for (int i = 0; i < 64; ++i) v[i] = p[(size_t)i * N];
        bf16_t* q = WT + (size_t)map(n) * K + k0;
#pragma unroll
        for (int j = 0; j < 8; ++j) { u32x4 o; o.x = cvt_pk_bf16(v[8 * j], v[8 * j + 1]); o.y = cvt_pk_bf16(v[8 * j + 2], v[8 * j + 3]); o.z = cvt_pk_bf16(v[8 * j + 4], v[8 * j + 5]); o.w = cvt_pk_bf16(v[8 * j + 6], v[8 * j + 7]);
            *(u32x4*)(q + 8 * j) = o; }
    }
}
__device__ __forceinline__ void cplx_pow(float lre, float lim, float dt, int d, float& zr, float& zi) {
    const float mag = __expf((float)d * lre * dt);
    const double rev = (double)d * ((double)dt * (double)lim) * 0.15915494309189535;
    const float r = (float)(rev - rint(rev));
    zr = mag * __builtin_amdgcn_cosf(r); zi = mag * __builtin_amdgcn_sinf(r);
}
__device__ __forceinline__ void s5_coef(float lre, float lim, float dt, float& cr, float& ci) {
    const float a = lre * dt; const double rev = ((double)dt * (double)lim) * 0.15915494309189535; const float r = (float)(rev - rint(rev));
    const float cb = __builtin_amdgcn_cosf(r), sb = __builtin_amdgcn_sinf(r), sh = __builtin_amdgcn_sinf(0.5f * r);
    const float er = expm1_neg(a) * cb - 2.0f * sh * sh, ei = __expf(a) * sb;
    const float den = rcpf_(lre * lre + lim * lim);
    cr = (er * lre + ei * lim) * den; ci = (ei * lre - er * lim) * den;
}
__device__ __forceinline__ void phase_convert(const Frame& F, int l) {
    unsigned char* ws = KWS();
    const int gw = F.gw(), NGW = F.ngw();
    constexpr int I_GU = (D_MODEL / 64) * (D_FF / 64), I_DN = (D_FF / 64) * (D_MODEL / 64), I_IN = (D_MODEL / 64) * ((D_IN + 63) / 64), I_OUT = (D_MODEL / 64) * (D_MODEL / 64), I_GLU = (512 / 64) * (512 / 64);
    constexpr int NITEMS = 4 * I_GU + 2 * I_DN + I_IN + I_OUT + I_GLU;
    const size_t oGU = (size_t)l * D_MODEL * D_FF, oIN = (size_t)l * D_MODEL * D_IN, oOUT = (size_t)l * D_MODEL * D_MODEL, oGLU = (size_t)l * 512 * 512;
    for (int it = gw; it < NITEMS; it += NGW) {
        int r = it;
        if (r < I_GU) { transpose_item<D_MODEL, D_FF>(KIN(1) + oGU, (bf16_t*)(ws + WS_WGU1), r, F.lane, MapGU{0}); continue; } r -= I_GU;
        if (r < I_GU) { transpose_item<D_MODEL, D_FF>(KIN(2) + oGU, (bf16_t*)(ws + WS_WGU1), r, F.lane, MapGU{1}); continue; } r -= I_GU;
        if (r < I_DN) { transpose_item<D_FF, D_MODEL>(KIN(3) + oGU, (bf16_t*)(ws + WS_WD1), r, F.lane, MapId{}); continue; } r -= I_DN;
        if (r < I_GU) { transpose_item<D_MODEL, D_FF>(KIN(31) + oGU, (bf16_t*)(ws + WS_WGU2), r, F.lane, MapGU{0}); continue; } r -= I_GU;
        if (r < I_GU) { transpose_item<D_MODEL, D_FF>(KIN(32) + oGU, (bf16_t*)(ws + WS_WGU2), r, F.lane, MapGU{1}); continue; } r -= I_GU;
        if (r < I_DN) { transpose_item<D_FF, D_MODEL>(KIN(33) + oGU, (bf16_t*)(ws + WS_WD2), r, F.lane, MapId{}); continue; } r -= I_DN;
        if (r < I_IN) { transpose_item<D_MODEL, D_IN>(KIN(6) + oIN, (bf16_t*)(ws + WS_WIN), r, F.lane, MapIn{}); continue; } r -= I_IN;
        if (r < I_OUT) { transpose_item<D_MODEL, D_MODEL>(KIN(28) + oOUT, (bf16_t*)(ws + WS_WOUT), r, F.lane, MapId{}); continue; } r -= I_OUT;
        transpose_item<512, 512>(KIN(15) + oGLU, (bf16_t*)(ws + WS_WGLU), r, F.lane, MapId{});
    }
    STAMPR(l, 25, 40);
    const int gt = F.gt(), NGT = F.ngt();
    { const float* wa = KIN(23) + (size_t)l * 8 * 64 * 64; const float* wx = KIN(25) + (size_t)l * 8 * 64 * 64; bf16_t* WL = (bf16_t*)(ws + WS_WLRU);
      for (int idx = gt; idx < 1024 * 512; idx += NGT) { const int row = idx >> 9, k = idx & 511, pn = row >> 8, bj = (row >> 7) & 1, j = row & 127, c = 128 * pn + j, h = c >> 6;
          float v = 0.f; if ((k >> 6) == h) v = (bj ? wx : wa)[(h * 64 + (k & 63)) * 64 + (c & 63)];
          WL[idx] = (bf16_t)f2bf(v); } }
    STAMPR(l, 26, 40);
    if (F.G == 256) {
        __syncthreads();
        const float* lre_ = KIN(7) + l * 2048; const float* lim_ = KIN(8) + l * 2048; const float* bre = KIN(9) + (size_t)l * 32768; const float* bim = KIN(10) + (size_t)l * 32768;
        const float* cre = KIN(11) + (size_t)l * 32768; const float* cim = KIN(12) + (size_t)l * 32768; const float* lstep = KIN(14) + l * 32;
        const int g = F.bid & 31, sl8 = F.bid >> 5, tid = F.tid;
        LAS float* PW = (LAS float*)F.lds;
        LAS float* LB = PW + 64 * 18;
        LAS float* CF = LB + 128;
        const float dt = __expf(lstep[g]);
        for (int e = tid; e < 64 * 9; e += 512) { const int n = e / 9, k = e - 9 * n; const float lre = fminf(lre_[g * 64 + n], -1e-4f), lim = lim_[g * 64 + n];
            float zr, zi; cplx_pow(lre, lim, dt, 8 * k, zr, zi); PW[e * 2] = zr; PW[e * 2 + 1] = zi; }
        if (tid < 64) { const float lre = fminf(lre_[g * 64 + tid], -1e-4f), lim = lim_[g * 64 + tid]; float ar, ai, cr, ci; cplx_pow(lre, lim, dt, 1, ar, ai); s5_coef(lre, lim, dt, cr, ci);
            LB[2 * tid] = ar; LB[2 * tid + 1] = ai; CF[2 * tid] = cr; CF[2 * tid + 1] = ci; }
        LAS float* BR = CF + 128; LAS float* BI = BR + 1024; LAS float* CR = BI + 1024; LAS float* CI = CR + 1024;
        for (int e = tid; e < 1024; e += 512) { BR[e] = bre[g * 1024 + e]; BI[e] = bim[g * 1024 + e]; CR[e] = cre[g * 1024 + e]; CI[e] = cim[g * 1024 + e]; }
        __syncthreads();
        bf16_t* KT = (bf16_t*)(ws + WS_KTAB); bf16_t* PT = (bf16_t*)(ws + WS_PTAB); bf16_t* QT = (bf16_t*)(ws + WS_QTAB);
        if (tid < 256) {
            const int it = sl8 * 256 + tid, q = it & 15, d8 = (it >> 4) & 7, p = it >> 7;
            float acc[8];
#pragma unroll
            for (int dd = 0; dd < 8; ++dd) acc[dd] = 0.f;
            for (int n = 0; n < 64; ++n) { const float zr = PW[(n * 9 + d8) * 2], zi = PW[(n * 9 + d8) * 2 + 1], ar = LB[2 * n], ai = LB[2 * n + 1], cr = CF[2 * n], ci = CF[2 * n + 1];
                const float br = BR[n * 16 + q], bi = BI[n * 16 + q];
                const float bbr = cr * br - ci * bi, bbi = cr * bi + ci * br;
                float wr_ = zr * bbr - zi * bbi, wi_ = zr * bbi + zi * bbr;
                const float c_r = CR[p * 64 + n], c_i = CI[p * 64 + n];
#pragma unroll
                for (int dd = 0; dd < 8; ++dd) { acc[dd] += c_r * wr_ - c_i * wi_; const float t = wr_ * ar - wi_ * ai; wi_ = wr_ * ai + wi_ * ar; wr_ = t; } }
#pragma unroll
            for (int dd = 0; dd < 8; ++dd) KT[(((size_t)g * 16 + p) * 128 + (63 - 8 * d8 - dd)) * 16 + q] = (bf16_t)f2bf(acc[dd]);
        }
#pragma unroll
        for (int rep = 0; rep < 2; ++rep) {
            const int it = sl8 * 1024 + rep * 512 + tid, q = it & 15, s8 = (it >> 4) & 7, n = it >> 7;
            const float zr = PW[(n * 9 + (7 - s8)) * 2], zi = PW[(n * 9 + (7 - s8)) * 2 + 1], ar = LB[2 * n], ai = LB[2 * n + 1], cr = CF[2 * n], ci = CF[2 * n + 1];
            const float br = BR[n * 16 + q], bi = BI[n * 16 + q];
            const float bbr = cr * br - ci * bi, bbi = cr * bi + ci * br;
            float wr_ = zr * bbr - zi * bbi, wi_ = zr * bbi + zi * bbr;
#pragma unroll
            for (int ss = 7; ss >= 0; --ss) { const int s_ = 8 * s8 + ss;
                PT[((size_t)g * 256 + 2 * n) * 1024 + s_ * 16 + q] = (bf16_t)f2bf(wr_); PT[((size_t)g * 256 + 2 * n + 1) * 1024 + s_ * 16 + q] = (bf16_t)f2bf(wi_);
                const float t = wr_ * ar - wi_ * ai; wi_ = wr_ * ai + wi_ * ar; wr_ = t; }
        }
#pragma unroll
        for (int rep = 0; rep < 2; ++rep) {
            const int it = sl8 * 1024 + rep * 512 + tid, n = it & 63, t8 = (it >> 6) & 7, p = it >> 9;
            const float ar = LB[2 * n], ai = LB[2 * n + 1]; const float z0r = PW[(n * 9 + t8) * 2], z0i = PW[(n * 9 + t8) * 2 + 1];
            const float zr = z0r * ar - z0i * ai, zi = z0r * ai + z0i * ar;
            const float c_r = CR[p * 64 + n], c_i = CI[p * 64 + n];
            float wr_ = c_r * zr - c_i * zi, wi_ = c_r * zi + c_i * zr;
#pragma unroll
            for (int tt = 0; tt < 8; ++tt) { const int t = 8 * t8 + tt;
                *(unsigned*)(QT + ((size_t)g * 1024 + t * 16 + p) * 256 + 2 * n) = cvt_pk_bf16(wr_, -wi_);
                const float tmp = wr_ * ar - wi_ * ai; wi_ = wr_ * ai + wi_ * ar; wr_ = tmp; }
        }
        if (l == 0) {
            for (int idx = gt; idx < 32 * 16 * 64 * 2; idx += NGT) { const int gp = idx >> 7, r = idx & 127; *(u32x4*)(KT + ((size_t)gp * 128 + 64) * 16 + r * 8) = (u32x4){0u, 0u, 0u, 0u}; }
            for (int idx = gt; idx < 32 * 1024 * 16; idx += NGT) { const int row = idx >> 4, r = idx & 15; *(u32x4*)(QT + (size_t)row * 256 + 128 + r * 8) = (u32x4){0u, 0u, 0u, 0u}; } }
        __syncthreads();
    }
    STAMPR(l, 27, 40);
}
__device__ __forceinline__ void phase_x_to_bf16(const Frame& F, const float* x, bf16_t* XN) {
    const size_t n8 = (size_t)M_TOK * D_MODEL / 8;
    for (size_t i = F.gt(); i < n8; i += F.ngt()) { const f32x4 a = *(const f32x4*)(x + i * 8), b = *(const f32x4*)(x + i * 8 + 4);
        u32x4 w; w.x = cvt_pk_bf16(a[0], a[1]); w.y = cvt_pk_bf16(a[2], a[3]); w.z = cvt_pk_bf16(b[0], b[1]); w.w = cvt_pk_bf16(b[2], b[3]); *(u32x4*)(XN + i * 8) = w; }
}
__device__ __forceinline__ void phase_ln(const Frame& F, float* X, const float* gam, const float* bet, bf16_t* XN) {
    f32x4 gv[8], bv[8];
#pragma unroll
    for (int j = 0; j < 8; ++j) { gv[j] = *(const f32x4*)(gam + 4 * F.lane + 256 * j); bv[j] = *(const f32x4*)(bet + 4 * F.lane + 256 * j); }
    for (int m = F.gw(); m < M_TOK; m += F.ngw()) {
        float* xr = X + (size_t)m * D_MODEL + 4 * F.lane; f32x4 v[8]; float s = 0.f;
#pragma unroll
        for (int j = 0; j < 8; ++j) { v[j] = *(const f32x4*)(xr + 256 * j); s += (v[j][0] + v[j][1]) + (v[j][2] + v[j][3]); }
        const float mean = wave_sum(s) * (1.f / D_MODEL); float s2 = 0.f;
#pragma unroll
        for (int j = 0; j < 8; ++j) { v[j] = v[j] - mean; s2 += (v[j][0] * v[j][0] + v[j][1] * v[j][1]) + (v[j][2] * v[j][2] + v[j][3] * v[j][3]); }
        const float rstd = rsqf_(wave_sum(s2) * (1.f / D_MODEL) + LN_EPS);
        bf16_t* xo = XN + (size_t)m * D_MODEL + 4 * F.lane;
#pragma unroll
        for (int j = 0; j < 8; ++j) { const f32x4 o = v[j] * rstd * gv[j] + bv[j]; *(f32x4*)(xr + 256 * j) = o;
            u32x2 w; w.x = cvt_pk_bf16(o[0], o[1]); w.y = cvt_pk_bf16(o[2], o[3]); *(u32x2*)(xo + 256 * j) = w; }
    }
}

__device__ __forceinline__ void phase_lru_conv(const Frame& F, const bf16_t* LX, const float* cw, const float* cb, bf16_t* XC) {
    const int nitems = M_TOK * 64;
    for (int it = F.gt(); it < nitems; it += F.ngt()) {
        const int row = it >> 6, c8 = (it & 63) * 8, t = row & (SEQ - 1);
        float acc[8];
#pragma unroll
        for (int e = 0; e < 8; ++e) acc[e] = cb[c8 + e];
#pragma unroll
        for (int k = 0; k < 4; ++k) { const int dt_ = 3 - k; if (t - dt_ >= 0) {
                const u32x4 xx = *(const u32x4*)(LX + (size_t)(row - dt_) * LRU_W + c8);
                const f32x4 w0 = *(const f32x4*)(cw + k * LRU_W + c8), w1 = *(const f32x4*)(cw + k * LRU_W + c8 + 4);
                acc[0] += w0[0] * bflo(xx.x); acc[1] += w0[1] * bfhi(xx.x); acc[2] += w0[2] * bflo(xx.y); acc[3] += w0[3] * bfhi(xx.y);
                acc[4] += w1[0] * bflo(xx.z); acc[5] += w1[1] * bfhi(xx.z); acc[6] += w1[2] * bflo(xx.w); acc[7] += w1[3] * bfhi(xx.w); } }
        u32x4 w; w.x = cvt_pk_bf16(acc[0], acc[1]); w.y = cvt_pk_bf16(acc[2], acc[3]); w.z = cvt_pk_bf16(acc[4], acc[5]); w.w = cvt_pk_bf16(acc[6], acc[7]);
        *(u32x4*)(XC + (size_t)row * LRU_W + c8) = w;
    }
}
__device__ __forceinline__ void lru_p1_tile(int tid, int pm, int pn, const float* LA, const float* LB, float* CA, float* CB) {
    const int bc = pm * 4 + (tid >> 7), ch = pn * 128 + (tid & 127); const size_t base = (size_t)bc * CH * LRU_W + ch;
    float A = 1.f, B = 0.f;
#pragma unroll 16
    for (int t = 0; t < CH; ++t) { const float a = LA[base + (size_t)t * LRU_W], b = LB[base + (size_t)t * LRU_W]; B = a * B + b; A *= a; }
    CA[bc * LRU_W + ch] = A; CB[bc * LRU_W + ch] = B;
}
__device__ __forceinline__ void phase_lru_p3(int gt, int ngt, const float* LA, const float* LB, const float* CA, const float* CB, const bf16_t* LG, bf16_t* CAT) {
    for (int it = gt; it < NCHT * LRU_W; it += ngt) {
        const int bc = it >> 9, ch = it & 511, b = bc >> 7, c = bc & (NCH - 1); const size_t row0 = (size_t)bc * CH;
        float h = 0.f;
        for (int c0 = 0; c0 < c; c0 += 8) { float av[8], bv[8];
#pragma unroll
            for (int k = 0; k < 8; ++k) { const int cc = (c0 + k < c) ? c0 + k : c - 1; const int o = (b * NCH + cc) * LRU_W + ch; av[k] = CA[o]; bv[k] = CB[o]; }
#pragma unroll
            for (int k = 0; k < 8; ++k) if (c0 + k < c) h = av[k] * h + bv[k]; }
#pragma unroll 8
        for (int t = 0; t < CH; ++t) { const size_t row = row0 + t; h = LA[row * LRU_W + ch] * h + LB[row * LRU_W + ch];
            const float gt_ = bf2f(LG[row * LRU_W + ch]); CAT[row * D_MODEL + 1536 + ch] = (bf16_t)f2bf(h * gelu_tanh(gt_)); }
    }
}

__device__ __forceinline__ void s5_carry_group(int g, int tix, const float* lre_, const float* lim_, const float* lstep, const float* S5S, bf16_t* HEXT) {
    if (tix >= BATCH * 64) return;
    const int b = tix >> 6, n = tix & 63;
    const float dt = __expf(lstep[g]); const float lre = fminf(lre_[g * 64 + n], -1e-4f), lim = lim_[g * 64 + n];
    float ar, ai; cplx_pow(lre, lim, dt, 64, ar, ai);
    float hr = 0.f, hi = 0.f;
    for (int c0 = 0; c0 < NCH; c0 += 16) {
        f32x2 sv[16];
#pragma unroll
        for (int k = 0; k < 16; ++k) sv[k] = *(const f32x2*)(S5S + ((size_t)g * NCHT + b * NCH + c0 + k) * 128 + 2 * n);
#pragma unroll
        for (int k = 0; k < 16; ++k) { const size_t rowi = (size_t)g * NCHT + b * NCH + c0 + k;
            *(unsigned*)(HEXT + rowi * 256 + 2 * n) = cvt_pk_bf16(hr, hi); *(unsigned*)(HEXT + rowi * 256 + 128 + 2 * n) = 0u;
            const float nr = ar * hr - ai * hi + sv[k][0], ni = ar * hi + ai * hr + sv[k][1]; hr = nr; hi = ni; } }
}

__device__ __forceinline__ int fragoff(int m, int k, int KS) { const int idx = k & 31, g = (idx & 15) >> 2, j = (idx & 3) + 4 * (idx >> 4); return ((((m >> 4) * KS + (k >> 5)) * 64) + 16 * g + (m & 15)) * 8 + j; }
__device__ __forceinline__ bf16x8 ldsfrag(LAS unsigned char* lds, int base, int stride, int row0, int k0, int lane) { return *(const LAS bf16x8*)(lds + base + (row0 + (lane & 15)) * stride + (k0 + 8 * (lane >> 4)) * 2); }
typedef short v4i16_t __attribute__((ext_vector_type(4)));
__device__ __forceinline__ bf16x8 ldstr(LAS unsigned char* lds, int base, int stride, int row_lo, int row_hi, int col0, int lane) {
#if defined(TR_SLOW)
    const int n = lane & 15; bf16x8 r;
#pragma unroll
    for (int j = 0; j < 4; ++j) { r[j] = *(const LAS short*)(lds + base + (row_lo + j) * stride + (col0 + n) * 2); r[4 + j] = *(const LAS short*)(lds + base + (row_hi + j) * stride + (col0 + n) * 2); }
    return r;
#else
    const int q = (lane & 15) >> 2, p = lane & 3;
    const v4i16_t lo = __builtin_amdgcn_ds_read_tr16_b64_v4i16((LAS v4i16_t*)(lds + base + (row_lo + q) * stride + (col0 + 4 * p) * 2));
    const v4i16_t hi = __builtin_amdgcn_ds_read_tr16_b64_v4i16((LAS v4i16_t*)(lds + base + (row_hi + q) * stride + (col0 + 4 * p) * 2));
    return (bf16x8){lo[0], lo[1], lo[2], lo[3], hi[0], hi[1], hi[2], hi[3]};
#endif
}
__device__ __forceinline__ bf16x8 pack2(const f32x4& a, const f32x4& b) { u32x4 w; w.x = cvt_pk_bf16(a[0], a[1]); w.y = cvt_pk_bf16(a[2], a[3]); w.z = cvt_pk_bf16(b[0], b[1]); w.w = cvt_pk_bf16(b[2], b[3]); return __builtin_bit_cast(bf16x8, w); }
constexpr int GP_QS = 0, GP_KS = 18432, GP_KB = 36864, GP_KD = 55296, GP_VB = 73728, GP_QD = 92160, GP_MF = 110592, GP_TB = 126976, GP_MISC = 137216, GP_TMP = GP_MISC + 1024, GP_RS = 288;
__device__ __forceinline__ void gdn_prep_unit(const Frame& F, int l, int unit) {
    unsigned char* ws = KWS(); LAS unsigned char* lds = F.lds;
    const int tid = F.tid, lane = F.lane, wave = F.wave;
    const int c = unit & (NCH - 1), bh = unit >> 7, h = bh & 7, b = bh >> 3, t0 = c * CH; const size_t tok0 = (size_t)b * SEQ + t0;
    const bf16_t* QKV = (const bf16_t*)(ws + WS_QKV); const float* AB = (const float*)(ws + WS_AB);
    LAS float* gcs = (LAS float*)(lds + GP_MISC); LAS float* betas = gcs + 64; LAS float* egs = gcs + 128; LAS float* egls = gcs + 192;
    LAS float* Mf = (LAS float*)(lds + GP_MF); LAS float* Xf = (LAS float*)(lds + GP_KS); LAS float* Tmp = (LAS float*)(lds + GP_TMP);
    if (wave == 0) {
        const float al = AB[(tok0 + lane) * 16 + h], bl = AB[(tok0 + lane) * 16 + 8 + h];
        float g = -__expf(KIN(18)[l * 8 + h]) * softplusf_(al + KIN(19)[l * 8 + h]);
#pragma unroll
        for (int o = 1; o < 64; o <<= 1) { const float t = __shfl_up(g, o); if (lane >= o) g += t; }
        const float glast = __shfl(g, 63);
        gcs[lane] = g; betas[lane] = sigmoidf_(bl); egs[lane] = __expf(g); egls[lane] = __expf(glast - g);
        if (lane == 0) ((float*)(ws + WS_GL))[unit] = __expf(glast);
    }
    __syncthreads();
    {
        const float* convw = KIN(17) + (size_t)l * 4 * 3072;
        const int cg = lane & 15, rl = lane >> 4;
#pragma unroll
        for (int pass = 0; pass < 2; ++pass) {
            const int i = wave * 8 + pass * 4 + rl, tt = t0 + i;
            float y[3][8];
#pragma unroll
            for (int sg = 0; sg < 3; ++sg) {
                const int col = sg * 1024 + h * 128 + 8 * cg;
#pragma unroll
                for (int e = 0; e < 8; ++e) y[sg][e] = 0.f;
#pragma unroll
                for (int k = 0; k < 4; ++k) {
                    u32x4 xx = (u32x4){0u, 0u, 0u, 0u};
                    if (tt - (3 - k) >= 0) xx = *(const u32x4*)(QKV + (tok0 + i - (3 - k)) * 3072 + col);
                    const f32x4 w0 = *(const f32x4*)(convw + k * 3072 + col), w1 = *(const f32x4*)(convw + k * 3072 + col + 4);
                    y[sg][0] += w0[0] * bflo(xx.x); y[sg][1] += w0[1] * bfhi(xx.x); y[sg][2] += w0[2] * bflo(xx.y); y[sg][3] += w0[3] * bfhi(xx.y);
                    y[sg][4] += w1[0] * bflo(xx.z); y[sg][5] += w1[1] * bfhi(xx.z); y[sg][6] += w1[2] * bflo(xx.w); y[sg][7] += w1[3] * bfhi(xx.w);
                }
#pragma unroll
                for (int e = 0; e < 8; ++e) y[sg][e] = siluf_(y[sg][e]);
            }
            float ssq = 0.f, ssk = 0.f;
#pragma unroll
            for (int e = 0; e < 8; ++e) { ssq += y[0][e] * y[0][e]; ssk += y[1][e] * y[1][e]; }
            ssq = row16_sum(ssq); ssk = row16_sum(ssk);
            const float rq = rsqf_(ssq + RMS_EPS) * 0.08838834764831845f, rk = rsqf_(ssk + RMS_EPS);
            const float be = betas[i], eg = egs[i], egl = egls[i];
            float q[8], kk_[8];
#pragma unroll
            for (int e = 0; e < 8; ++e) { q[e] = y[0][e] * rq; kk_[e] = y[1][e] * rk; }
            const int ro = i * GP_RS + cg * 16;
#define PK8(a, sc) (u32x4){cvt_pk_bf16(a[0] * (sc), a[1] * (sc)), cvt_pk_bf16(a[2] * (sc), a[3] * (sc)), cvt_pk_bf16(a[4] * (sc), a[5] * (sc)), cvt_pk_bf16(a[6] * (sc), a[7] * (sc))}
            *(LAS u32x4*)(lds + GP_QS + ro) = PK8(q, 1.0f);
            *(LAS u32x4*)(lds + GP_KS + ro) = PK8(kk_, 1.0f);
            *(LAS u32x4*)(lds + GP_KB + ro) = PK8(kk_, be * eg);
            *(LAS u32x4*)(lds + GP_KD + ro) = PK8(kk_, egl);
            *(LAS u32x4*)(lds + GP_VB + ro) = PK8(y[2], be);
            *(LAS u32x4*)(lds + GP_QD + ro) = PK8(q, eg);
#undef PK8
        }
    }
    __syncthreads();
    {
        u32x4* dq = (u32x4*)(ws + WS_GQD + (size_t)unit * 16384);
#pragma unroll
        for (int rep = 0; rep < 2; ++rep) { const int e = tid + 512 * rep, f = e >> 6, ln = e & 63, i4 = f >> 2, s4 = f & 3, r = ln & 15, g = ln >> 4;
            const u32x2 lo = *(const LAS u32x2*)(lds + GP_QD + (16 * i4 + r) * GP_RS + (32 * s4 + 4 * g) * 2), hi = *(const LAS u32x2*)(lds + GP_QD + (16 * i4 + r) * GP_RS + (32 * s4 + 16 + 4 * g) * 2);
            dq[e] = (u32x4){lo.x, lo.y, hi.x, hi.y}; }
    }
    {
        u32x4* dk = (u32x4*)(ws + WS_GKD + (size_t)unit * 16384);
#pragma unroll
        for (int s2 = 0; s2 < 2; ++s2) { const int G = lane >> 4;
            const bf16x8 fr = ldstr(lds, GP_KD, GP_RS, 32 * s2 + 4 * G, 32 * s2 + 16 + 4 * G, 16 * wave, lane);
            dk[(wave * 2 + s2) * 64 + lane] = __builtin_bit_cast(u32x4, fr); }
    }
    {
        const int it = wave >> 1, s2 = wave & 1;
        f32x4 kk[2], qk[2];
#pragma unroll
        for (int jj = 0; jj < 2; ++jj) { kk[jj] = (f32x4){0.f, 0.f, 0.f, 0.f}; qk[jj] = (f32x4){0.f, 0.f, 0.f, 0.f}; }
#pragma unroll
        for (int s = 0; s < 4; ++s) { const bf16x8 bK = ldsfrag(lds, GP_KS, GP_RS, 16 * it, 32 * s, lane), bQ = ldsfrag(lds, GP_QS, GP_RS, 16 * it, 32 * s, lane);
#pragma unroll
            for (int jj = 0; jj < 2; ++jj) { const bf16x8 aK = ldsfrag(lds, GP_KS, GP_RS, 16 * (2 * s2 + jj), 32 * s, lane);
                kk[jj] = __builtin_amdgcn_mfma_f32_16x16x32_bf16(aK, bK, kk[jj], 0, 0, 0); qk[jj] = __builtin_amdgcn_mfma_f32_16x16x32_bf16(aK, bQ, qk[jj], 0, 0, 0); } }
        const int i = 16 * it + (lane & 15); const float gci = gcs[i], bei = betas[i];
        f32x4 qm[2];
#pragma unroll
        for (int jj = 0; jj < 2; ++jj) { f32x4 mrow;
#pragma unroll
            for (int r = 0; r < 4; ++r) { const int j = 16 * (2 * s2 + jj) + 4 * (lane >> 4) + r;
                const float dec = (i >= j) ? __expf(gci - gcs[j]) : 0.f;
                mrow[r] = (i > j) ? bei * kk[jj][r] * dec : 0.f; qm[jj][r] = qk[jj][r] * dec; }
            *(LAS f32x4*)(Mf + i * 64 + 16 * (2 * s2 + jj) + 4 * (lane >> 4)) = mrow; }
        ((u32x4*)(ws + WS_GQK + (size_t)unit * 8192))[(it * 2 + s2) * 64 + lane] = __builtin_bit_cast(u32x4, pack2(qm[0], qm[1]));
    }
    __syncthreads();
    {   for (int e = tid; e < 6 * 256; e += 512) { const int blk = e >> 8, i = (e >> 4) & 15, j = e & 15; const int br = blk < 3 ? 0 : (blk < 5 ? 1 : 2), bc = blk < 3 ? blk + 1 : (blk < 5 ? blk - 1 : 3);
            Xf[(16 * br + i) * 64 + 16 * bc + j] = 0.f; }
        if (wave == 0) { const int bb = lane >> 4, cc = lane & 15; float x[16];
#pragma unroll
            for (int i = 0; i < 16; ++i) { float s_ = (i == cc) ? 1.f : 0.f;
#pragma unroll
                for (int j = 0; j < i; ++j) s_ -= Mf[(16 * bb + i) * 64 + 16 * bb + j] * x[j];
                x[i] = s_; }
#pragma unroll
            for (int i = 0; i < 16; ++i) Xf[(16 * bb + i) * 64 + 16 * bb + cc] = x[i]; }
    }
    __syncthreads();
    { const int pr = tid >> 8, i = (tid >> 4) & 15, j = tid & 15, lo = 32 * pr, hi = lo + 16; float s_ = 0.f;
#pragma unroll
      for (int k = 0; k < 16; ++k) s_ += Mf[(hi + i) * 64 + lo + k] * Xf[(lo + k) * 64 + lo + j];
      Tmp[pr * 256 + i * 16 + j] = s_; }
    __syncthreads();
    { const int pr = tid >> 8, i = (tid >> 4) & 15, j = tid & 15, lo = 32 * pr, hi = lo + 16; float s_ = 0.f;
#pragma unroll
      for (int k = 0; k < 16; ++k) s_ += Xf[(hi + i) * 64 + hi + k] * Tmp[pr * 256 + k * 16 + j];
      Xf[(hi + i) * 64 + lo + j] = -s_; }
    __syncthreads();
#pragma unroll
    for (int rep = 0; rep < 2; ++rep) { const int e = tid + 512 * rep, i = e >> 5, j = e & 31; float s_ = 0.f;
#pragma unroll 8
        for (int k = 0; k < 32; ++k) s_ += Mf[(32 + i) * 64 + k] * Xf[k * 64 + j];
        Tmp[i * 32 + j] = s_; }
    __syncthreads();
#pragma unroll
    for (int rep = 0; rep < 2; ++rep) { const int e = tid + 512 * rep, i = e >> 5, j = e & 31; float s_ = 0.f;
#pragma unroll 8
        for (int k = 0; k < 32; ++k) s_ += Xf[(32 + i) * 64 + 32 + k] * Tmp[k * 32 + j];
        Xf[(32 + i) * 64 + j] = -s_; }
    __syncthreads();
    { const int row = tid >> 3, c0 = (tid & 7) * 8; const LAS float* sp = Xf + row * 64 + c0;
      u32x4 w; w.x = cvt_pk_bf16(sp[0], sp[1]); w.y = cvt_pk_bf16(sp[2], sp[3]); w.z = cvt_pk_bf16(sp[4], sp[5]); w.w = cvt_pk_bf16(sp[6], sp[7]);
      *(LAS u32x4*)(lds + GP_TB + row * 160 + c0 * 2) = w; }
    __syncthreads();
    {
        float* GU = (float*)(ws + WS_GU); const int G = lane >> 4;
        bf16x8 tb[4][2];
#pragma unroll
        for (int i = 0; i < 4; ++i)
#pragma unroll
            for (int s = 0; s < 2; ++s) tb[i][s] = ldsfrag(lds, GP_TB, 160, 16 * i, 32 * s, lane);
        bf16x8 vbf[2];
#pragma unroll
        for (int s = 0; s < 2; ++s) vbf[s] = ldstr(lds, GP_VB, GP_RS, 32 * s + 8 * G, 32 * s + 8 * G + 4, 16 * wave, lane);
#pragma unroll
        for (int i = 0; i < 4; ++i) { f32x4 au = (f32x4){0.f, 0.f, 0.f, 0.f};
#pragma unroll
            for (int s = 0; s < 2; ++s) au = __builtin_amdgcn_mfma_f32_16x16x32_bf16(tb[i][s], vbf[s], au, 0, 0, 0);
            *(f32x4*)(GU + ((((size_t)unit * 8 + wave) * 4 + i) * 64 + lane) * 4) = au; }
        const int ct = wave >> 1;
#pragma unroll
        for (int ss = 0; ss < 2; ++ss) { const int s4 = 2 * (wave & 1) + ss; f32x4 aw[2];
#pragma unroll
            for (int kp = 0; kp < 2; ++kp) { const int kt = 2 * s4 + kp; aw[kp] = (f32x4){0.f, 0.f, 0.f, 0.f};
#pragma unroll
                for (int s = 0; s < 2; ++s) aw[kp] = __builtin_amdgcn_mfma_f32_16x16x32_bf16(ldstr(lds, GP_KB, GP_RS, 32 * s + 8 * G, 32 * s + 8 * G + 4, 16 * kt, lane), ldsfrag(lds, GP_TB, 160, 16 * ct, 32 * s, lane), aw[kp], 0, 0, 0); }
            ((u32x4*)(ws + WS_GW + (size_t)unit * 16384))[(ct * 4 + s4) * 64 + lane] = __builtin_bit_cast(u32x4, pack2(aw[0], aw[1])); }
    }
    __syncthreads();
}
constexpr int SC_BUF = 61440, SC_W = 0, SC_QD = 16384, SC_KD = 32768, SC_QK = 49152, SC_U = 57344, SC_OST = 2 * SC_BUF, SC_AHEAD = 3;
__device__ __forceinline__ void gdn_scan_wg(LAS unsigned char* lds, int wave, int lane, int bh, int sl) {
    unsigned char* ws = KWS(); const int b = bh >> 3, h = bh & 7;
    const int role = wave - 1;
    const unsigned char* src0 = ws; size_t ustr0 = 16384; int off0 = 0;
    if (role == 0 || role == 1) { src0 = ws + WS_GW + (role & 1) * 8192; off0 = SC_W + (role & 1) * 8192; }
    else if (role == 2 || role == 3) { src0 = ws + WS_GQD + (role & 1) * 8192; off0 = SC_QD + (role & 1) * 8192; }
    else if (role == 4 || role == 5) { src0 = ws + WS_GKD + (role & 1) * 8192; off0 = SC_KD + (role & 1) * 8192; }
    else if (role == 6) { src0 = ws + WS_GQK; ustr0 = 8192; off0 = SC_QK; }
    const unsigned char* srcU = ws + WS_GU + (size_t)sl * 4096;
#define SC_LOAD(c_) do { const int unit_ = bh * NCH + (c_); const int bo_ = ((c_) & 1) * SC_BUF; \
        const unsigned char* p_ = src0 + (size_t)unit_ * ustr0 + lane * 16; \
        _Pragma("unroll") for (int k_ = 0; k_ < 8; ++k_) __builtin_amdgcn_global_load_lds((const unsigned*)(p_ + k_ * 1024), (LAS unsigned*)(lds + bo_ + off0 + k_ * 1024), 16, 0, 0); \
        if (role == 6) { const unsigned char* q_ = srcU + (size_t)unit_ * 32768 + lane * 16; \
            _Pragma("unroll") for (int k_ = 0; k_ < 4; ++k_) __builtin_amdgcn_global_load_lds((const unsigned*)(q_ + k_ * 1024), (LAS unsigned*)(lds + bo_ + SC_U + k_ * 1024), 16, 0, 0); } } while (0)
    f32x4 S[8];
#pragma unroll
    for (int j = 0; j < 8; ++j) S[j] = (f32x4){0.f, 0.f, 0.f, 0.f};
    if (wave != 0) { SC_LOAD(0); asm volatile("s_waitcnt vmcnt(0)" ::: "memory"); }
    asm volatile("" ::: "memory"); __builtin_amdgcn_s_barrier(); asm volatile("" ::: "memory");
    bf16_t* GO = (bf16_t*)(ws + WS_GO);
    const float* GLp = (const float*)(ws + WS_GL) + bh * NCH;
    float gl_next = GLp[0];
    for (int c = 0; c < NCH; ++c) {
        const float gl = gl_next; gl_next = GLp[c + 1 < NCH ? c + 1 : c];
        if (wave != 0) {
            if (c + 1 < NCH) { SC_LOAD(c + 1); asm volatile("s_waitcnt vmcnt(0)" ::: "memory"); }
        } else {
            LAS unsigned char* bb = lds + (c & 1) * SC_BUF + lane * 16;
            bf16x8 Sb[4];
#pragma unroll
            for (int s = 0; s < 4; ++s) Sb[s] = pack2(S[2 * s], S[2 * s + 1]);
            f32x4 vn[4], o[4];
#pragma unroll
            for (int i = 0; i < 4; ++i) { f32x4 p = (f32x4){0.f, 0.f, 0.f, 0.f}; o[i] = (f32x4){0.f, 0.f, 0.f, 0.f};
#pragma unroll
                for (int s = 0; s < 4; ++s) { p = __builtin_amdgcn_mfma_f32_16x16x32_bf16(*(const LAS bf16x8*)(bb + SC_W + (i * 4 + s) * 1024), Sb[s], p, 0, 0, 0);
                    o[i] = __builtin_amdgcn_mfma_f32_16x16x32_bf16(*(const LAS bf16x8*)(bb + SC_QD + (i * 4 + s) * 1024), Sb[s], o[i], 0, 0, 0); }
                vn[i] = *(const LAS f32x4*)(bb + SC_U + i * 1024) - p; }
            bf16x8 vb[2];
            vb[0] = pack2(vn[0], vn[1]); vb[1] = pack2(vn[2], vn[3]);
#pragma unroll
            for (int i = 0; i < 4; ++i)
#pragma unroll
                for (int s = 0; s < 2; ++s) o[i] = __builtin_amdgcn_mfma_f32_16x16x32_bf16(*(const LAS bf16x8*)(bb + SC_QK + (i * 2 + s) * 1024), vb[s], o[i], 0, 0, 0);
#pragma unroll
            for (int j = 0; j < 8; ++j) { S[j] = S[j] * gl;
#pragma unroll
                for (int s = 0; s < 2; ++s) S[j] = __builtin_amdgcn_mfma_f32_16x16x32_bf16(*(const LAS bf16x8*)(bb + SC_KD + (j * 2 + s) * 1024), vb[s], S[j], 0, 0, 0); }
            LAS bf16_t* ost = (LAS bf16_t*)(lds + SC_OST);
#pragma unroll
            for (int i = 0; i < 4; ++i)
#pragma unroll
                for (int r = 0; r < 4; ++r) ost[(16 * i + 4 * (lane >> 4) + r) * 16 + (lane & 15)] = (bf16_t)f2bf(o[i][r]);
            LDS_WAIT();
#pragma unroll
            for (int k = 0; k < 2; ++k) { const int row = 32 * k + (lane >> 1); const u32x4 v = *(const LAS u32x4*)(ost + row * 16 + (lane & 1) * 8);
                *(u32x4*)(GO + ((size_t)b * SEQ + c * CH + row) * GDN_W + h * GDN_D + 16 * sl + (lane & 1) * 8) = v; }
            LDS_WAIT();
        }
        asm volatile("" ::: "memory"); __builtin_amdgcn_s_barrier(); asm volatile("" ::: "memory");
    }
#undef SC_LOAD
}
__device__ __forceinline__ void phase_gdn_post(const Frame& F, const bf16_t* GO, const bf16_t* Z, const float* ng, bf16_t* CAT) {
    const int d0 = (F.lane & 7) * 16;
    float gv[16];
#pragma unroll
    for (int e = 0; e < 16; ++e) gv[e] = ng[d0 + e];
    for (int m = F.gw(); m < M_TOK; m += F.ngw()) {
        const u32x4 o0 = *(const u32x4*)(GO + (size_t)m * GDN_W + F.lane * 16), o1 = *(const u32x4*)(GO + (size_t)m * GDN_W + F.lane * 16 + 8);
        const float v[16] = {bflo(o0.x), bfhi(o0.x), bflo(o0.y), bfhi(o0.y), bflo(o0.z), bfhi(o0.z), bflo(o0.w), bfhi(o0.w), bflo(o1.x), bfhi(o1.x), bflo(o1.y), bfhi(o1.y), bflo(o1.z), bfhi(o1.z), bflo(o1.w), bfhi(o1.w)};
        float ss = 0.f;
#pragma unroll
        for (int e = 0; e < 16; ++e) ss += v[e] * v[e];
        ss += __shfl_xor(ss, 1); ss += __shfl_xor(ss, 2); ss += __shfl_xor(ss, 4);
        const float rn = rsqf_(ss * (1.0f / GDN_D) + RMS_EPS);
        const u32x4 z0 = *(const u32x4*)(Z + (size_t)m * GDN_W + F.lane * 16), z1 = *(const u32x4*)(Z + (size_t)m * GDN_W + F.lane * 16 + 8);
        const float zz[16] = {bflo(z0.x), bfhi(z0.x), bflo(z0.y), bfhi(z0.y), bflo(z0.z), bfhi(z0.z), bflo(z0.w), bfhi(z0.w), bflo(z1.x), bfhi(z1.x), bflo(z1.y), bfhi(z1.y), bflo(z1.z), bfhi(z1.z), bflo(z1.w), bfhi(z1.w)};
        float o[16];
#pragma unroll
        for (int e = 0; e < 16; ++e) o[e] = v[e] * rn * gv[e] * siluf_(zz[e]);
        u32x4 w0, w1; w0.x = cvt_pk_bf16(o[0], o[1]); w0.y = cvt_pk_bf16(o[2], o[3]); w0.z = cvt_pk_bf16(o[4], o[5]); w0.w = cvt_pk_bf16(o[6], o[7]);
        w1.x = cvt_pk_bf16(o[8], o[9]); w1.y = cvt_pk_bf16(o[10], o[11]); w1.z = cvt_pk_bf16(o[12], o[13]); w1.w = cvt_pk_bf16(o[14], o[15]);
        bf16_t* cp = CAT + (size_t)m * D_MODEL + 512 + F.lane * 16; *(u32x4*)cp = w0; *(u32x4*)(cp + 8) = w1;
    }
}

struct DiagOrder { int nunits, G, c; __device__ bool next(int i, Unit& u) const { if (c < 0) return false; const long L = (long)i * G + c; if (L >= nunits) return false; u.pm = (int)L; u.pn = (int)L; return true; } };
struct GeoS5Intra {
    const char* U5; const char* KT;
    __device__ __forceinline__ int nt() const { return 16; }
    __device__ __forceinline__ int a_voff(int R, int C) const { return (R * 1024 + C) * 2; }
    __device__ __forceinline__ int b_voff(int R, int C) const { return (((R & 15) * 128 - (R >> 4)) * 16 + C) * 2; }
    __device__ __forceinline__ long a_hstep() const { return (long)128 * 1024 * 2; }
    __device__ __forceinline__ long b_hstep() const { return -256; }
    __device__ __forceinline__ const char* a_base(const Unit& u) const { return U5 + (size_t)u.pm * 256 * 1024 * 2; }
    __device__ __forceinline__ const char* b_base(const Unit& u) const { return KT + (size_t)u.pm * (16 * 128 * 16 * 2) + (63 - 16 * u.pn) * 32; }
};
struct GeoS5Inter {
    const char* HX; const char* QT;
    __device__ __forceinline__ int nt() const { return 4; }
    __device__ __forceinline__ int a_voff(int R, int C) const { return (R * 256 + C) * 2; }
    __device__ __forceinline__ int b_voff(int R, int C) const { return (R * 256 + C) * 2; }
    __device__ __forceinline__ long a_hstep() const { return (long)128 * 256 * 2; }
    __device__ __forceinline__ long b_hstep() const { return (long)128 * 256 * 2; }
    __device__ __forceinline__ const char* a_base(const Unit& u) const { return HX + (size_t)u.pm * 256 * 256 * 2; }
    __device__ __forceinline__ const char* b_base(const Unit& u) const { return QT + ((size_t)u.pm * 4 + u.pn) * 256 * 256 * 2; }
};

#define PHASE_FN static __device__ __forceinline__ void
extern __shared__ __attribute__((aligned(16))) unsigned char lds_raw[];
#define UNI(x) x = __builtin_amdgcn_readfirstlane(x)
__device__ __forceinline__ Frame make_frame() { Frame F; F.lds = (LAS unsigned char*)lds_raw;
    int t = threadIdx.x; asm volatile("" : "+v"(t)); F.tid = t; F.lane = t & 63; F.wave = __builtin_amdgcn_readfirstlane(t >> 6);
    int b = blockIdx.x, g = gridDim.x; asm volatile("" : "+s"(b), "+s"(g)); F.bid = b; F.G = g; return F; }
PHASE_FN ph_convert(int l) { UNI(l); const Frame F = make_frame(); unsigned char* const ws = KWS();
    phase_convert(F, l);
    if (l == 0) phase_x_to_bf16(F, KIN(0), (bf16_t*)(ws + WS_XN)); }
PHASE_FN ph_ffn_up(int sb) { UNI(sb); const Frame F = make_frame(); unsigned char* const ws = KWS();
    pg8::GeoStd g{(const char*)(ws + WS_XN), (const char*)(ws + (sb ? WS_WGU2 : WS_WGU1)), D_MODEL, D_MODEL, D_MODEL};
    pg8::StaticOrder S; S.init(M_TOK, 2 * D_FF, F.G, F.bid); EpiSwiGLU E{(bf16_t*)(ws + WS_H)};
    pg8::gemm_phase<pg8::GeoStd, EpiSwiGLU, pg8::StaticOrder, true>(F.lds, F.wave, g, S, E); }
PHASE_FN ph_ffn_down(int sb, int first) { UNI(sb); UNI(first); const Frame F = make_frame(); unsigned char* const ws = KWS();
    pg8::GeoStd g{(const char*)(ws + WS_H), (const char*)(ws + (sb ? WS_WD2 : WS_WD1)), D_FF, D_FF, D_FF};
    float* out = KOUT();
    pg8::StaticOrder S; S.init(M_TOK, D_MODEL, F.G, F.bid); EpiResid E{first ? KIN(0) : out, out, 0.5f};
    pg8::gemm_phase<pg8::GeoStd, EpiResid, pg8::StaticOrder, true>(F.lds, F.wave, g, S, E); }
PHASE_FN ph_ln(int l, int which) { UNI(l); UNI(which); const Frame F = make_frame(); unsigned char* const ws = KWS();
    const float* g = (which == 0 ? KIN(4) : which == 1 ? KIN(29) : KIN(34)) + l * D_MODEL; const float* b = (which == 0 ? KIN(5) : which == 1 ? KIN(30) : KIN(35)) + l * D_MODEL;
    phase_ln(F, KOUT(), g, b, (bf16_t*)(ws + WS_XN)); }
PHASE_FN ph_inproj() { const Frame F = make_frame(); unsigned char* const ws = KWS();
    pg8::GeoStd g{(const char*)(ws + WS_XN), (const char*)(ws + WS_WIN), D_MODEL, D_MODEL, D_MODEL};
    pg8::StaticOrder S; S.init(M_TOK, N_IN_PAD, F.G, F.bid);
    EpiInproj E{(bf16_t*)(ws + WS_U5), (bf16_t*)(ws + WS_QKV), (bf16_t*)(ws + WS_Z), (bf16_t*)(ws + WS_LX), (bf16_t*)(ws + WS_LG), (float*)(ws + WS_AB)};
    pg8::gemm_phase<pg8::GeoStd, EpiInproj, pg8::StaticOrder, true>(F.lds, F.wave, g, S, E); }
PHASE_FN ph_gdn_prep(int l) { UNI(l); const Frame F = make_frame();
    for (int uu = F.bid; uu < NUNIT / 8; uu += F.G)
        for (int u8 = 0; u8 < 8; ++u8) gdn_prep_unit(F, l, uu * 8 + u8); }
PHASE_FN ph_lru_conv(int l) { UNI(l); const Frame F = make_frame(); unsigned char* const ws = KWS();
    phase_lru_conv(F, (const bf16_t*)(ws + WS_LX), KIN(21) + l * 4 * LRU_W, KIN(22) + l * LRU_W, (bf16_t*)(ws + WS_XC)); }
PHASE_FN ph_s5_state() { const Frame F = make_frame(); unsigned char* const ws = KWS();
    pg8::GeoStd g{(const char*)(ws + WS_U5), (const char*)(ws + WS_PTAB), 1024, 1024, 1024};
    DiagOrder S{32, F.G, F.bid}; EpiS5S E{(float*)(ws + WS_S5S)};
    pg8::gemm_phase<pg8::GeoStd, EpiS5S, DiagOrder, false>(F.lds, F.wave, g, S, E); }
PHASE_FN ph_s5_intra() { const Frame F = make_frame(); unsigned char* const ws = KWS();
    GeoS5Intra g{(const char*)(ws + WS_U5), (const char*)(ws + WS_KTAB)};
    pg8::GroupOrder S{128, 4, F.G, F.bid - 32}; EpiS5Intra E{(float*)(ws + WS_YIN)};
    pg8::gemm_phase<GeoS5Intra, EpiS5Intra, pg8::GroupOrder, false>(F.lds, F.wave, g, S, E); }
PHASE_FN ph_gdn_scan() { const Frame F = make_frame();
    const int xcd = F.bid & 7, q = F.bid >> 3; gdn_scan_wg(F.lds, F.wave, F.lane, xcd * 2 + (q >> 3), q & 7); }
constexpr int NSCAN = 128, NCHAIN = 256 - NSCAN;
struct OwnUnitOrder { int g, j; __device__ bool next(int i, Unit& u) const { if (i >= 1) return false; u.pm = g; u.pn = j; return true; } };
template <int L> PHASE_FN ph_chain_a(int rep) { const int l = L; UNI(rep); const Frame F = make_frame(); unsigned char* const ws = KWS();
    const int w = F.bid - NSCAN;
    if (w < 128) {
        const int g = w >> 2, j = w & 3;
        bf16_t* hx = (bf16_t*)(ws + WS_HEXT) + (size_t)j * 32 * 256 * 256;
        s5_carry_group(g, F.tid, KIN(7) + l * 2048, KIN(8) + l * 2048, KIN(14) + l * 32, (const float*)(ws + WS_S5S), hx);
        asm volatile("s_waitcnt vmcnt(0)" ::: "memory"); __syncthreads();
        GeoS5Inter gg{(const char*)hx, (const char*)(ws + WS_QTAB)};
        OwnUnitOrder S{g, j}; EpiS5Inter E{(const float*)(ws + WS_YIN), (const bf16_t*)(ws + WS_U5), KIN(13) + l * S5_W, (bf16_t*)(ws + WS_YACT)};
        pg8::gemm_phase<GeoS5Inter, EpiS5Inter, OwnUnitOrder, false>(F.lds, F.wave, gg, S, E);
        STAMP<L>(18, 128);
    }
    {
        pg8::GeoStd g{(const char*)(ws + WS_XC), (const char*)(ws + WS_WLRU), LRU_W, LRU_W, LRU_W};
        pg8::StaticOrder S; S.init(M_TOK, 1024, NCHAIN, w);
        EpiLRU E{(const bf16_t*)(ws + WS_XC), KIN(24) + l * LRU_W, KIN(26) + l * LRU_W, KIN(27) + l * LRU_W, (float*)(ws + WS_LA), (float*)(ws + WS_LB)};
        pg8::gemm_phase<pg8::GeoStd, EpiLRU, pg8::StaticOrder, false>(F.lds, F.wave, g, S, E);
        asm volatile("s_waitcnt vmcnt(0)" ::: "memory"); __syncthreads();
        STAMP<L>(22, 128);
        Unit u; for (int i = 0; S.next(i, u); ++i) lru_p1_tile(F.tid, u.pm, u.pn, (const float*)(ws + WS_LA), (const float*)(ws + WS_LB), (float*)(ws + WS_CA), (float*)(ws + WS_CB));
        STAMP<L>(23, 128);
    }
    sub_barrier((unsigned*)(ws + WS_CTL) + CW_SUB + 64 * (2 * l + rep), (unsigned)NCHAIN);
}
template <int L> PHASE_FN ph_chain_b() { const int l = L; const Frame F = make_frame(); unsigned char* const ws = KWS();
    const int w = F.bid - NSCAN;
    {   pg8::GeoStd g{(const char*)(ws + WS_YACT), (const char*)(ws + WS_WGLU), S5_W, S5_W, S5_W};
        pg8::StaticOrder S; S.init(M_TOK, S5_W, NCHAIN, w); EpiGLU E{(const bf16_t*)(ws + WS_YACT), KIN(16) + l * S5_W, (bf16_t*)(ws + WS_CAT)};
        pg8::gemm_phase<pg8::GeoStd, EpiGLU, pg8::StaticOrder, false>(F.lds, F.wave, g, S, E); }
    STAMP<L>(20, 128);
    phase_lru_p3(w * (NWAVES * 64) + F.tid, NCHAIN * NWAVES * 64, (const float*)(ws + WS_LA), (const float*)(ws + WS_LB), (const float*)(ws + WS_CA), (const float*)(ws + WS_CB), (const bf16_t*)(ws + WS_LG), (bf16_t*)(ws + WS_CAT));
}
PHASE_FN ph_gdn_post(int l) { UNI(l); const Frame F = make_frame(); unsigned char* const ws = KWS();
    phase_gdn_post(F, (const bf16_t*)(ws + WS_GO), (const bf16_t*)(ws + WS_Z), KIN(20) + l * GDN_D, (bf16_t*)(ws + WS_CAT)); }
PHASE_FN ph_outproj() { const Frame F = make_frame(); unsigned char* const ws = KWS();
    pg8::GeoStd g{(const char*)(ws + WS_CAT), (const char*)(ws + WS_WOUT), D_MODEL, D_MODEL, D_MODEL};
    float* out = KOUT();
    pg8::StaticOrder S; S.init(M_TOK, D_MODEL, F.G, F.bid); EpiResid E{out, out, 1.0f};
    pg8::gemm_phase<pg8::GeoStd, EpiResid, pg8::StaticOrder, true>(F.lds, F.wave, g, S, E); }
PHASE_FN ph_grid_bar() { XcdBarrier b; b.bar = (unsigned*)(KWS() + WS_CTL) + CW_BAR; b.x = xb_xcc_id(); b.st = (volatile LAS unsigned*)((LAS unsigned char*)lds_raw + MISC_OFF) + 8; xcd_barrier(b); }

#ifndef PROBE_CONVERT
#define PROBE_CONVERT 1
#endif
#ifndef PROBE_FFNUP
#define PROBE_FFNUP 1
#endif
#ifndef PROBE_PREP
#define PROBE_PREP 1
#endif
#ifndef PROBE_SCAN
#define PROBE_SCAN 1
#endif
#ifndef PROBE_MIXER
#define PROBE_MIXER 1
#endif
#define GRID_BAR() ph_grid_bar()
#define REPEAT(N, stmt) do { { constexpr int mixrep_ = 0; (void)mixrep_; stmt; } if constexpr ((N) > 1) { GRID_BAR(); constexpr int mixrep_ = 1; (void)mixrep_; stmt; } } while (0)
template <int L, int SB> __device__ __forceinline__ void half_layer(int bid) {
    REPEAT(PROBE_FFNUP, ph_ffn_up(SB));
    GRID_BAR(); STAMP<L>(SB ? 11 : 2, 0);
    ph_ffn_down(SB, (L == 0 && SB == 0) ? 1 : 0);
    GRID_BAR(); STAMP<L>(SB ? 12 : 3, 0);
    ph_ln(L, SB ? 2 : 0);
    GRID_BAR(); STAMP<L>(SB ? 13 : 4, 0);
    if constexpr (SB == 0) {
        ph_inproj();
        GRID_BAR(); STAMP<L>(5, 0);
#define MIXER_BODY do { \
          \
        ph_gdn_prep(L); if constexpr (PROBE_PREP > 1) ph_gdn_prep(L); STAMP<L>(14, 40); ph_lru_conv(L); STAMP<L>(15, 40); ph_s5_state(); ph_s5_intra(); STAMP<L>(16, 40); \
        GRID_BAR(); STAMP<L>(6, 0); \
          \
        if (bid < NSCAN) { ph_gdn_scan(); if constexpr (PROBE_SCAN > 1) ph_gdn_scan(); STAMP<L>(17, 0); } else { ph_chain_a<L>(mixrep_); STAMP<L>(19, 128); ph_chain_b<L>(); STAMP<L>(21, 128); } \
        GRID_BAR(); STAMP<L>(7, 0); \
          \
        ph_gdn_post(L); } while (0)
        REPEAT(PROBE_MIXER, MIXER_BODY);
#undef MIXER_BODY
        GRID_BAR(); STAMP<L>(8, 0);
        ph_outproj();
        GRID_BAR(); STAMP<L>(9, 0);
        ph_ln(L, 1);
        GRID_BAR(); STAMP<L>(10, 0);
    }
}
template <int L> __device__ __forceinline__ void layer(int bid) {
    STAMP<L>(0, 0);
    REPEAT(PROBE_CONVERT, ph_convert(L));
    GRID_BAR(); STAMP<L>(1, 0);
    half_layer<L, 0>(bid);
    half_layer<L, 1>(bid);
}
__global__ void __launch_bounds__(NWAVES * 64, 2) fwd_kernel(Params Pdummy) {
    LAS unsigned char* lds = (LAS unsigned char*)lds_raw;
    for (int u = threadIdx.x; u < (LDS_BYTES - LDSCTL_OFF) / 4; u += NWAVES * 64) ((LAS unsigned*)(lds + LDSCTL_OFF))[u] = 0u;
    __syncthreads();
    LAS unsigned* st = (LAS unsigned*)(lds + MISC_OFF) + 8;
    unsigned* barw = (unsigned*)(KWS() + WS_CTL) + CW_BAR;
    (void)xcd_barrier_post(barw, (volatile LAS unsigned*)st);
    int bid = blockIdx.x; asm volatile("" : "+s"(bid));
    layer<0>(bid); layer<1>(bid); layer<2>(bid); layer<3>(bid);
    probe_tail();
}
#undef GRID_BAR

extern "C" void kernel_launch(void* const* d_in, const int* in_sizes, int n_in, void* d_out, int out_size, void* d_ws, size_t ws_size, hipStream_t stream) {
    static int grid = 0;
    if (grid == 0) {
        if (n_in != 36 || in_sizes[0] != M_TOK * D_MODEL || out_size != M_TOK * D_MODEL || ws_size < WS_END) { fprintf(stderr, "kernel_launch: unexpected shapes (n_in %d, ws %zu < %zu?)\n", n_in, ws_size, (size_t)WS_END); grid = -1; return; }
        int dev = 0, cus = 0, per_cu = 0;
        if (hipGetDevice(&dev) != hipSuccess || hipDeviceGetAttribute(&cus, hipDeviceAttributeMultiprocessorCount, dev) != hipSuccess) { grid = -1; return; }
        if (hipFuncSetAttribute((const void*)fwd_kernel, hipFuncAttributeMaxDynamicSharedMemorySize, LDS_BYTES) != hipSuccess) { fprintf(stderr, "kernel_launch: hipFuncSetAttribute failed\n"); grid = -1; return; }
        if (hipOccupancyMaxActiveBlocksPerMultiprocessor(&per_cu, (const void*)fwd_kernel, NWAVES * 64, LDS_BYTES) != hipSuccess || per_cu < 1) { fprintf(stderr, "kernel_launch: occupancy query reports %d\n", per_cu); }
        (void)hipGetLastError();
        if (cus < 256) { fprintf(stderr, "kernel_launch: needs 256 CUs, device has %d\n", cus); grid = -1; return; }
        grid = 256;
    }
    if (grid < 0) return;
    (void)hipMemsetAsync((char*)d_ws + WS_CTL, 0, CTL_BYTES, stream);
    Params p{};
    for (int i = 0; i < 36; ++i) p.in[i] = (const float*)d_in[i];
    p.out = (float*)d_out; p.ws = (unsigned char*)d_ws;
    hipLaunchKernelGGL(fwd_kernel, dim3(grid), dim3(NWAVES * 64), LDS_BYTES, stream, p);
}
```
